# Optimizing an MI355X kernel written in HIP

```python
import math
import jax, jax.numpy as jnp
from jax import lax
import numpy as np

D_MODEL = 1024
BATCH = 8
SEQ = 4096
DEPTH = 1

HEAD_DIM = 64
N_Q_HEADS = 16
N_KV_HEADS = 4
GROUP = N_Q_HEADS // N_KV_HEADS
ATTN_WIDTH = N_Q_HEADS * HEAD_DIM
KV_WIDTH = N_KV_HEADS * HEAD_DIM
WINDOW = 128
BLOCK = 128
ROT_DIM = HEAD_DIM // 4
ROPE_THETA = 500000.0
NEG_INF = -1e30
LRU_WIDTH = 1024
LRU_BLOCKS = 16
LRU_BLOCK_W = LRU_WIDTH // LRU_BLOCKS
CONV_W = 4
LRU_C = 8.0
MIX_WIDTH = ATTN_WIDTH + LRU_WIDTH
IN_DIM = ATTN_WIDTH + 2 * KV_WIDTH + ATTN_WIDTH + 2 * LRU_WIDTH
SPLITS = tuple(np.cumsum([ATTN_WIDTH, KV_WIDTH, KV_WIDTH, ATTN_WIDTH, LRU_WIDTH]).tolist())
EPS = 1e-6

kernel_name = "hymba_swa_sink_rglru_hybrid"


def rmsnorm(x, g):
    xf = x.astype(jnp.float32)
    y = xf * lax.rsqrt(jnp.mean(xf * xf, axis=-1, keepdims=True) + EPS)
    return (y * g.astype(jnp.float32)).astype(x.dtype)


def partial_rope(t, cos, sin):
    half = ROT_DIM // 2
    t1 = t[..., :half].astype(jnp.float32)
    t2 = t[..., half:ROT_DIM].astype(jnp.float32)
    rot = jnp.concatenate([t1 * cos - t2 * sin, t2 * cos + t1 * sin], axis=-1)
    return jnp.concatenate([rot.astype(t.dtype), t[..., ROT_DIM:]], axis=-1)


def swa_sink_attention(q, k, v, sinks):
    b, s = q.shape[0], q.shape[1]
    nb = s // BLOCK
    qb = q.reshape(b, nb, BLOCK, N_KV_HEADS, GROUP, HEAD_DIM)

    def with_prev(t):
        tb = t.reshape(b, nb, BLOCK, N_KV_HEADS, HEAD_DIM)
        prev = jnp.pad(tb, ((0, 0), (1, 0), (0, 0), (0, 0), (0, 0)))[:, :-1]
        return jnp.concatenate([prev, tb], axis=2)

    kc, vc = with_prev(k), with_prev(v)
    scores = jnp.einsum('bnqhgd,bnkhd->bnhgqk', qb, kc,
                        preferred_element_type=jnp.float32) * (HEAD_DIM ** -0.5)
    qi = jnp.arange(BLOCK)[:, None]
    kj = jnp.arange(2 * BLOCK)[None, :]
    diff = qi + BLOCK - kj
    band = (diff >= 0) & (diff < WINDOW)
    blk = jnp.arange(nb)[:, None, None]
    valid = band[None] & ((blk > 0) | (kj >= BLOCK)[None])
    scores = jnp.where(valid[None, :, None, None], scores, NEG_INF)
    sink = sinks.astype(jnp.float32).reshape(N_KV_HEADS, GROUP)[None, None, :, :, None, None]
    m = jnp.maximum(jnp.max(scores, axis=-1, keepdims=True), sink)
    p = jnp.exp(scores - m)
    denom = jnp.sum(p, axis=-1, keepdims=True) + jnp.exp(sink - m)
    o = jnp.einsum('bnhgqk,bnkhd->bnqhgd', p / denom, vc.astype(jnp.float32))
    return o.reshape(b, s, ATTN_WIDTH).astype(q.dtype)


def causal_depthwise_conv(x, w, bias):
    s = x.shape[1]
    xp = jnp.pad(x, ((0, 0), (CONV_W - 1, 0), (0, 0)))
    y = bias[None, None, :]
    for tap in range(CONV_W):
        y = y + xp[:, tap:tap + s] * w[tap][None, None, :]
    return y


def rg_lru(x, w_r, b_r, w_i, b_i, lam):
    b, s, _ = x.shape
    xf = x.astype(jnp.float32)
    xb = xf.reshape(b, s, LRU_BLOCKS, LRU_BLOCK_W)
    r = jax.nn.sigmoid(jnp.einsum('bsnc,ncd->bsnd', xb, w_r.astype(jnp.float32)).reshape(b, s, LRU_WIDTH)
                       + b_r.astype(jnp.float32))
    i = jax.nn.sigmoid(jnp.einsum('bsnc,ncd->bsnd', xb, w_i.astype(jnp.float32)).reshape(b, s, LRU_WIDTH)
                       + b_i.astype(jnp.float32))
    log_a = -LRU_C * r * jax.nn.softplus(-lam.astype(jnp.float32))
    a = jnp.exp(log_a)
    u = jnp.sqrt(-jnp.expm1(2.0 * log_a)) * (i * xf)

    def combine(left, right):
        a1, b1 = left
        a2, b2 = right
        return a1 * a2, a2 * b1 + b2

    _, h = lax.associative_scan(combine, (a, u), axis=1)
    return h.astype(x.dtype)


def setup_inputs(seed: int = 0) -> dict:
    key = jax.random.key(seed)
    ks = jax.random.split(key, 16)
    f32 = jnp.float32
    x = jax.random.normal(ks[0], (BATCH, SEQ, D_MODEL), f32)
    ln_gain = 1.0 + 0.02 * jax.random.normal(ks[1], (DEPTH, D_MODEL), f32)
    w_in = jax.random.normal(ks[2], (DEPTH, D_MODEL, IN_DIM), f32) * D_MODEL ** -0.5
    sinks = 0.5 * jax.random.normal(ks[3], (DEPTH, N_Q_HEADS), f32)
    conv_w = jax.random.normal(ks[4], (DEPTH, CONV_W, LRU_WIDTH), f32) * CONV_W ** -0.5
    conv_b = 0.02 * jax.random.normal(ks[5], (DEPTH, LRU_WIDTH), f32)
    w_rgate = jax.random.normal(ks[6], (DEPTH, LRU_BLOCKS, LRU_BLOCK_W, LRU_BLOCK_W), f32) * LRU_BLOCK_W ** -0.5
    b_rgate = 0.02 * jax.random.normal(ks[7], (DEPTH, LRU_WIDTH), f32)
    w_igate = jax.random.normal(ks[8], (DEPTH, LRU_BLOCKS, LRU_BLOCK_W, LRU_BLOCK_W), f32) * LRU_BLOCK_W ** -0.5
    b_igate = 0.02 * jax.random.normal(ks[9], (DEPTH, LRU_WIDTH), f32)
    a0 = jax.random.uniform(ks[10], (DEPTH, LRU_WIDTH), f32, 0.9, 0.999)
    sig = a0 ** (1.0 / LRU_C)
    lru_lambda = jnp.log(sig) - jnp.log1p(-sig)
    attn_out_gain = 1.0 + 0.02 * jax.random.normal(ks[11], (DEPTH, ATTN_WIDTH), f32)
    lru_out_gain = 1.0 + 0.02 * jax.random.normal(ks[12], (DEPTH, LRU_WIDTH), f32)
    w_out = jax.random.normal(ks[13], (DEPTH, MIX_WIDTH, D_MODEL), f32) * MIX_WIDTH ** -0.5
    final_gain = 1.0 + 0.02 * jax.random.normal(ks[14], (D_MODEL,), f32)
    return {"x": x, "ln_gain": ln_gain, "w_in": w_in, "sinks": sinks,
            "conv_w": conv_w, "conv_b": conv_b, "w_rgate": w_rgate, "b_rgate": b_rgate,
            "w_igate": w_igate, "b_igate": b_igate, "lru_lambda": lru_lambda,
            "attn_out_gain": attn_out_gain, "lru_out_gain": lru_out_gain,
            "w_out": w_out, "final_gain": final_gain}


def reference(x, ln_gain, w_in, sinks, conv_w, conv_b, w_rgate, b_rgate, w_igate, b_igate,
              lru_lambda, attn_out_gain, lru_out_gain, w_out, final_gain):
    b, s, _ = x.shape
    pos = jnp.arange(s, dtype=jnp.float32)
    inv_freq = ROPE_THETA ** (-jnp.arange(0, ROT_DIM, 2, dtype=jnp.float32) / ROT_DIM)
    ang = pos[:, None] * inv_freq[None, :]
    cos = jnp.cos(ang)[None, :, None, :]
    sin = jnp.sin(ang)[None, :, None, :]
    for l in range(DEPTH):
        h = rmsnorm(x, ln_gain[l])
        z = jnp.einsum('bsd,de->bse', h, w_in[l])
        q, k, v, g_attn, x_lru, g_lru = jnp.split(z, SPLITS, axis=-1)
        q = partial_rope(q.reshape(b, s, N_Q_HEADS, HEAD_DIM), cos, sin)
        k = partial_rope(k.reshape(b, s, N_KV_HEADS, HEAD_DIM), cos, sin)
        v = v.reshape(b, s, N_KV_HEADS, HEAD_DIM)
        y_attn = swa_sink_attention(q, k, v, sinks[l])
        y_attn = rmsnorm(y_attn * jax.nn.silu(g_attn), attn_out_gain[l])
        u = causal_depthwise_conv(x_lru, conv_w[l], conv_b[l])
        y_lru = rg_lru(u, w_rgate[l], b_rgate[l], w_igate[l], b_igate[l], lru_lambda[l])
        y_lru = rmsnorm(y_lru * jax.nn.silu(g_lru), lru_out_gain[l])
        y = jnp.einsum('bse,ed->bsd', jnp.concatenate([y_attn, y_lru], axis=-1), w_out[l])
        x = x + y
    return rmsnorm(x, final_gain)
```

```cpp
#include <hip/hip_runtime.h>
#include <hip/hip_cooperative_groups.h>
#include <cstdio>
#include <cstdint>
namespace cg = cooperative_groups;

#ifndef MK_N_LAUNCHES
#define MK_N_LAUNCHES 1
#endif

#ifndef REP_P0
#define REP_P0 1
#endif
#ifndef REP_P1
#define REP_P1 1
#endif
#ifndef REP_P2L
#define REP_P2L 1
#endif
#ifndef REP_P2A
#define REP_P2A 1
#endif
#ifndef REP_P3
#define REP_P3 1
#endif
#ifndef REP_P4
#define REP_P4 1
#endif
#ifndef REP_SYNC
#define REP_SYNC 1
#endif

#define LAS __attribute__((address_space(3)))
typedef unsigned short bf16_t;
typedef short bf16x8 __attribute__((ext_vector_type(8)));
typedef short s16x4 __attribute__((ext_vector_type(4)));
typedef float f32x4 __attribute__((ext_vector_type(4)));
typedef float f32x2 __attribute__((ext_vector_type(2)));
typedef float f32x16 __attribute__((ext_vector_type(16)));
typedef unsigned u32x4 __attribute__((ext_vector_type(4)));
typedef unsigned u32x2 __attribute__((ext_vector_type(2)));

constexpr int SEQ = 4096, NB = 8, M_TOK = NB * SEQ, DM = 1024, NIN = 4608, KOUT = 2048;
constexpr int COL_Q = 0, COL_K = 1024, COL_V = 1280, COL_GA = 1536, COL_XL = 2560, COL_GL = 3584;
constexpr float EPS = 1e-6f;
constexpr float LOG2E = 1.4426950408889634f;
constexpr float C2 = 0.125f * LOG2E;

constexpr size_t MiB = 1u << 20;
constexpr size_t WS_CTL = 0;
constexpr int CW_BAR = 1024;
constexpr int CW_PANEL = 8192;
constexpr int CW_LRU = 16384;
constexpr size_t WS_WIN = 2 * MiB;
constexpr size_t WS_WOUT = 12 * MiB;
constexpr size_t WS_CS = 16 * MiB;
constexpr size_t WS_SN = 16 * MiB + 128 * 1024;
constexpr size_t WS_MB = 128 * 1024;
constexpr size_t WS_SSQA = 17 * MiB;
constexpr size_t WS_SSQL = 19 * MiB;
constexpr size_t WS_PSS = 21 * MiB;
constexpr size_t WS_XN = 32 * MiB;
constexpr size_t WS_Y = 32 * MiB;
constexpr size_t WS_Z = 160 * MiB;
constexpr size_t WS_END = 448 * MiB;

constexpr int RING_BYTES = 131072;
constexpr int MISC_OFF = RING_BYTES;
constexpr int RS_OFF = RING_BYTES + 512;
constexpr int LDS_BYTES = 147456;

__device__ __forceinline__ unsigned cvt_pk_bf16(float lo, float hi) { unsigned r; asm volatile("v_cvt_pk_bf16_f32 %0, %1, %2" : "=v"(r) : "v"(lo), "v"(hi)); return r; }
__device__ __forceinline__ float bf_lo(unsigned w) { return __uint_as_float(w << 16); }
__device__ __forceinline__ float bf_hi(unsigned w) { return __uint_as_float(w & 0xffff0000u); }
__device__ __forceinline__ unsigned f2bf(float f) { unsigned u = __float_as_uint(f); return (u + 0x7fffu + ((u >> 16) & 1u)) >> 16; }
__device__ __forceinline__ unsigned pk2(float lo, float hi) { return f2bf(lo) | (f2bf(hi) << 16); }
__device__ __forceinline__ float fast_sigmoid(float v) { return __builtin_amdgcn_rcpf(1.0f + __builtin_amdgcn_exp2f(-v * LOG2E)); }

namespace pg8 {
constexpr int BM = 256, BK = 64, HALF = 128, HTB = HALF * BK * 2, STAGE_BYTES = 8 * HTB, NXCD = 8, WGM = 8;
__host__ __device__ __forceinline__ int lds_byte(int r, int c) { const int st = (r >> 4) * 2 + (c >> 5), rr = r & 15, cc = c & 31, ob = rr * 64 + cc * 2; return st * 1024 + (ob ^ (((ob >> 9) & 1) << 5)); }
__host__ __device__ __forceinline__ void stage_rc(int b, int& R, int& C) { const int st = b / 1024, sb = b % 1024, swz = sb ^ (((sb >> 9) & 1) << 5); R = (st >> 1) * 16 + swz / 64; C = (st & 1) * 32 + (swz % 64) / 2; }
__host__ __device__ __forceinline__ int perm32(int rho) { const int n = rho >> 4, i = rho & 15; return 8 * (i >> 2) + 4 * n + (i & 3); }

struct Unit { int pm, pn; };
struct Gemm { const bf16_t* A; const bf16_t* Bt; int M, N, K; };

struct StaticOrder {
    int nM, nN, nwg, G, c, rep;
    __host__ __device__ void init(int M, int N, int G_, int c_, int rep_ = 1) { nM = M / BM; nN = N / BM; nwg = nM * nN; G = G_; c = c_; rep = rep_; }
    __host__ __device__ bool next(int i, Unit& u) const {
        const long L = (long)i * G + c; if (L >= (long)nwg * rep) return false;
        int wgid = (int)(L % nwg); { const int q = nwg / NXCD, r = nwg % NXCD, xcd = wgid % NXCD, off = wgid / NXCD; wgid = (xcd < r ? xcd * (q + 1) : r * (q + 1) + (xcd - r) * q) + off; }
        const int nig = WGM * nN, gid = wgid / nig, fm = gid * WGM, gsz = (nM - fm) < WGM ? (nM - fm) : WGM;
        u.pm = fm + ((wgid % nig) % gsz); u.pn = (wgid % nig) / gsz; return true;
    }
};

template <class Epi, class Sched, bool ALIGN_EPI>
__device__ __forceinline__ void gemm_phase(LAS unsigned char* lds, const Gemm g, const Sched& S, const Epi& E) {
    const int tid = threadIdx.x, wid = __builtin_amdgcn_readfirstlane(tid >> 6), lane = tid & 63, wr = wid >> 2, wc = wid & 3, fr = lane & 15, fq = lane >> 4;
    const int K = g.K, nt = K / BK;
    unsigned voffA[2], voffB[2];
#pragma unroll
    for (int i = 0; i < 2; ++i) { int R, C; stage_rc(tid * 16 + i * 8192, R, C); const int Rb = Epi::PERM ? ((R & ~31) + perm32(R & 31)) : R;
        voffA[i] = (unsigned)(R * K + C) * 2u; voffB[i] = (unsigned)(Rb * K + C) * 2u; }
    const size_t kstep = (size_t)(BK * 2);
    const size_t hstep = (size_t)HALF * K * 2;
    const size_t tstep = 2 * hstep;
    const unsigned ldsw = (unsigned)wid * 1024u;
    const int aoff = lds_byte(wr * 64 + fr, fq * 8), boff = lds_byte(wc * 32 + fr, fq * 8);
#define PG8_SA(b, h) (((b) * 2 + (h)) * HTB)
#define PG8_SB(b, h) ((4 + (b) * 2 + (h)) * HTB)
#define PG8_STAGE(bufoff, gbase, voff) do { _Pragma("unroll") for (int _i = 0; _i < 2; ++_i) \
        __builtin_amdgcn_global_load_lds((const unsigned*)((const char*)(gbase) + (voff)[_i]), (LAS unsigned*)(lds + (bufoff) + ldsw + _i * 8192), 16, 0, 0); } while (0)
#define PG8_LDA(dst, b, h) do { _Pragma("unroll") for (int m = 0; m < 4; ++m) _Pragma("unroll") for (int k = 0; k < 2; ++k) dst[m][k] = *(const LAS bf16x8*)(lds + PG8_SA(b, h) + aoff + m * 2048 + k * 1024); } while (0)
#define PG8_LDB(dst, b, h) do { _Pragma("unroll") for (int n = 0; n < 2; ++n) _Pragma("unroll") for (int k = 0; k < 2; ++k) dst[n][k] = *(const LAS bf16x8*)(lds + PG8_SB(b, h) + boff + n * 2048 + k * 1024); } while (0)
#define PG8_MMA(ai, bj, At, Bt) do { __builtin_amdgcn_s_setprio(1); _Pragma("unroll") for (int m = 0; m < 4; ++m) _Pragma("unroll") for (int n = 0; n < 2; ++n) _Pragma("unroll") for (int k = 0; k < 2; ++k) \
        acc[ai][bj][m][n] = __builtin_amdgcn_mfma_f32_16x16x32_bf16(Bt[n][k], At[m][k], acc[ai][bj][m][n], 0, 0, 0); __builtin_amdgcn_s_setprio(0); } while (0)
#define PG8_WAIT_V(n) asm volatile("s_waitcnt vmcnt(" #n ")" ::: "memory")
#define PG8_WAIT_L(n) asm volatile("s_waitcnt lgkmcnt(" #n ")" ::: "memory")
#define PG8_BAR __builtin_amdgcn_s_barrier()
#define PG8_SCHED __builtin_amdgcn_sched_barrier(0)
    Unit cur, nxt; int ui = 0;
    if (!S.next(0, cur)) return;
    f32x4 acc[2][2][4][2];
#pragma unroll
    for (int a = 0; a < 2; ++a)
#pragma unroll
        for (int b = 0; b < 2; ++b)
#pragma unroll
            for (int m = 0; m < 4; ++m)
#pragma unroll
                for (int n = 0; n < 2; ++n) acc[a][b][m][n] = (f32x4){0.f, 0.f, 0.f, 0.f};
    bf16x8 At[4][2], B0[2][2], B1[2][2];
    const char* cA = (const char*)g.A + (size_t)cur.pm * tstep; const char* cB = (const char*)g.Bt + (size_t)cur.pn * tstep;
    PG8_STAGE(PG8_SB(0, 0), cB, voffB); PG8_STAGE(PG8_SB(0, 1), cB + hstep, voffB); PG8_STAGE(PG8_SA(0, 0), cA, voffA); PG8_STAGE(PG8_SA(0, 1), cA + hstep, voffA);
    if (wr == 1) PG8_BAR;
    PG8_WAIT_V(2); PG8_BAR;
    PG8_STAGE(PG8_SB(1, 0), cB + kstep, voffB); PG8_STAGE(PG8_SA(1, 0), cA + kstep, voffA); PG8_STAGE(PG8_SB(1, 1), cB + hstep + kstep, voffB);
    PG8_WAIT_V(6); PG8_BAR;
    for (;;) {
        const bool has_next = S.next(ui + 1, nxt);
        const char* nA = has_next ? (const char*)g.A + (size_t)nxt.pm * tstep : cA; const char* nB = has_next ? (const char*)g.Bt + (size_t)nxt.pn * tstep : cB;
        for (int t = 0; t < nt; t += 2) {
            const bool last = (t == nt - 2);
            const char* a1 = cA + (size_t)(t + 1) * kstep;
            const char* a2 = last ? nA : cA + (size_t)(t + 2) * kstep; const char* b2 = last ? nB : cB + (size_t)(t + 2) * kstep;
            const char* a3 = a2 + kstep; const char* b3 = b2 + kstep;
            if constexpr (Epi::MIDK > 0) { if (t == Epi::MIDK) E.mid(acc, ui, wr, fr); }
            PG8_LDB(B0, 0, 0); PG8_LDB(B1, 0, 1); PG8_SCHED; PG8_LDA(At, 0, 0); PG8_STAGE(PG8_SA(1, 1), a1 + hstep, voffA);
            PG8_WAIT_V(8); PG8_WAIT_L(0); PG8_BAR; PG8_MMA(0, 0, At, B0); PG8_MMA(0, 1, At, B1); PG8_BAR; PG8_SCHED;
            PG8_LDA(At, 0, 1); PG8_STAGE(PG8_SB(0, 0), b2, voffB); PG8_STAGE(PG8_SB(0, 1), b2 + hstep, voffB); PG8_STAGE(PG8_SA(0, 0), a2, voffA);
            PG8_WAIT_V(8); PG8_WAIT_L(0); PG8_BAR; PG8_MMA(1, 0, At, B0); PG8_MMA(1, 1, At, B1); PG8_BAR; PG8_SCHED;
            PG8_LDB(B0, 1, 0); PG8_LDB(B1, 1, 1); PG8_SCHED; PG8_LDA(At, 1, 0); PG8_STAGE(PG8_SA(0, 1), a2 + hstep, voffA);
            PG8_WAIT_V(8); PG8_WAIT_L(0); PG8_BAR; PG8_MMA(0, 0, At, B0); PG8_MMA(0, 1, At, B1); PG8_BAR; PG8_SCHED;
            PG8_LDA(At, 1, 1); PG8_STAGE(PG8_SB(1, 0), b3, voffB); PG8_STAGE(PG8_SB(1, 1), b3 + hstep, voffB); PG8_STAGE(PG8_SA(1, 0), a3, voffA);
            PG8_WAIT_V(8); PG8_WAIT_L(0); PG8_BAR; PG8_MMA(1, 0, At, B0); PG8_MMA(1, 1, At, B1); PG8_BAR; PG8_SCHED;
        }
        if constexpr (ALIGN_EPI) { if (wr == 0) PG8_BAR; }
        E(acc, cur, ui, wr, wc, fr, fq);
        if (!has_next) break;
#pragma unroll
        for (int a = 0; a < 2; ++a)
#pragma unroll
            for (int b = 0; b < 2; ++b)
#pragma unroll
                for (int m = 0; m < 4; ++m)
#pragma unroll
                    for (int n = 0; n < 2; ++n) acc[a][b][m][n] = (f32x4){0.f, 0.f, 0.f, 0.f};
        cur = nxt; cA = nA; cB = nB; ++ui;
        if constexpr (ALIGN_EPI) { if (wr == 1) PG8_BAR; }
    }
    PG8_WAIT_V(0);
    if constexpr (!ALIGN_EPI) { if (wr == 0) PG8_BAR; }
    PG8_BAR;
#undef PG8_SA
#undef PG8_SB
#undef PG8_STAGE
#undef PG8_LDA
#undef PG8_LDB
#undef PG8_MMA
#undef PG8_WAIT_V
#undef PG8_WAIT_L
#undef PG8_BAR
#undef PG8_SCHED
}
}

struct EpiZ {
    static constexpr bool PERM = true; static constexpr int MIDK = 0;
    bf16_t* Z; const float* cs; const float* sn;
    __device__ __forceinline__ void mid(f32x4 (&acc)[2][2][4][2], int ui, int wr, int fr) const {}
    __device__ __forceinline__ void operator()(const f32x4 (&acc)[2][2][4][2], const pg8::Unit& u, int ui, int wr, int wc, int fr, int fq) const {
        const int row0 = u.pm * 256 + wr * 64 + fr, col0 = u.pn * 256 + wc * 32 + 8 * fq, pn = u.pn;
        const int mode = (pn <= 4) ? 2 : (pn == 5 ? 0 : (pn <= 9 ? 1 : (pn <= 13 ? 0 : 1)));
        const bool rope = (mode == 2) && ((wc & 1) == 0);
        const float sc = (pn <= 3) ? C2 : 1.f;
        const float sgn = (fq == 0) ? -1.f : 1.f;
#pragma unroll
        for (int ai = 0; ai < 2; ++ai)
#pragma unroll
            for (int m = 0; m < 4; ++m) {
                const int row = row0 + ai * 128 + m * 16;
                bf16_t* rowp = Z + (size_t)row * NIN + col0;
                f32x4 c0 = {1.f, 1.f, 1.f, 1.f}, c1 = c0, s0 = {0.f, 0.f, 0.f, 0.f}, s1 = s0;
                if (rope && fq < 2) { const int pos = row & (SEQ - 1); c0 = *(const f32x4*)(cs + pos * 8); c1 = *(const f32x4*)(cs + pos * 8 + 4); s0 = *(const f32x4*)(sn + pos * 8) * sgn; s1 = *(const f32x4*)(sn + pos * 8 + 4) * sgn; }
#pragma unroll
                for (int bj = 0; bj < 2; ++bj) {
                    f32x4 v0 = acc[ai][bj][m][0], v1 = acc[ai][bj][m][1];
                    if (rope) {
                        f32x4 p0, p1;
#pragma unroll
                        for (int k = 0; k < 4; ++k) { p0[k] = __shfl_xor(v0[k], 16); p1[k] = __shfl_xor(v1[k], 16); }
                        v0 = v0 * c0 + p0 * s0; v1 = v1 * c1 + p1 * s1;
                    } else if (mode == 1) {
#pragma unroll
                        for (int k = 0; k < 4; ++k) { v0[k] = v0[k] * fast_sigmoid(v0[k]); v1[k] = v1[k] * fast_sigmoid(v1[k]); }
                    }
                    v0 = v0 * sc; v1 = v1 * sc;
                    u32x4 w; w.x = cvt_pk_bf16(v0[0], v0[1]); w.y = cvt_pk_bf16(v0[2], v0[3]); w.z = cvt_pk_bf16(v1[0], v1[1]); w.w = cvt_pk_bf16(v1[2], v1[3]);
                    *(u32x4*)(rowp + bj * 128) = w;
                }
            }
    }
};

struct EpiOut {
    static constexpr bool PERM = false; static constexpr int MIDK = 16;
    const float* x; float* out; float* pss; LAS const f32x2* RS;
    __device__ __forceinline__ void mid(f32x4 (&acc)[2][2][4][2], int ui, int wr, int fr) const {
#pragma unroll
        for (int ai = 0; ai < 2; ++ai)
#pragma unroll
            for (int m = 0; m < 4; ++m) { const float ratio = RS[(ui & 3) * 256 + ai * 128 + wr * 64 + m * 16 + fr].x;
#pragma unroll
                for (int bj = 0; bj < 2; ++bj)
#pragma unroll
                    for (int n = 0; n < 2; ++n) acc[ai][bj][m][n] = acc[ai][bj][m][n] * ratio; }
    }
    __device__ __forceinline__ void operator()(const f32x4 (&acc)[2][2][4][2], const pg8::Unit& u, int ui, int wr, int wc, int fr, int fq) const {
        const int col0 = u.pn * 256 + wc * 32 + 4 * fq;
#pragma unroll
        for (int ai = 0; ai < 2; ++ai)
#pragma unroll
            for (int m = 0; m < 4; ++m) {
                const int lr = ai * 128 + wr * 64 + m * 16 + fr; const float rB = RS[(ui & 3) * 256 + lr].y;
                const size_t off = (size_t)(u.pm * 256 + lr) * DM + col0; float ss = 0.f;
#pragma unroll
                for (int bj = 0; bj < 2; ++bj)
#pragma unroll
                    for (int n = 0; n < 2; ++n) { const f32x4 xb = *(const f32x4*)(x + off + bj * 128 + n * 16); const f32x4 o = xb + acc[ai][bj][m][n] * rB;
                        ss += (o[0] * o[0] + o[1] * o[1]) + (o[2] * o[2] + o[3] * o[3]); *(f32x4*)(out + off + bj * 128 + n * 16) = o; }
                ss += __shfl_xor(ss, 16); ss += __shfl_xor(ss, 32);
                if (fq == 0) pss[(size_t)(u.pm * 256 + lr) * 16 + u.pn * 4 + wc] = ss;
            }
    }
};

struct EpiOutF {
    static constexpr bool PERM = false; static constexpr int MIDK = 16;
    const float* x; float* out; const float* fg; float* xbuf; unsigned* cnt; LAS const f32x2* RS; LAS float* PP; LAS float* SS;
    __device__ __forceinline__ void mid(f32x4 (&acc)[2][2][4][2], int ui, int wr, int fr) const {
#pragma unroll
        for (int ai = 0; ai < 2; ++ai)
#pragma unroll
            for (int m = 0; m < 4; ++m) { const float ratio = RS[(ui & 3) * 256 + ai * 128 + wr * 64 + m * 16 + fr].x;
#pragma unroll
                for (int bj = 0; bj < 2; ++bj)
#pragma unroll
                    for (int n = 0; n < 2; ++n) acc[ai][bj][m][n] = acc[ai][bj][m][n] * ratio; }
    }
    __device__ __forceinline__ void operator()(f32x4 (&acc)[2][2][4][2], const pg8::Unit& u, int ui, int wr, int wc, int fr, int fq) const {
        const int tid = threadIdx.x, lane = tid & 63, wid = __builtin_amdgcn_readfirstlane(tid >> 6);
        const int col0 = u.pn * 256 + wc * 32 + 4 * fq;
#pragma unroll
        for (int ai = 0; ai < 2; ++ai)
#pragma unroll
            for (int m = 0; m < 4; ++m) {
                const int lr = ai * 128 + wr * 64 + m * 16 + fr; const float rB = RS[(ui & 3) * 256 + lr].y;
                const size_t off = (size_t)(u.pm * 256 + lr) * DM + col0; float ss = 0.f;
#pragma unroll
                for (int bj = 0; bj < 2; ++bj)
#pragma unroll
                    for (int n = 0; n < 2; ++n) { const f32x4 xb = __builtin_nontemporal_load((const f32x4*)(x + off + bj * 128 + n * 16)); const f32x4 o = xb + acc[ai][bj][m][n] * rB;
                        ss += (o[0] * o[0] + o[1] * o[1]) + (o[2] * o[2] + o[3] * o[3]); acc[ai][bj][m][n] = o; }
                ss += __shfl_xor(ss, 16); ss += __shfl_xor(ss, 32);
                if (fq == 0) PP[lr * 4 + wc] = ss;
            }
        asm volatile("s_waitcnt lgkmcnt(0)" ::: "memory"); __builtin_amdgcn_s_barrier(); asm volatile("" ::: "memory");
        unsigned* pc = cnt + 64 * u.pm;
        if (tid < 256) { const f32x4 pp = *(const LAS f32x4*)(PP + tid * 4); const float tp = (pp[0] + pp[1]) + (pp[2] + pp[3]);
            __hip_atomic_store(xbuf + (size_t)(u.pm * 256 + tid) * 4 + u.pn, tp, __ATOMIC_RELAXED, __HIP_MEMORY_SCOPE_AGENT); }
        asm volatile("s_waitcnt vmcnt(0)" ::: "memory");
        if (tid < 256 && lane == 0) __hip_atomic_fetch_add(pc, 1u, __ATOMIC_RELAXED, __HIP_MEMORY_SCOPE_AGENT);
        if (wid == 0) {
            unsigned sp = 0;
            while ((unsigned)__builtin_amdgcn_readfirstlane(__hip_atomic_load(pc, __ATOMIC_RELAXED, __HIP_MEMORY_SCOPE_AGENT)) < 16u) { __builtin_amdgcn_s_sleep(2); if (++sp > (1u << 22)) break; }
            __builtin_amdgcn_fence(__ATOMIC_ACQUIRE, "agent");
        }
        asm volatile("s_waitcnt vmcnt(0) lgkmcnt(0)" ::: "memory"); __builtin_amdgcn_s_barrier(); asm volatile("" ::: "memory");
        if (tid < 256) { const float* slot = xbuf + (size_t)(u.pm * 256 + tid) * 4; float q = 0.f;
#pragma unroll
            for (int t = 0; t < 4; ++t) q += __hip_atomic_load(slot + t, __ATOMIC_RELAXED, __HIP_MEMORY_SCOPE_AGENT);
            SS[tid] = 1.0f / sqrtf(q * (1.f / DM) + EPS); }
        asm volatile("s_waitcnt lgkmcnt(0)" ::: "memory"); __builtin_amdgcn_s_barrier(); asm volatile("" ::: "memory");
        f32x4 gv[2][2];
#pragma unroll
        for (int bj = 0; bj < 2; ++bj)
#pragma unroll
            for (int n = 0; n < 2; ++n) gv[bj][n] = *(const f32x4*)(fg + col0 + bj * 128 + n * 16);
#pragma unroll
        for (int ai = 0; ai < 2; ++ai)
#pragma unroll
            for (int m = 0; m < 4; ++m) {
                const int lr = ai * 128 + wr * 64 + m * 16 + fr; const float rs = SS[lr];
                const size_t off = (size_t)(u.pm * 256 + lr) * DM + col0;
#pragma unroll
                for (int bj = 0; bj < 2; ++bj)
#pragma unroll
                    for (int n = 0; n < 2; ++n) __builtin_nontemporal_store(acc[ai][bj][m][n] * rs * gv[bj][n], (f32x4*)(out + off + bj * 128 + n * 16));
            }
        asm volatile("s_waitcnt lgkmcnt(0)" ::: "memory"); __builtin_amdgcn_s_barrier(); asm volatile("" ::: "memory");
    }
};

__device__ __forceinline__ float wave_sum(float v) {
#pragma unroll
    for (int o = 1; o < 64; o <<= 1) v += __shfl_xor(v, o);
    return v;
}
__device__ __forceinline__ void p0_transpose_item(const float* W, int K, int N, bf16_t* WT, const float* kscale, LAS float* scr, int item, int lane) {
    const int nblk = N / 32, kb = item / nblk, nb = item % nblk, k0 = 64 * kb, n0 = 32 * nb;
#pragma unroll
    for (int i = 0; i < 32; ++i) { const int kk = 2 * i + (lane >> 5); float v = W[(size_t)(k0 + kk) * N + n0 + (lane & 31)]; if (kscale) v *= kscale[k0 + kk]; scr[kk * 33 + (lane & 31)] = v; }
    asm volatile("s_waitcnt lgkmcnt(0)" ::: "memory");
    const int c = lane & 7;
#pragma unroll
    for (int j = 0; j < 4; ++j) { const int n = (lane >> 3) + 8 * j; const LAS float* s = scr + (8 * c) * 33 + n;
        u32x4 o; o.x = pk2(s[0 * 33], s[1 * 33]); o.y = pk2(s[2 * 33], s[3 * 33]); o.z = pk2(s[4 * 33], s[5 * 33]); o.w = pk2(s[6 * 33], s[7 * 33]);
        *(u32x4*)(WT + (size_t)(n0 + n) * K + k0 + 8 * c) = o; }
    asm volatile("s_waitcnt lgkmcnt(0)" ::: "memory");
}
__device__ __forceinline__ void sincos_d(double xx, double& s, double& c) {
    const double kq = rint(xx * 0.63661977236758134308);
    double r = fma(-kq, 1.57079632679489655800e+00, xx); r = fma(-kq, 6.12323399573676603587e-17, r);
    const int q = ((int)kq) & 3; const double r2 = r * r;
    const double sp = r * (1.0 + r2 * (-1.0 / 6.0 + r2 * (1.0 / 120.0 + r2 * (-1.0 / 5040.0 + r2 * (1.0 / 362880.0 + r2 * (-1.0 / 39916800.0 + r2 * (1.0 / 6227020800.0 + r2 * (-1.0 / 1307674368000.0))))))));
    const double cp = 1.0 + r2 * (-0.5 + r2 * (1.0 / 24.0 + r2 * (-1.0 / 720.0 + r2 * (1.0 / 40320.0 + r2 * (-1.0 / 3628800.0 + r2 * (1.0 / 479001600.0 + r2 * (-1.0 / 87178291200.0 + r2 * (1.0 / 20922789888000.0))))))));
    s = (q == 0) ? sp : (q == 1) ? cp : (q == 2) ? -sp : -cp;
    c = (q == 0) ? cp : (q == 1) ? -sp : (q == 2) ? -cp : sp;
}

namespace att {
constexpr int KV_ROWS = 192, RS = 144;
constexpr int L_K = 0, L_V = KV_ROWS * RS, L_STG = 2 * KV_ROWS * RS, STG_RS = 272, STG_W = 32 * STG_RS, L_LW = L_STG + 8 * STG_W, L_END = L_LW + 8 * 128;
static_assert(L_END <= RING_BYTES, "attention LDS");
__device__ __forceinline__ int crow(int i, int h) { return (i & 3) + 8 * (i >> 2) + 4 * h; }
__device__ __forceinline__ s16x4 vtr(LAS const unsigned char* p) { return __builtin_bit_cast(s16x4, __builtin_amdgcn_ds_read_tr16_b64_v4i16((LAS s16x4*)p)); }

constexpr int NUNITS = NB * 4 * 64;
__device__ __forceinline__ void load_kvq(u32x4 (&kreg)[3], u32x4 (&vreg)[3], bf16x8 (&qr)[4], const bf16_t* __restrict__ z, int u, int tid, int wid, int r, int h) {
    const int b = u >> 8, kvh = (u >> 6) & 3, q0 = (u & 63) * 64; const size_t rowbase = (size_t)b * SEQ;
    const int head = kvh * 4 + (wid >> 1), qs = q0 + 32 * (wid & 1);
#pragma unroll
    for (int i = 0; i < 3; ++i) { const int pidx = tid + 512 * i, row = pidx >> 3, ch = pidx & 7, pos = q0 - 128 + row;
        if (pos >= 0) { const bf16_t* src = z + (rowbase + pos) * NIN + COL_K + kvh * 64 + ch * 8; kreg[i] = *(const u32x4*)src; vreg[i] = *(const u32x4*)(src + 256); }
        else { kreg[i] = (u32x4){0u, 0u, 0u, 0u}; vreg[i] = (u32x4){0u, 0u, 0u, 0u}; } }
#pragma unroll
    for (int d0 = 0; d0 < 4; ++d0) qr[d0] = *(const bf16x8*)(z + (rowbase + qs + r) * NIN + COL_Q + head * 64 + d0 * 16 + h * 8);
}

__device__ __forceinline__ void run(LAS unsigned char* lds, const bf16_t* __restrict__ z, bf16_t* __restrict__ y, float* __restrict__ ssq, const float* __restrict__ sinks, unsigned* ctr, LAS int* ubox) {
    const int tid = threadIdx.x, lane = tid & 63, r = lane & 31, h = lane >> 5, wid = __builtin_amdgcn_readfirstlane(tid >> 6);
    if (tid == 0) ubox[0] = (int)atomicAdd(ctr, 1u);
    __syncthreads();
    int u = ubox[0];
    if (u >= NUNITS) return;
    u32x4 kreg[3], vreg[3]; bf16x8 qn[4];
    load_kvq(kreg, vreg, qn, z, u, tid, wid, r, h);
    if (tid == 0) ubox[1] = (int)atomicAdd(ctr, 1u);
    for (int n = 0;; ++n) {
        const int b = u >> 8, kvh = (u >> 6) & 3, q0 = (u & 63) * 64; const size_t rowbase = (size_t)b * SEQ;
        const int head = kvh * 4 + (wid >> 1), qs = q0 + 32 * (wid & 1);
        bf16x8 qr[4];
#pragma unroll
        for (int d0 = 0; d0 < 4; ++d0) qr[d0] = qn[d0];
#pragma unroll
        for (int i = 0; i < 3; ++i) { const int pidx = tid + 512 * i, row = pidx >> 3, ch = pidx & 7;
            *(LAS u32x4*)(lds + L_K + row * RS + ch * 16) = kreg[i]; *(LAS u32x4*)(lds + L_V + row * RS + ch * 16) = vreg[i]; }
        __syncthreads();
        const int un = ubox[(n + 1) & 1];
        if (un < NUNITS) load_kvq(kreg, vreg, qn, z, un, tid, wid, r, h);
        unsigned nxt2 = 0u;
        if (tid == 0) nxt2 = atomicAdd(ctr, 1u);
        u32x4 gv[4];
#pragma unroll
        for (int it = 0; it < 4; ++it) gv[it] = *(const u32x4*)(z + (rowbase + qs + it * 8 + (lane >> 3)) * NIN + COL_GA + head * 64 + (lane & 7) * 8);
        f32x16 s[5];
        const LAS unsigned char* kb = lds + L_K + (32 * (wid & 1) + r) * RS + h * 16;
#pragma unroll
        for (int c = 0; c < 5; ++c) { f32x16 a = {0.f, 0.f, 0.f, 0.f, 0.f, 0.f, 0.f, 0.f, 0.f, 0.f, 0.f, 0.f, 0.f, 0.f, 0.f, 0.f};
#pragma unroll
            for (int d0 = 0; d0 < 4; ++d0) { const bf16x8 kf = *(const LAS bf16x8*)(kb + c * 32 * RS + d0 * 32); a = __builtin_amdgcn_mfma_f32_32x32x16_bf16(kf, qr[d0], a, 0, 0, 0); }
            s[c] = a; }
        const float sink2 = sinks[head] * LOG2E;
        float mx = -1e30f;
        if (q0 < 128) {
#pragma unroll
            for (int c = 0; c < 5; ++c)
#pragma unroll
                for (int i = 0; i < 16; ++i) { const int cr = crow(i, h), diff = 128 - 32 * c + r - cr, kp = qs - 128 + 32 * c + cr;
                    const bool valid = (diff >= 0) && (diff < 128) && (kp >= 0); const float v = valid ? s[c][i] : -1e30f; s[c][i] = v; mx = fmaxf(mx, v); }
        } else {
#pragma unroll
            for (int i = 0; i < 16; ++i) { const int cr = crow(i, h); const float v0 = (cr > r) ? s[0][i] : -1e30f, v4 = (cr <= r) ? s[4][i] : -1e30f; s[0][i] = v0; s[4][i] = v4; mx = fmaxf(mx, fmaxf(v0, v4)); }
#pragma unroll
            for (int c = 1; c < 4; ++c)
#pragma unroll
                for (int i = 0; i < 16; ++i) mx = fmaxf(mx, s[c][i]);
        }
        mx = fmaxf(mx, __shfl_xor(mx, 32));
        const float mref = fmaxf(mx, sink2);
        float lsum = 0.f;
#pragma unroll
        for (int c = 0; c < 5; ++c)
#pragma unroll
            for (int i = 0; i < 16; ++i) { const float pv = __builtin_amdgcn_exp2f(s[c][i] - mref); s[c][i] = pv; lsum += pv; }
        lsum += __shfl_xor(lsum, 32);
        const float l = lsum + __builtin_amdgcn_exp2f(sink2 - mref);
        f32x16 o[2];
        o[0] = (f32x16){0.f, 0.f, 0.f, 0.f, 0.f, 0.f, 0.f, 0.f, 0.f, 0.f, 0.f, 0.f, 0.f, 0.f, 0.f, 0.f}; o[1] = o[0];
        const LAS unsigned char* vb = lds + L_V + (32 * (wid & 1) + 4 * h + ((lane & 15) >> 2)) * RS + ((lane >> 4) & 1) * 32 + (lane & 3) * 8;
#pragma unroll
        for (int c = 0; c < 5; ++c)
#pragma unroll
            for (int s2 = 0; s2 < 2; ++s2) {
                u32x4 pw; pw.x = cvt_pk_bf16(s[c][8 * s2 + 0], s[c][8 * s2 + 1]); pw.y = cvt_pk_bf16(s[c][8 * s2 + 2], s[c][8 * s2 + 3]); pw.z = cvt_pk_bf16(s[c][8 * s2 + 4], s[c][8 * s2 + 5]); pw.w = cvt_pk_bf16(s[c][8 * s2 + 6], s[c][8 * s2 + 7]);
                const bf16x8 pa = __builtin_bit_cast(bf16x8, pw);
#pragma unroll
                for (int dh = 0; dh < 2; ++dh) { const LAS unsigned char* ap = vb + (32 * c + 16 * s2) * RS + dh * 64;
                    const s16x4 lo = vtr(ap), hi = vtr(ap + 8 * RS);
                    const bf16x8 vf = __builtin_shufflevector(lo, hi, 0, 1, 2, 3, 4, 5, 6, 7);
                    o[dh] = __builtin_amdgcn_mfma_f32_32x32x16_bf16(pa, vf, o[dh], 0, 0, 0); }
            }
        LAS float* lw = (LAS float*)(lds + L_LW + wid * 128);
        if (h == 0) lw[r] = l;
        LAS unsigned char* stg = lds + L_STG + wid * STG_W;
#pragma unroll
        for (int i = 0; i < 16; ++i) { const int cr = crow(i, h); const float rl = __builtin_amdgcn_rcpf(lw[cr]);
            *(LAS float*)(stg + cr * STG_RS + r * 4) = o[0][i] * rl; *(LAS float*)(stg + cr * STG_RS + (32 + r) * 4) = o[1][i] * rl; }
#pragma unroll
        for (int it = 0; it < 4; ++it) { const int row = it * 8 + (lane >> 3), ch = lane & 7;
            const f32x4 a0 = *(const LAS f32x4*)(stg + row * STG_RS + ch * 32), a1 = *(const LAS f32x4*)(stg + row * STG_RS + ch * 32 + 16);
            const size_t grow = rowbase + qs + row;
            const u32x4 g = gv[it];
            const float g0 = bf_lo(g.x), g1 = bf_hi(g.x), g2 = bf_lo(g.y), g3 = bf_hi(g.y), g4 = bf_lo(g.z), g5 = bf_hi(g.z), g6 = bf_lo(g.w), g7 = bf_hi(g.w);
            const float y0 = a0[0] * g0, y1 = a0[1] * g1, y2 = a0[2] * g2, y3 = a0[3] * g3;
            const float y4 = a1[0] * g4, y5 = a1[1] * g5, y6 = a1[2] * g6, y7 = a1[3] * g7;
            float ss = (y0 * y0 + y1 * y1) + (y2 * y2 + y3 * y3) + (y4 * y4 + y5 * y5) + (y6 * y6 + y7 * y7);
            ss += __shfl_xor(ss, 1); ss += __shfl_xor(ss, 2); ss += __shfl_xor(ss, 4);
            u32x4 w; w.x = cvt_pk_bf16(y0, y1); w.y = cvt_pk_bf16(y2, y3); w.z = cvt_pk_bf16(y4, y5); w.w = cvt_pk_bf16(y6, y7);
            *(u32x4*)(y + grow * KOUT + head * 64 + ch * 8) = w;
            if (ch == 0) ssq[grow * 16 + head] = ss; }
        if (tid == 0) ubox[n & 1] = (int)nxt2;
        __syncthreads();
        u = un;
        if (u >= NUNITS) break;
    }
}
}

namespace lru {
constexpr int L_CW = 0, L_WT = 2048, L_STG = L_WT + 8192, STG_RS = 272, STG_W = 16 * STG_RS, L_END = L_STG + 8 * STG_W;
static_assert(L_END <= RING_BYTES, "lru LDS");
constexpr int NCH = SEQ / 128;

template <bool FIRST> __device__ __forceinline__ void load_x(u32x4 (&xv)[4][2], const bf16_t* __restrict__ z, size_t rowbase, int tok, int cbase) {
#pragma unroll
    for (int tap = 0; tap < 4; ++tap) { const int pos = tok - 3 + tap, posc = (FIRST && pos < 0) ? 0 : pos;
#pragma unroll
        for (int ks = 0; ks < 2; ++ks) xv[tap][ks] = *(const u32x4*)(z + (rowbase + posc) * NIN + cbase + 32 * ks); }
    if (FIRST) {
#pragma unroll
        for (int tap = 0; tap < 3; ++tap) if (tok - 3 + tap < 0) { xv[tap][0] = (u32x4){0u, 0u, 0u, 0u}; xv[tap][1] = (u32x4){0u, 0u, 0u, 0u}; }
    }
}

template <bool PAIRED>
__device__ __forceinline__ void unit(LAS unsigned char* lds, const bf16_t* __restrict__ z, bf16_t* __restrict__ y, float* __restrict__ ssq,
                                     const float* __restrict__ conv_w, const float* __restrict__ conv_b, const float* __restrict__ w_r, const float* __restrict__ b_r,
                                     const float* __restrict__ w_i, const float* __restrict__ b_i, const float* __restrict__ lam, int b, int blk,
                                     int half, unsigned* myseq, unsigned* pseq, float* mydata, float* pdata) {
    constexpr int STEP = PAIRED ? 2 : 1, NIT = NCH / STEP;
    const int tid = threadIdx.x, lane = tid & 63, fr = lane & 15, fq = lane >> 4, wid = __builtin_amdgcn_readfirstlane(tid >> 6);
    const size_t rowbase = (size_t)b * SEQ;
    LAS float* cw = (LAS float*)(lds + L_CW);
    if (tid < 320) { const int tap = tid >> 6, c = tid & 63; cw[tid] = (tap < 4) ? conv_w[tap * 1024 + blk * 64 + c] : conv_b[blk * 64 + c]; }
    bf16x8 bfr[2][4], bfi[2][4];
#pragma unroll
    for (int ks = 0; ks < 2; ++ks)
#pragma unroll
        for (int nt = 0; nt < 4; ++nt) {
            u32x4 wr_, wi_; unsigned* pr = (unsigned*)&wr_; unsigned* pi = (unsigned*)&wi_;
#pragma unroll
            for (int j = 0; j < 8; j += 2) { const size_t o0 = ((size_t)blk * 64 + 8 * fq + j + 32 * ks) * 64 + fr + 16 * nt;
                pr[j >> 1] = pk2(w_r[o0], w_r[o0 + 64]); pi[j >> 1] = pk2(w_i[o0], w_i[o0 + 64]); }
            bfr[ks][nt] = __builtin_bit_cast(bf16x8, wr_); bfi[ks][nt] = __builtin_bit_cast(bf16x8, wi_);
        }
    float nbr[4], nbi[4], sp[4], carry[4], Aown[4], Hown[4];
#pragma unroll
    for (int nt = 0; nt < 4; ++nt) { const int c = blk * 64 + fr + 16 * nt; nbr[nt] = -b_r[c] * LOG2E; nbi[nt] = -b_i[c] * LOG2E; sp[nt] = -8.0f * log1pf(expf(-lam[c])) * LOG2E; carry[nt] = 0.f; Aown[nt] = 1.f; Hown[nt] = 0.f; }
    __syncthreads();
    const int cbaseA = COL_XL + blk * 64 + 8 * fq;
    LAS unsigned char* stg = lds + L_STG + wid * STG_W;
    u32x4 xn[4][2], gn[2];
    if (wid == 0 && half == 0) load_x<true>(xn, z, rowbase, fr, cbaseA); else load_x<false>(xn, z, rowbase, 128 * half + 16 * wid + fr, cbaseA);
    const bf16_t* gbase = z + (rowbase + 128 * half + 16 * wid + (lane >> 3)) * NIN + COL_GL + blk * 64 + (lane & 7) * 8;
    gn[0] = *(const u32x4*)gbase; gn[1] = *(const u32x4*)(gbase + (size_t)8 * NIN);
    for (int kk = 0; kk < NIT; ++kk) {
        asm volatile("" ::: "memory");
        const int k = half + STEP * kk;
        const int tw = 128 * k + 16 * wid;
        bf16x8 uA[2];
#pragma unroll
        for (int ks = 0; ks < 2; ++ks) {
            float u[8];
            { const f32x4 b0 = *(const LAS f32x4*)(cw + 4 * 64 + 32 * ks + 8 * fq), b1 = *(const LAS f32x4*)(cw + 4 * 64 + 32 * ks + 8 * fq + 4);
              u[0] = b0[0]; u[1] = b0[1]; u[2] = b0[2]; u[3] = b0[3]; u[4] = b1[0]; u[5] = b1[1]; u[6] = b1[2]; u[7] = b1[3]; }
#pragma unroll
            for (int tap = 0; tap < 4; ++tap) { const f32x4 w0 = *(const LAS f32x4*)(cw + tap * 64 + 32 * ks + 8 * fq), w1 = *(const LAS f32x4*)(cw + tap * 64 + 32 * ks + 8 * fq + 4); const u32x4 xx = xn[tap][ks];
                u[0] += w0[0] * bf_lo(xx.x); u[1] += w0[1] * bf_hi(xx.x); u[2] += w0[2] * bf_lo(xx.y); u[3] += w0[3] * bf_hi(xx.y);
                u[4] += w1[0] * bf_lo(xx.z); u[5] += w1[1] * bf_hi(xx.z); u[6] += w1[2] * bf_lo(xx.w); u[7] += w1[3] * bf_hi(xx.w); }
            u32x4 pw; pw.x = cvt_pk_bf16(u[0], u[1]); pw.y = cvt_pk_bf16(u[2], u[3]); pw.z = cvt_pk_bf16(u[4], u[5]); pw.w = cvt_pk_bf16(u[6], u[7]);
            uA[ks] = __builtin_bit_cast(bf16x8, pw);
            *(LAS f32x4*)(stg + fr * STG_RS + (32 * ks + 8 * fq) * 4) = (f32x4){u[0], u[1], u[2], u[3]};
            *(LAS f32x4*)(stg + fr * STG_RS + (32 * ks + 8 * fq) * 4 + 16) = (f32x4){u[4], u[5], u[6], u[7]};
        }
        const u32x4 gc0 = gn[0], gc1 = gn[1];
        if (kk + 1 < NIT) { load_x<false>(xn, z, rowbase, tw + 128 * STEP + fr, cbaseA); const bf16_t* gp = gbase + (size_t)(128 * STEP * (kk + 1)) * NIN; gn[0] = *(const u32x4*)gp; gn[1] = *(const u32x4*)(gp + (size_t)8 * NIN); }
        float Al[4][4], Hl[4][4], At_[4], Ht_[4];
#pragma unroll
        for (int nt = 0; nt < 4; ++nt) {
            f32x4 R = {0.f, 0.f, 0.f, 0.f}, I = R;
            R = __builtin_amdgcn_mfma_f32_16x16x32_bf16(uA[0], bfr[0][nt], R, 0, 0, 0); R = __builtin_amdgcn_mfma_f32_16x16x32_bf16(uA[1], bfr[1][nt], R, 0, 0, 0);
            I = __builtin_amdgcn_mfma_f32_16x16x32_bf16(uA[0], bfi[0][nt], I, 0, 0, 0); I = __builtin_amdgcn_mfma_f32_16x16x32_bf16(uA[1], bfi[1][nt], I, 0, 0, 0);
            float A = 1.f, H = 0.f;
#pragma unroll
            for (int ip = 0; ip < 2; ++ip) {
                const f32x2 uc = {*(const LAS float*)(stg + (4 * fq + 2 * ip) * STG_RS + (fr + 16 * nt) * 4), *(const LAS float*)(stg + (4 * fq + 2 * ip + 1) * STG_RS + (fr + 16 * nt) * 4)};
                const f32x2 R2 = {R[2 * ip], R[2 * ip + 1]}, I2 = {I[2 * ip], I[2 * ip + 1]};
                const f32x2 t1 = R2 * (-LOG2E) + nbr[nt], t2 = I2 * (-LOG2E) + nbi[nt];
                f32x2 d1 = {__builtin_amdgcn_exp2f(t1.x), __builtin_amdgcn_exp2f(t1.y)}, d2 = {__builtin_amdgcn_exp2f(t2.x), __builtin_amdgcn_exp2f(t2.y)};
                d1 = d1 + 1.0f; d2 = d2 + 1.0f;
                const f32x2 dd = d1 * d2; const f32x2 inv = {__builtin_amdgcn_rcpf(dd.x), __builtin_amdgcn_rcpf(dd.y)};
                const f32x2 rg = d2 * inv, ig = d1 * inv, la = rg * sp[nt];
                const f32x2 a = {__builtin_amdgcn_exp2f(la.x), __builtin_amdgcn_exp2f(la.y)};
                const f32x2 om = 1.0f - a * a; const f32x2 sq = {__builtin_amdgcn_sqrtf(om.x), __builtin_amdgcn_sqrtf(om.y)};
                const f32x2 bb = sq * (ig * uc);
                H = a.x * H + bb.x; A = A * a.x; Al[nt][2 * ip] = A; Hl[nt][2 * ip] = H;
                H = a.y * H + bb.y; A = A * a.y; Al[nt][2 * ip + 1] = A; Hl[nt][2 * ip + 1] = H;
            }
            float pA = __shfl_up(A, 16), pH = __shfl_up(H, 16);
            if (fq >= 1) { H = A * pH + H; A = A * pA; }
            pA = __shfl_up(A, 32); pH = __shfl_up(H, 32);
            if (fq >= 2) { H = A * pH + H; A = A * pA; }
            At_[nt] = A; Ht_[nt] = H;
            if (fq == 3) *(LAS f32x2*)(lds + L_WT + (((kk & 1) * 8 + wid) * 64 + nt * 16 + fr) * 8) = (f32x2){A, H};
        }
        __syncthreads();
        float Ap[4], Hp[4];
        if constexpr (PAIRED) {
            if (wid < 4 && k + 1 < NCH) {
                const int nt = wid; const unsigned tag = 0x11u + (unsigned)kk;
                unsigned long long* slotp = (unsigned long long*)mydata + (kk & 3) * 64 + nt * 16 + fr;
                float Ar = 1.f, Hr = 0.f;
#pragma unroll
                for (int w = 0; w < 8; ++w) { const f32x2 t = *(const LAS f32x2*)(lds + L_WT + (((kk & 1) * 8 + w) * 64 + nt * 16 + fr) * 8); Hr = t.x * Hr + t.y; Ar = Ar * t.x; }
                if (fq == 0) __hip_atomic_store(slotp, ((unsigned long long)__float_as_uint(Hr) << 32) | (unsigned long long)((__float_as_uint(Ar) & 0xffffff00u) | tag), __ATOMIC_RELAXED, __HIP_MEMORY_SCOPE_AGENT);
            }
            if (k > 0) {
                const unsigned need = half ? (unsigned)(kk + 1) : (unsigned)kk, tag = 0x10u + need; unsigned spn = 0;
                const unsigned long long* pd = (const unsigned long long*)pdata + ((need - 1u) & 3u) * 64 + fr;
                for (;;) {
                    unsigned long long v[4]; bool ok = true;
#pragma unroll
                    for (int nt = 0; nt < 4; ++nt) { v[nt] = __hip_atomic_load(pd + nt * 16, __ATOMIC_RELAXED, __HIP_MEMORY_SCOPE_AGENT); ok = ok && (((unsigned)v[nt] & 0xffu) == tag); }
#pragma unroll
                    for (int nt = 0; nt < 4; ++nt) { Ap[nt] = __uint_as_float((unsigned)v[nt] & 0xffffff00u); Hp[nt] = __uint_as_float((unsigned)(v[nt] >> 32)); }
                    if (__all(ok) || ++spn > (1u << 20)) break;
                    __builtin_amdgcn_s_sleep(1);
                }
            } else {
#pragma unroll
                for (int nt = 0; nt < 4; ++nt) { Ap[nt] = 0.f; Hp[nt] = 0.f; }
            }
        }
#pragma unroll
        for (int nt = 0; nt < 4; ++nt) {
            float Ar = 1.f, Hr = 0.f, Ain = 1.f, Hin = 0.f;
#pragma unroll
            for (int w = 0; w < 8; ++w) { const f32x2 t = *(const LAS f32x2*)(lds + L_WT + (((kk & 1) * 8 + w) * 64 + nt * 16 + fr) * 8); if (w == wid) { Ain = Ar; Hin = Hr; } Hr = t.x * Hr + t.y; Ar = Ar * t.x; }
            float cc;
            if constexpr (PAIRED) { cc = Ap[nt] * (Aown[nt] * carry[nt] + Hown[nt]) + Hp[nt]; carry[nt] = cc; Aown[nt] = Ar; Hown[nt] = Hr; }
            else { cc = carry[nt]; carry[nt] = Ar * cc + Hr; }
            const float cin = Ain * cc + Hin;
            float eA = __shfl_up(At_[nt], 16), eH = __shfl_up(Ht_[nt], 16);
            if (fq == 0) { eA = 1.f; eH = 0.f; }
            const float hin = eA * cin + eH;
#pragma unroll
            for (int i = 0; i < 4; ++i) *(LAS float*)(stg + (4 * fq + i) * STG_RS + (fr + 16 * nt) * 4) = Hl[nt][i] + Al[nt][i] * hin;
        }
#pragma unroll
        for (int it = 0; it < 2; ++it) { const int row = it * 8 + (lane >> 3), ch = lane & 7;
            const f32x4 a0 = *(const LAS f32x4*)(stg + row * STG_RS + ch * 32), a1 = *(const LAS f32x4*)(stg + row * STG_RS + ch * 32 + 16);
            const size_t grow = rowbase + tw + row;
            const u32x4 g = it ? gc1 : gc0;
            const float y0 = a0[0] * bf_lo(g.x), y1 = a0[1] * bf_hi(g.x), y2 = a0[2] * bf_lo(g.y), y3 = a0[3] * bf_hi(g.y);
            const float y4 = a1[0] * bf_lo(g.z), y5 = a1[1] * bf_hi(g.z), y6 = a1[2] * bf_lo(g.w), y7 = a1[3] * bf_hi(g.w);
            float ss = (y0 * y0 + y1 * y1) + (y2 * y2 + y3 * y3) + (y4 * y4 + y5 * y5) + (y6 * y6 + y7 * y7);
            ss += __shfl_xor(ss, 1); ss += __shfl_xor(ss, 2); ss += __shfl_xor(ss, 4);
            u32x4 w; w.x = cvt_pk_bf16(y0, y1); w.y = cvt_pk_bf16(y2, y3); w.z = cvt_pk_bf16(y4, y5); w.w = cvt_pk_bf16(y6, y7);
            *(u32x4*)(y + grow * KOUT + 1024 + blk * 64 + ch * 8) = w;
            if (ch == 0) ssq[grow * 16 + blk] = ss; }
    }
    __syncthreads();
}
}

#define XB_TMO      128
#define XB_XCNT(j)  (256  + 64 * (j))
#define XB_XSUB(j)  (1280 + 64 * (j))
#define XB_XGEN(j)  (2304 + 64 * (j))
#define XB_TOP      3328
#define XB_TOPGEN   3392
#define XCD_BAR_WORDS 3456
#define XB_SPIN_CAP (1u << 18)
__device__ __forceinline__ unsigned xb_ld(unsigned* p)              { return __hip_atomic_load(p, __ATOMIC_RELAXED, __HIP_MEMORY_SCOPE_AGENT); }
__device__ __forceinline__ unsigned xb_add(unsigned* p, unsigned v) { return __hip_atomic_fetch_add(p, v, __ATOMIC_RELAXED, __HIP_MEMORY_SCOPE_AGENT); }
__device__ __forceinline__ unsigned xb_xcc_id() { return (unsigned)__builtin_amdgcn_s_getreg((3 << 11) | 20) & 0xFu; }
#define XB_SPIN(cond, bar) do { unsigned _sp = 0; while (cond) { __builtin_amdgcn_s_sleep(1); \
    if ((++_sp & 255u) == 0u) { if (xb_ld(&(bar)[XB_TMO])) break; if (_sp > XB_SPIN_CAP) { atomicAdd(&(bar)[XB_TMO], 1u); break; } } } } while (0)
struct XcdBarrier { unsigned* bar; unsigned x; volatile LAS unsigned* st; };
__device__ __forceinline__ XcdBarrier xcd_barrier_post(unsigned* bar, volatile LAS unsigned* st) {
    XcdBarrier b; b.bar = bar; b.x = xb_xcc_id(); b.st = st;
    if (threadIdx.x == 0) (void)xb_add(&bar[XB_XCNT(b.x)], 1u);
    return b;
}
__device__ __forceinline__ void xcd_barrier_complete(unsigned* bar, unsigned x, unsigned& nloc, unsigned& nx) {
    const unsigned G = gridDim.x * gridDim.y * gridDim.z;
    unsigned sum, cnt, mine, sp = 0u;
    for (;;) {
        sum = 0u; cnt = 0u; mine = 0u;
#pragma unroll
        for (unsigned j = 0; j < 16; ++j) { const unsigned c = xb_ld(&bar[XB_XCNT(j)]); sum += c; cnt += (c > 0u) ? 1u : 0u; mine = (j == x) ? c : mine; }
        if (sum == G) break;
        __builtin_amdgcn_s_sleep(1);
        if ((++sp & 255u) == 0u) { if (xb_ld(&bar[XB_TMO])) break; if (sp > XB_SPIN_CAP) { atomicAdd(&bar[XB_TMO], 1u); break; } }
    }
    nloc = mine > 0u ? mine : 1u; nx = cnt > 0u ? cnt : 1u;
}
__device__ __forceinline__ void xcd_barrier(const XcdBarrier& b) {
    asm volatile("s_waitcnt vmcnt(0)" ::: "memory");
    __syncthreads();
    if (threadIdx.x == 0) {
        unsigned* bar = b.bar;
        __builtin_amdgcn_s_waitcnt(0);
        unsigned nloc = b.st[0], nx = b.st[1];
        if (nloc == 0u) { xcd_barrier_complete(bar, b.x, nloc, nx); b.st[0] = nloc; b.st[1] = nx; }
        const unsigned old = xb_add(&bar[XB_XSUB(b.x)], 1u);
        const unsigned gen = old / nloc;
        if (old + 1u == (gen + 1u) * nloc) {
            __builtin_amdgcn_fence(__ATOMIC_RELEASE, "agent");
            asm volatile("s_waitcnt vmcnt(0)" ::: "memory");
            const unsigned og = xb_add(&bar[XB_TOP], 1u);
            const unsigned tg = og / nx;
            if (og + 1u == (tg + 1u) * nx) xb_add(&bar[XB_TOPGEN], 1u);
            else XB_SPIN(xb_ld(&bar[XB_TOPGEN]) == tg, bar);
            __builtin_amdgcn_fence(__ATOMIC_ACQUIRE, "agent");
            xb_add(&bar[XB_XGEN(b.x)], 1u);
            asm volatile("s_waitcnt vmcnt(0)" ::: "memory");
        } else {
            XB_SPIN(xb_ld(&bar[XB_XGEN(b.x)]) == gen, bar);
            __builtin_amdgcn_fence(__ATOMIC_ACQUIRE, "agent");
            asm volatile("s_waitcnt vmcnt(0)" ::: "memory");
        }
    }
    __syncthreads();
}

struct Params {
    const float* x; const float* ln_gain; const float* w_in; const float* sinks; const float* conv_w; const float* conv_b;
    const float* w_r; const float* b_r; const float* w_i; const float* b_i; const float* lam; const float* ga; const float* gl; const float* w_out; const float* fg;
    float* out; unsigned char* ws; int ph_lo, ph_hi;
};

__global__ void __launch_bounds__(512, 2) mega(Params p) {
    extern __shared__ __attribute__((aligned(16))) unsigned char lds_raw[];
    LAS unsigned char* lds = (LAS unsigned char*)lds_raw;
    const int tid = threadIdx.x, lane = tid & 63, wave = __builtin_amdgcn_readfirstlane(tid >> 6);
    const int G = gridDim.x, bx = blockIdx.x;
    unsigned char* ws = p.ws;
    unsigned* ctl = (unsigned*)(ws + WS_CTL);
    bf16_t* WinT = (bf16_t*)(ws + WS_WIN); bf16_t* WoutT = (bf16_t*)(ws + WS_WOUT);
    float* cs = (float*)(ws + WS_CS); float* sn = (float*)(ws + WS_SN);
    float* ssqa = (float*)(ws + WS_SSQA); float* ssql = (float*)(ws + WS_SSQL); float* pss = (float*)(ws + WS_PSS);
    bf16_t* XN = (bf16_t*)(ws + WS_XN); bf16_t* Y = (bf16_t*)(ws + WS_Y); bf16_t* Z = (bf16_t*)(ws + WS_Z);
    const int lo = p.ph_lo, hi = p.ph_hi;
#define IN(k) (lo <= (k) && (k) < hi)
    if (tid < 32) ((LAS unsigned*)(lds + MISC_OFF))[tid] = 0u;
    __syncthreads();
    XcdBarrier bar; bar.bar = ctl + CW_BAR; bar.x = 0; bar.st = nullptr;
    if (hi - lo > 1) bar = xcd_barrier_post(ctl + CW_BAR, (volatile LAS unsigned*)(lds + MISC_OFF) + 8);
    if (hi > 1000) cg::this_grid().sync();
#define SEAM(k) do { if (IN(k) && IN((k) + 1)) { for (int rs_ = 0; rs_ < REP_SYNC; ++rs_) xcd_barrier(bar); } } while (0)

    if (IN(0)) for (int rep = 0; rep < REP_P0; ++rep) {
        LAS float* scr = (LAS float*)(lds + wave * 16384);
        const int gw = bx * 8 + wave, NGW = G * 8;
        constexpr int I_IN = (DM / 64) * (NIN / 32), I_OUT = (KOUT / 64) * (DM / 32);
        for (int it = gw; it < I_IN + I_OUT; it += NGW) {
            if (it < I_IN) p0_transpose_item(p.w_in, DM, NIN, WinT, nullptr, scr, it, lane);
            else { const int r = it - I_IN; const int kb = r / (DM / 32); p0_transpose_item(p.w_out, KOUT, DM, WoutT, (kb < 16) ? p.ga : (p.gl - 1024), scr, r, lane); }
        }
        for (int e = bx * 512 + tid; e < SEQ * 8; e += G * 512) {
            const int pos = e >> 3, i = e & 7;
            const double invf = (i == 0) ? 1.0 : (i == 1) ? 0.19392274474868576 : (i == 2) ? 0.03760603093086393 : (i == 3) ? 0.007292664737217109 : (i == 4) ? 0.001414213562373095
                              : (i == 5) ? 0.0002742481756762073 : (i == 6) ? 5.318295896944988e-05 : 1.031338537721246e-05;
            double s, c; sincos_d((double)pos * invf, s, c); cs[e] = (float)c; sn[e] = (float)s;
        }
        {
            const f32x4* gr = (const f32x4*)p.ln_gain + lane;
            f32x4 gq[4];
#pragma unroll
            for (int j = 0; j < 4; ++j) gq[j] = gr[64 * j];
            for (int m0 = gw * 4; m0 < M_TOK; m0 += NGW * 4) {
                f32x4 v[4][4]; float s2[4];
#pragma unroll
                for (int rr = 0; rr < 4; ++rr) { const f32x4* xr = (const f32x4*)(p.x + (size_t)(m0 + rr) * DM) + lane;
#pragma unroll
                    for (int j = 0; j < 4; ++j) v[rr][j] = __builtin_nontemporal_load(xr + 64 * j); }
#pragma unroll
                for (int rr = 0; rr < 4; ++rr) { float t = 0.f;
#pragma unroll
                    for (int j = 0; j < 4; ++j) t += (v[rr][j].x * v[rr][j].x + v[rr][j].y * v[rr][j].y) + (v[rr][j].z * v[rr][j].z + v[rr][j].w * v[rr][j].w);
                    s2[rr] = t; }
#pragma unroll
                for (int o = 1; o < 64; o <<= 1) {
#pragma unroll
                    for (int rr = 0; rr < 4; ++rr) s2[rr] += __shfl_xor(s2[rr], o); }
#pragma unroll
                for (int rr = 0; rr < 4; ++rr) { const float rstd = 1.0f / sqrtf(s2[rr] * (1.f / DM) + EPS);
                    u32x2* o8 = (u32x2*)(XN + (size_t)(m0 + rr) * DM) + lane;
#pragma unroll
                    for (int j = 0; j < 4; ++j) { const f32x4 g = gq[j]; u32x2 w; w.x = cvt_pk_bf16(v[rr][j].x * rstd * g.x, v[rr][j].y * rstd * g.y); w.y = cvt_pk_bf16(v[rr][j].z * rstd * g.z, v[rr][j].w * rstd * g.w); o8[64 * j] = w; } }
            }
        }
    }
    SEAM(0);

    if (IN(1)) {
        pg8::Gemm g{XN, WinT, M_TOK, NIN, DM}; pg8::StaticOrder S; S.init(M_TOK, NIN, G, bx, REP_P1);
        EpiZ E{Z, cs, sn};
        pg8::gemm_phase<EpiZ, pg8::StaticOrder, true>(lds, g, S, E);
    }
    SEAM(1);

    if (IN(2)) {
        {
            const int uu = bx & 127, half = (bx >> 7) & 1;
            unsigned* sq = ctl + CW_LRU + uu * 128; float* mb = (float*)(ws + WS_MB) + uu * 1024;
            lru::unit<true>(lds, Z, Y, ssql, p.conv_w, p.conv_b, p.w_r, p.b_r, p.w_i, p.b_i, p.lam, uu >> 4, uu & 15, half, sq + 64 * half, sq + 64 * (half ^ 1), mb + 512 * half, mb + 512 * (half ^ 1));
        }
        LAS int* ubox = (LAS int*)(lds + MISC_OFF);
        for (int rep = 0; rep < REP_P2A; ++rep) { att::run(lds, Z, Y, ssqa, p.sinks, ctl + 64 + 64 * rep, ubox); __syncthreads(); }
    }
    SEAM(2);

    if (IN(3)) {
        pg8::Gemm g{Y, WoutT, M_TOK, DM, KOUT}; pg8::StaticOrder S; S.init(M_TOK, DM, G, bx, REP_P3);
        LAS f32x2* RS = (LAS f32x2*)(lds + RS_OFF);
        pg8::Unit u;
        for (int i = 0; i < 4 && S.next(i, u); ++i) {
            if (tid < 256) { const size_t row = (size_t)u.pm * 256 + tid; const f32x4* pa = (const f32x4*)(ssqa + row * 16); const f32x4* pl = (const f32x4*)(ssql + row * 16);
                float sa = 0.f, sl = 0.f;
#pragma unroll
                for (int j = 0; j < 4; ++j) { const f32x4 a = pa[j], l = pl[j]; sa += (a.x + a.y) + (a.z + a.w); sl += (l.x + l.y) + (l.z + l.w); }
                const float rA = 1.0f / sqrtf(sa * (1.f / 1024.f) + EPS), rB = 1.0f / sqrtf(sl * (1.f / 1024.f) + EPS);
                RS[i * 256 + tid] = (f32x2){rA / rB, rB}; }
        }
        __syncthreads();
        EpiOutF E{p.x, p.out, p.fg, pss, ctl + CW_PANEL, RS, (LAS float*)(lds + RS_OFF + 8192), (LAS float*)(lds + RS_OFF + 8192 + 4096)};
        pg8::gemm_phase<EpiOutF, pg8::StaticOrder, true>(lds, g, S, E);
    }
    SEAM(3);

    if (IN(4)) {
        const int gw = bx * 8 + wave, NGW = G * 8;
        const f32x4* fgr = (const f32x4*)p.fg + lane;
        for (int rep = 0; rep < REP_P4; ++rep)
        for (int m = gw; m < M_TOK; m += NGW) {
            float s2 = (lane < 16) ? pss[(size_t)m * 16 + lane] : 0.f;
            s2 += __shfl_xor(s2, 1); s2 += __shfl_xor(s2, 2); s2 += __shfl_xor(s2, 4); s2 += __shfl_xor(s2, 8);
            s2 = __shfl(s2, 0);
            float rstd = 1.0f / sqrtf(s2 * (1.f / DM) + EPS);
            if (rep > 0) rstd = 1.0f;
            f32x4* orow = (f32x4*)(p.out + (size_t)m * DM) + lane;
#pragma unroll
            for (int j = 0; j < 4; ++j) { const f32x4 t = orow[64 * j]; f32x4 g = fgr[64 * j]; if (rep > 0) g = (f32x4){1.f, 1.f, 1.f, 1.f}; orow[64 * j] = t * rstd * g; }
        }
    }
#undef IN
#undef SEAM
}

extern "C" void kernel_launch(void* const* d_in, const int* in_sizes, int n_in, void* d_out, int out_size, void* d_ws, size_t ws_size, hipStream_t stream) {
    static int grid = 0;
    if (grid == 0) {
        if (n_in != 15 || in_sizes[0] != M_TOK * DM || out_size != M_TOK * DM || ws_size < WS_END) { fprintf(stderr, "kernel_launch: unexpected shapes (n_in %d, ws %zu)\n", n_in, ws_size); grid = -1; return; }
        int dev = 0, cus = 0, per_cu = 0;
        (void)hipGetDevice(&dev); (void)hipDeviceGetAttribute(&cus, hipDeviceAttributeMultiprocessorCount, dev);
        if (hipFuncSetAttribute((const void*)mega, hipFuncAttributeMaxDynamicSharedMemorySize, LDS_BYTES) != hipSuccess) { fprintf(stderr, "kernel_launch: hipFuncSetAttribute failed\n"); grid = -1; return; }
        if (hipOccupancyMaxActiveBlocksPerMultiprocessor(&per_cu, (const void*)mega, 512, LDS_BYTES) != hipSuccess || per_cu < 1) { fprintf(stderr, "kernel_launch: occupancy query says %d\n", per_cu); per_cu = 1; }
        (void)hipGetLastError();
        grid = 256;
        if (cus * per_cu < 256) fprintf(stderr, "kernel_launch: device capacity %d x %d < 256 workgroups\n", cus, per_cu);
    }
    if (grid < 0) return;
    (void)hipMemsetAsync((char*)d_ws + WS_CTL, 0, 131072 + 524288, stream);
    Params p{};
    p.x = (const float*)d_in[0]; p.ln_gain = (const float*)d_in[1]; p.w_in = (const float*)d_in[2]; p.sinks = (const float*)d_in[3]; p.conv_w = (const float*)d_in[4]; p.conv_b = (const float*)d_in[5];
    p.w_r = (const float*)d_in[6]; p.b_r = (const float*)d_in[7]; p.w_i = (const float*)d_in[8]; p.b_i = (const float*)d_in[9]; p.lam = (const float*)d_in[10]; p.ga = (const float*)d_in[11]; p.gl = (const float*)d_in[12];
    p.w_out = (const float*)d_in[13]; p.fg = (const float*)d_in[14]; p.out = (float*)d_out; p.ws = (unsigned char*)d_ws;
    if (MK_N_LAUNCHES == 1) {
        p.ph_lo = 0; p.ph_hi = 4; void* args[] = {&p};
        hipError_t e = hipLaunchCooperativeKernel((const void*)mega, dim3(grid), dim3(512), args, LDS_BYTES, stream);
        if (e != hipSuccess) fprintf(stderr, "kernel_launch: cooperative launch failed: %s (grid %d)\n", hipGetErrorString(e), grid);
    } else {
        for (int ph = 0; ph < 4; ++ph) { p.ph_lo = ph; p.ph_hi = ph + 1; hipLaunchKernelGGL(mega, dim3(grid), dim3(512), LDS_BYTES, stream, p); }
    }
}
```

```cpp
#include <hip/hip_runtime.h>
#include <hip/hip_cooperative_groups.h>
#include <cstdio>
#include <cstdint>
namespace cg = cooperative_groups;

#ifndef MK_N_LAUNCHES
#define MK_N_LAUNCHES 1
#endif

#ifndef REP_P0
#define REP_P0 1
#endif
#ifndef REP_P1
#define REP_P1 1
#endif
#ifndef REP_P2L
#define REP_P2L 1
#endif
#ifndef REP_P2A
#define REP_P2A 1
#endif
#ifndef REP_P3
#define REP_P3 1
#endif
#ifndef REP_P4
#define REP_P4 1
#endif
#ifndef REP_SYNC
#define REP_SYNC 1
#endif

#define LAS __attribute__((address_space(3)))
typedef unsigned short bf16_t;
typedef short bf16x8 __attribute__((ext_vector_type(8)));
typedef short s16x4 __attribute__((ext_vector_type(4)));
typedef float f32x4 __attribute__((ext_vector_type(4)));
typedef float f32x2 __attribute__((ext_vector_type(2)));
typedef float f32x16 __attribute__((ext_vector_type(16)));
typedef unsigned u32x4 __attribute__((ext_vector_type(4)));
typedef unsigned u32x2 __attribute__((ext_vector_type(2)));

constexpr int SEQ = 4096, NB = 8, M_TOK = NB * SEQ, DM = 1024, NIN = 4608, KOUT = 2048;
constexpr int COL_Q = 0, COL_K = 1024, COL_V = 1280, COL_GA = 1536, COL_XL = 2560, COL_GL = 3584;
constexpr float EPS = 1e-6f;
constexpr float LOG2E = 1.4426950408889634f;
constexpr float C2 = 0.125f * LOG2E;

constexpr size_t MiB = 1u << 20;
constexpr size_t WS_CTL = 0;
constexpr int CW_BAR = 1024;
constexpr int CW_PANEL = 8192;
constexpr int CW_LRU = 16384;
constexpr size_t WS_WIN = 2 * MiB;
constexpr size_t WS_WOUT = 12 * MiB;
constexpr size_t WS_CS = 16 * MiB;
constexpr size_t WS_SN = 16 * MiB + 128 * 1024;
constexpr size_t WS_MB = 128 * 1024;
constexpr size_t WS_SSQA = 17 * MiB;
constexpr size_t WS_SSQL = 19 * MiB;
constexpr size_t WS_PSS = 21 * MiB;
constexpr size_t WS_XN = 32 * MiB;
constexpr size_t WS_Y = 32 * MiB;
constexpr size_t WS_Z = 160 * MiB;
constexpr size_t WS_END = 448 * MiB;

constexpr int RING_BYTES = 131072;
constexpr int MISC_OFF = RING_BYTES;
constexpr int RS_OFF = RING_BYTES + 512;
constexpr int LDS_BYTES = 147456;

__device__ __forceinline__ unsigned cvt_pk_bf16(float lo, float hi) { unsigned r; asm volatile("v_cvt_pk_bf16_f32 %0, %1, %2" : "=v"(r) : "v"(lo), "v"(hi)); return r; }
__device__ __forceinline__ float bf_lo(unsigned w) { return __uint_as_float(w << 16); }
__device__ __forceinline__ float bf_hi(unsigned w) { return __uint_as_float(w & 0xffff0000u); }
__device__ __forceinline__ unsigned f2bf(float f) { unsigned u = __float_as_uint(f); return (u + 0x7fffu + ((u >> 16) & 1u)) >> 16; }
__device__ __forceinline__ unsigned pk2(float lo, float hi) { return f2bf(lo) | (f2bf(hi) << 16); }
__device__ __forceinline__ float fast_sigmoid(float v) { return __builtin_amdgcn_rcpf(1.0f + __builtin_amdgcn_exp2f(-v * LOG2E)); }

namespace pg8 {
constexpr int BM = 256, BK = 64, HALF = 128, HTB = HALF * BK * 2, STAGE_BYTES = 8 * HTB, NXCD = 8, WGM = 8;
__host__ __device__ __forceinline__ int lds_byte(int r, int c) { const int st = (r >> 4) * 2 + (c >> 5), rr = r & 15, cc = c & 31, ob = rr * 64 + cc * 2; return st * 1024 + (ob ^ (((ob >> 9) & 1) << 5)); }
__host__ __device__ __forceinline__ void stage_rc(int b, int& R, int& C) { const int st = b / 1024, sb = b % 1024, swz = sb ^ (((sb >> 9) & 1) << 5); R = (st >> 1) * 16 + swz / 64; C = (st & 1) * 32 + (swz % 64) / 2; }
__host__ __device__ __forceinline__ int perm32(int rho) { const int n = rho >> 4, i = rho & 15; return 8 * (i >> 2) + 4 * n + (i & 3); }

struct Unit { int pm, pn; };
struct Gemm { const bf16_t* A; const bf16_t* Bt; int M, N, K; };

struct StaticOrder {
    int nM, nN, nwg, G, c, rep;
    __host__ __device__ void init(int M, int N, int G_, int c_, int rep_ = 1) { nM = M / BM; nN = N / BM; nwg = nM * nN; G = G_; c = c_; rep = rep_; }
    __host__ __device__ bool next(int i, Unit& u) const {
        const long L = (long)i * G + c; if (L >= (long)nwg * rep) return false;
        int wgid = (int)(L % nwg); { const int q = nwg / NXCD, r = nwg % NXCD, xcd = wgid % NXCD, off = wgid / NXCD; wgid = (xcd < r ? xcd * (q + 1) : r * (q + 1) + (xcd - r) * q) + off; }
        const int nig = WGM * nN, gid = wgid / nig, fm = gid * WGM, gsz = (nM - fm) < WGM ? (nM - fm) : WGM;
        u.pm = fm + ((wgid % nig) % gsz); u.pn = (wgid % nig) / gsz; return true;
    }
};

template <class Epi, class Sched, bool ALIGN_EPI>
__device__ __forceinline__ void gemm_phase(LAS unsigned char* lds, const Gemm g, const Sched& S, const Epi& E) {
    const int tid = threadIdx.x, wid = __builtin_amdgcn_readfirstlane(tid >> 6), lane = tid & 63, wr = wid >> 2, wc = wid & 3, fr = lane & 15, fq = lane >> 4;
    const int K = g.K, nt = K / BK;
    unsigned voffA[2], voffB[2];
#pragma unroll
    for (int i = 0; i < 2; ++i) { int R, C; stage_rc(tid * 16 + i * 8192, R, C); const int Rb = Epi::PERM ? ((R & ~31) + perm32(R & 31)) : R;
        voffA[i] = (unsigned)(R * K + C) * 2u; voffB[i] = (unsigned)(Rb * K + C) * 2u; }
    const size_t kstep = (size_t)(BK * 2);
    const size_t hstep = (size_t)HALF * K * 2;
    const size_t tstep = 2 * hstep;
    const unsigned ldsw = (unsigned)wid * 1024u;
    const int aoff = lds_byte(wr * 64 + fr, fq * 8), boff = lds_byte(wc * 32 + fr, fq * 8);
#define PG8_SA(b, h) (((b) * 2 + (h)) * HTB)
#define PG8_SB(b, h) ((4 + (b) * 2 + (h)) * HTB)
#define PG8_STAGE(bufoff, gbase, voff) do { _Pragma("unroll") for (int _i = 0; _i < 2; ++_i) \
        __builtin_amdgcn_global_load_lds((const unsigned*)((const char*)(gbase) + (voff)[_i]), (LAS unsigned*)(lds + (bufoff) + ldsw + _i * 8192), 16, 0, 0); } while (0)
#define PG8_LDA(dst, b, h) do { _Pragma("unroll") for (int m = 0; m < 4; ++m) _Pragma("unroll") for (int k = 0; k < 2; ++k) dst[m][k] = *(const LAS bf16x8*)(lds + PG8_SA(b, h) + aoff + m * 2048 + k * 1024); } while (0)
#define PG8_LDB(dst, b, h) do { _Pragma("unroll") for (int n = 0; n < 2; ++n) _Pragma("unroll") for (int k = 0; k < 2; ++k) dst[n][k] = *(const LAS bf16x8*)(lds + PG8_SB(b, h) + boff + n * 2048 + k * 1024); } while (0)
#define PG8_MMA(ai, bj, At, Bt) do { __builtin_amdgcn_s_setprio(1); _Pragma("unroll") for (int m = 0; m < 4; ++m) _Pragma("unroll") for (int n = 0; n < 2; ++n) _Pragma("unroll") for (int k = 0; k < 2; ++k) \
        acc[ai][bj][m][n] = __builtin_amdgcn_mfma_f32_16x16x32_bf16(Bt[n][k], At[m][k], acc[ai][bj][m][n], 0, 0, 0); __builtin_amdgcn_s_setprio(0); } while (0)
#define PG8_WAIT_V(n) asm volatile("s_waitcnt vmcnt(" #n ")" ::: "memory")
#define PG8_WAIT_L(n) asm volatile("s_waitcnt lgkmcnt(" #n ")" ::: "memory")
#define PG8_BAR __builtin_amdgcn_s_barrier()
#define PG8_SCHED __builtin_amdgcn_sched_barrier(0)
    Unit cur, nxt; int ui = 0;
    if (!S.next(0, cur)) return;
    f32x4 acc[2][2][4][2];
#pragma unroll
    for (int a = 0; a < 2; ++a)
#pragma unroll
        for (int b = 0; b < 2; ++b)
#pragma unroll
            for (int m = 0; m < 4; ++m)
#pragma unroll
                for (int n = 0; n < 2; ++n) acc[a][b][m][n] = (f32x4){0.f, 0.f, 0.f, 0.f};
    bf16x8 At[4][2], B0[2][2], B1[2][2];
    const char* cA = (const char*)g.A + (size_t)cur.pm * tstep; const char* cB = (const char*)g.Bt + (size_t)cur.pn * tstep;
    PG8_STAGE(PG8_SB(0, 0), cB, voffB); PG8_STAGE(PG8_SB(0, 1), cB + hstep, voffB); PG8_STAGE(PG8_SA(0, 0), cA, voffA); PG8_STAGE(PG8_SA(0, 1), cA + hstep, voffA);
    if (wr == 1) PG8_BAR;
    PG8_WAIT_V(2); PG8_BAR;
    PG8_STAGE(PG8_SB(1, 0), cB + kstep, voffB); PG8_STAGE(PG8_SA(1, 0), cA + kstep, voffA); PG8_STAGE(PG8_SB(1, 1), cB + hstep + kstep, voffB);
    PG8_WAIT_V(6); PG8_BAR;
    for (;;) {
        const bool has_next = S.next(ui + 1, nxt);
        const char* nA = has_next ? (const char*)g.A + (size_t)nxt.pm * tstep : cA; const char* nB = has_next ? (const char*)g.Bt + (size_t)nxt.pn * tstep : cB;
        for (int t = 0; t < nt; t += 2) {
            const bool last = (t == nt - 2);
            const char* a1 = cA + (size_t)(t + 1) * kstep;
            const char* a2 = last ? nA : cA + (size_t)(t + 2) * kstep; const char* b2 = last ? nB : cB + (size_t)(t + 2) * kstep;
            const char* a3 = a2 + kstep; const char* b3 = b2 + kstep;
            if constexpr (Epi::MIDK > 0) { if (t == Epi::MIDK) E.mid(acc, ui, wr, fr); }
            PG8_LDB(B0, 0, 0); PG8_LDB(B1, 0, 1); PG8_SCHED; PG8_LDA(At, 0, 0); PG8_STAGE(PG8_SA(1, 1), a1 + hstep, voffA);
            PG8_WAIT_V(8); PG8_WAIT_L(0); PG8_BAR; PG8_MMA(0, 0, At, B0); PG8_MMA(0, 1, At, B1); PG8_BAR; PG8_SCHED;
            PG8_LDA(At, 0, 1); PG8_STAGE(PG8_SB(0, 0), b2, voffB); PG8_STAGE(PG8_SB(0, 1), b2 + hstep, voffB); PG8_STAGE(PG8_SA(0, 0), a2, voffA);
            PG8_WAIT_V(8); PG8_WAIT_L(0); PG8_BAR; PG8_MMA(1, 0, At, B0); PG8_MMA(1, 1, At, B1); PG8_BAR; PG8_SCHED;
            PG8_LDB(B0, 1, 0); PG8_LDB(B1, 1, 1); PG8_SCHED; PG8_LDA(At, 1, 0); PG8_STAGE(PG8_SA(0, 1), a2 + hstep, voffA);
            PG8_WAIT_V(8); PG8_WAIT_L(0); PG8_BAR; PG8_MMA(0, 0, At, B0); PG8_MMA(0, 1, At, B1); PG8_BAR; PG8_SCHED;
            PG8_LDA(At, 1, 1); PG8_STAGE(PG8_SB(1, 0), b3, voffB); PG8_STAGE(PG8_SB(1, 1), b3 + hstep, voffB); PG8_STAGE(PG8_SA(1, 0), a3, voffA);
            PG8_WAIT_V(8); PG8_WAIT_L(0); PG8_BAR; PG8_MMA(1, 0, At, B0); PG8_MMA(1, 1, At, B1); PG8_BAR; PG8_SCHED;
        }
        if constexpr (ALIGN_EPI) { if (wr == 0) PG8_BAR; }
        E(acc, cur, ui, wr, wc, fr, fq);
        if (!has_next) break;
#pragma unroll
        for (int a = 0; a < 2; ++a)
#pragma unroll
            for (int b = 0; b < 2; ++b)
#pragma unroll
                for (int m = 0; m < 4; ++m)
#pragma unroll
                    for (int n = 0; n < 2; ++n) acc[a][b][m][n] = (f32x4){0.f, 0.f, 0.f, 0.f};
        cur = nxt; cA = nA; cB = nB; ++ui;
        if constexpr (ALIGN_EPI) { if (wr == 1) PG8_BAR; }
    }
    PG8_WAIT_V(0);
    if constexpr (!ALIGN_EPI) { if (wr == 0) PG8_BAR; }
    PG8_BAR;
#undef PG8_SA
#undef PG8_SB
#undef PG8_STAGE
#undef PG8_LDA
#undef PG8_LDB
#undef PG8_MMA
#undef PG8_WAIT_V
#undef PG8_WAIT_L
#undef PG8_BAR
#undef PG8_SCHED
}
}

struct EpiZ {
    static constexpr bool PERM = true; static constexpr int MIDK = 0;
    bf16_t* Z; const float* cs; const float* sn;
    __device__ __forceinline__ void mid(f32x4 (&acc)[2][2][4][2], int ui, int wr, int fr) const {}
    __device__ __forceinline__ void operator()(const f32x4 (&acc)[2][2][4][2], const pg8::Unit& u, int ui, int wr, int wc, int fr, int fq) const {
        const int row0 = u.pm * 256 + wr * 64 + fr, col0 = u.pn * 256 + wc * 32 + 8 * fq, pn = u.pn;
        const int mode = (pn <= 4) ? 2 : (pn == 5 ? 0 : (pn <= 9 ? 1 : (pn <= 13 ? 0 : 1)));
        const bool rope = (mode == 2) && ((wc & 1) == 0);
        const float sc = (pn <= 3) ? C2 : 1.f;
        const float sgn = (fq == 0) ? -1.f : 1.f;
#pragma unroll
        for (int ai = 0; ai < 2; ++ai)
#pragma unroll
            for (int m = 0; m < 4; ++m) {
                const int row = row0 + ai * 128 + m * 16;
                bf16_t* rowp = Z + (size_t)row * NIN + col0;
                f32x4 c0 = {1.f, 1.f, 1.f, 1.f}, c1 = c0, s0 = {0.f, 0.f, 0.f, 0.f}, s1 = s0;
                if (rope && fq < 2) { const int pos = row & (SEQ - 1); c0 = *(const f32x4*)(cs + pos * 8); c1 = *(const f32x4*)(cs + pos * 8 + 4); s0 = *(const f32x4*)(sn + pos * 8) * sgn; s1 = *(const f32x4*)(sn + pos * 8 + 4) * sgn; }
#pragma unroll
                for (int bj = 0; bj < 2; ++bj) {
                    f32x4 v0 = acc[ai][bj][m][0], v1 = acc[ai][bj][m][1];
                    if (rope) {
                        f32x4 p0, p1;
#pragma unroll
                        for (int k = 0; k < 4; ++k) { p0[k] = __shfl_xor(v0[k], 16); p1[k] = __shfl_xor(v1[k], 16); }
                        v0 = v0 * c0 + p0 * s0; v1 = v1 * c1 + p1 * s1;
                    } else if (mode == 1) {
#pragma unroll
                        for (int k = 0; k < 4; ++k) { v0[k] = v0[k] * fast_sigmoid(v0[k]); v1[k] = v1[k] * fast_sigmoid(v1[k]); }
                    }
                    v0 = v0 * sc; v1 = v1 * sc;
                    u32x4 w; w.x = cvt_pk_bf16(v0[0], v0[1]); w.y = cvt_pk_bf16(v0[2], v0[3]); w.z = cvt_pk_bf16(v1[0], v1[1]); w.w = cvt_pk_bf16(v1[2], v1[3]);
                    *(u32x4*)(rowp + bj * 128) = w;
                }
            }
    }
};

struct EpiOut {
    static constexpr bool PERM = false; static constexpr int MIDK = 16;
    const float* x; float* out; float* pss; LAS const f32x2* RS;
    __device__ __forceinline__ void mid(f32x4 (&acc)[2][2][4][2], int ui, int wr, int fr) const {
#pragma unroll
        for (int ai = 0; ai < 2; ++ai)
#pragma unroll
            for (int m = 0; m < 4; ++m) { const float ratio = RS[(ui & 3) * 256 + ai * 128 + wr * 64 + m * 16 + fr].x;
#pragma unroll
                for (int bj = 0; bj < 2; ++bj)
#pragma unroll
                    for (int n = 0; n < 2; ++n) acc[ai][bj][m][n] = acc[ai][bj][m][n] * ratio; }
    }
    __device__ __forceinline__ void operator()(const f32x4 (&acc)[2][2][4][2], const pg8::Unit& u, int ui, int wr, int wc, int fr, int fq) const {
        const int col0 = u.pn * 256 + wc * 32 + 4 * fq;
#pragma unroll
        for (int ai = 0; ai < 2; ++ai)
#pragma unroll
            for (int m = 0; m < 4; ++m) {
                const int lr = ai * 128 + wr * 64 + m * 16 + fr; const float rB = RS[(ui & 3) * 256 + lr].y;
                const size_t off = (size_t)(u.pm * 256 + lr) * DM + col0; float ss = 0.f;
#pragma unroll
                for (int bj = 0; bj < 2; ++bj)
#pragma unroll
                    for (int n = 0; n < 2; ++n) { const f32x4 xb = *(const f32x4*)(x + off + bj * 128 + n * 16); const f32x4 o = xb + acc[ai][bj][m][n] * rB;
                        ss += (o[0] * o[0] + o[1] * o[1]) + (o[2] * o[2] + o[3] * o[3]); *(f32x4*)(out + off + bj * 128 + n * 16) = o; }
                ss += __shfl_xor(ss, 16); ss += __shfl_xor(ss, 32);
                if (fq == 0) pss[(size_t)(u.pm * 256 + lr) * 16 + u.pn * 4 + wc] = ss;
            }
    }
};

struct EpiOutF {
    static constexpr bool PERM = false; static constexpr int MIDK = 16;
    const float* x; float* out; const float* fg; float* xbuf; unsigned* cnt; LAS const f32x2* RS; LAS float* PP; LAS float* SS;
    __device__ __forceinline__ void mid(f32x4 (&acc)[2][2][4][2], int ui, int wr, int fr) const {
#pragma unroll
        for (int ai = 0; ai < 2; ++ai)
#pragma unroll
            for (int m = 0; m < 4; ++m) { const float ratio = RS[(ui & 3) * 256 + ai * 128 + wr * 64 + m * 16 + fr].x;
#pragma unroll
                for (int bj = 0; bj < 2; ++bj)
#pragma unroll
                    for (int n = 0; n < 2; ++n) acc[ai][bj][m][n] = acc[ai][bj][m][n] * ratio; }
    }
    __device__ __forceinline__ void operator()(f32x4 (&acc)[2][2][4][2], const pg8::Unit& u, int ui, int wr, int wc, int fr, int fq) const {
        const int tid = threadIdx.x, lane = tid & 63, wid = __builtin_amdgcn_readfirstlane(tid >> 6);
        const int col0 = u.pn * 256 + wc * 32 + 4 * fq;
#pragma unroll
        for (int ai = 0; ai < 2; ++ai)
#pragma unroll
            for (int m = 0; m < 4; ++m) {
                const int lr = ai * 128 + wr * 64 + m * 16 + fr; const float rB = RS[(ui & 3) * 256 + lr].y;
                const size_t off = (size_t)(u.pm * 256 + lr) * DM + col0; float ss = 0.f;
#pragma unroll
                for (int bj = 0; bj < 2; ++bj)
#pragma unroll
                    for (int n = 0; n < 2; ++n) { const f32x4 xb = *(const f32x4*)(x + off + bj * 128 + n * 16); const f32x4 o = xb + acc[ai][bj][m][n] * rB;
                        ss += (o[0] * o[0] + o[1] * o[1]) + (o[2] * o[2] + o[3] * o[3]); acc[ai][bj][m][n] = o; }
                ss += __shfl_xor(ss, 16); ss += __shfl_xor(ss, 32);
                if (fq == 0) PP[lr * 4 + wc] = ss;
            }
        asm volatile("s_waitcnt lgkmcnt(0)" ::: "memory"); __builtin_amdgcn_s_barrier(); asm volatile("" ::: "memory");
        unsigned* pc = cnt + 64 * u.pm;
        if (tid < 256) { const f32x4 pp = *(const LAS f32x4*)(PP + tid * 4); const float tp = (pp[0] + pp[1]) + (pp[2] + pp[3]);
            __hip_atomic_store(xbuf + (size_t)(u.pm * 256 + tid) * 4 + u.pn, tp, __ATOMIC_RELAXED, __HIP_MEMORY_SCOPE_AGENT); }
        asm volatile("s_waitcnt vmcnt(0)" ::: "memory");
        if (tid < 256 && lane == 0) __hip_atomic_fetch_add(pc, 1u, __ATOMIC_RELAXED, __HIP_MEMORY_SCOPE_AGENT);
        if (wid == 0) {
            unsigned sp = 0;
            while ((unsigned)__builtin_amdgcn_readfirstlane(__hip_atomic_load(pc, __ATOMIC_RELAXED, __HIP_MEMORY_SCOPE_AGENT)) < 16u) { __builtin_amdgcn_s_sleep(2); if (++sp > (1u << 22)) break; }
            __builtin_amdgcn_fence(__ATOMIC_ACQUIRE, "agent");
        }
        asm volatile("s_waitcnt vmcnt(0) lgkmcnt(0)" ::: "memory"); __builtin_amdgcn_s_barrier(); asm volatile("" ::: "memory");
        if (tid < 256) { const float* slot = xbuf + (size_t)(u.pm * 256 + tid) * 4; float q = 0.f;
#pragma unroll
            for (int t = 0; t < 4; ++t) q += __hip_atomic_load(slot + t, __ATOMIC_RELAXED, __HIP_MEMORY_SCOPE_AGENT);
            SS[tid] = 1.0f / sqrtf(q * (1.f / DM) + EPS); }
        asm volatile("s_waitcnt lgkmcnt(0)" ::: "memory"); __builtin_amdgcn_s_barrier(); asm volatile("" ::: "memory");
        f32x4 gv[2][2];
#pragma unroll
        for (int bj = 0; bj < 2; ++bj)
#pragma unroll
            for (int n = 0; n < 2; ++n) gv[bj][n] = *(const f32x4*)(fg + col0 + bj * 128 + n * 16);
#pragma unroll
        for (int ai = 0; ai < 2; ++ai)
#pragma unroll
            for (int m = 0; m < 4; ++m) {
                const int lr = ai * 128 + wr * 64 + m * 16 + fr; const float rs = SS[lr];
                const size_t off = (size_t)(u.pm * 256 + lr) * DM + col0;
#pragma unroll
                for (int bj = 0; bj < 2; ++bj)
#pragma unroll
                    for (int n = 0; n < 2; ++n) *(f32x4*)(out + off + bj * 128 + n * 16) = acc[ai][bj][m][n] * rs * gv[bj][n];
            }
        asm volatile("s_waitcnt lgkmcnt(0)" ::: "memory"); __builtin_amdgcn_s_barrier(); asm volatile("" ::: "memory");
    }
};

__device__ __forceinline__ float wave_sum(float v) {
#pragma unroll
    for (int o = 1; o < 64; o <<= 1) v += __shfl_xor(v, o);
    return v;
}
__device__ __forceinline__ void p0_transpose_item(const float* W, int K, int N, bf16_t* WT, const float* kscale, LAS float* scr, int item, int lane) {
    const int nblk = N / 32, kb = item / nblk, nb = item % nblk, k0 = 64 * kb, n0 = 32 * nb;
#pragma unroll
    for (int i = 0; i < 32; ++i) { const int kk = 2 * i + (lane >> 5); float v = W[(size_t)(k0 + kk) * N + n0 + (lane & 31)]; if (kscale) v *= kscale[k0 + kk]; scr[kk * 33 + (lane & 31)] = v; }
    asm volatile("s_waitcnt lgkmcnt(0)" ::: "memory");
    const int c = lane & 7;
#pragma unroll
    for (int j = 0; j < 4; ++j) { const int n = (lane >> 3) + 8 * j; const LAS float* s = scr + (8 * c) * 33 + n;
        u32x4 o; o.x = pk2(s[0 * 33], s[1 * 33]); o.y = pk2(s[2 * 33], s[3 * 33]); o.z = pk2(s[4 * 33], s[5 * 33]); o.w = pk2(s[6 * 33], s[7 * 33]);
        *(u32x4*)(WT + (size_t)(n0 + n) * K + k0 + 8 * c) = o; }
    asm volatile("s_waitcnt lgkmcnt(0)" ::: "memory");
}
__device__ __forceinline__ void sincos_d(double xx, double& s, double& c) {
    const double kq = rint(xx * 0.63661977236758134308);
    double r = fma(-kq, 1.57079632679489655800e+00, xx); r = fma(-kq, 6.12323399573676603587e-17, r);
    const int q = ((int)kq) & 3; const double r2 = r * r;
    const double sp = r * (1.0 + r2 * (-1.0 / 6.0 + r2 * (1.0 / 120.0 + r2 * (-1.0 / 5040.0 + r2 * (1.0 / 362880.0 + r2 * (-1.0 / 39916800.0 + r2 * (1.0 / 6227020800.0 + r2 * (-1.0 / 1307674368000.0))))))));
    const double cp = 1.0 + r2 * (-0.5 + r2 * (1.0 / 24.0 + r2 * (-1.0 / 720.0 + r2 * (1.0 / 40320.0 + r2 * (-1.0 / 3628800.0 + r2 * (1.0 / 479001600.0 + r2 * (-1.0 / 87178291200.0 + r2 * (1.0 / 20922789888000.0))))))));
    s = (q == 0) ? sp : (q == 1) ? cp : (q == 2) ? -sp : -cp;
    c = (q == 0) ? cp : (q == 1) ? -sp : (q == 2) ? -cp : sp;
}

namespace att {
constexpr int KV_ROWS = 192, RS = 144;
constexpr int L_K = 0, L_V = KV_ROWS * RS, L_STG = 2 * KV_ROWS * RS, STG_RS = 272, STG_W = 32 * STG_RS, L_LW = L_STG + 8 * STG_W, L_END = L_LW + 8 * 128;
static_assert(L_END <= RING_BYTES, "attention LDS");
__device__ __forceinline__ int crow(int i, int h) { return (i & 3) + 8 * (i >> 2) + 4 * h; }
__device__ __forceinline__ s16x4 vtr(LAS const unsigned char* p) { return __builtin_bit_cast(s16x4, __builtin_amdgcn_ds_read_tr16_b64_v4i16((LAS s16x4*)p)); }

constexpr int NUNITS = NB * 4 * 64;
__device__ __forceinline__ void load_kvq(u32x4 (&kreg)[3], u32x4 (&vreg)[3], bf16x8 (&qr)[4], const bf16_t* __restrict__ z, int u, int tid, int wid, int r, int h) {
    const int b = u >> 8, kvh = (u >> 6) & 3, q0 = (u & 63) * 64; const size_t rowbase = (size_t)b * SEQ;
    const int head = kvh * 4 + (wid >> 1), qs = q0 + 32 * (wid & 1);
#pragma unroll
    for (int i = 0; i < 3; ++i) { const int pidx = tid + 512 * i, row = pidx >> 3, ch = pidx & 7, pos = q0 - 128 + row;
        if (pos >= 0) { const bf16_t* src = z + (rowbase + pos) * NIN + COL_K + kvh * 64 + ch * 8; kreg[i] = *(const u32x4*)src; vreg[i] = *(const u32x4*)(src + 256); }
        else { kreg[i] = (u32x4){0u, 0u, 0u, 0u}; vreg[i] = (u32x4){0u, 0u, 0u, 0u}; } }
#pragma unroll
    for (int d0 = 0; d0 < 4; ++d0) qr[d0] = *(const bf16x8*)(z + (rowbase + qs + r) * NIN + COL_Q + head * 64 + d0 * 16 + h * 8);
}

__device__ __forceinline__ void run(LAS unsigned char* lds, const bf16_t* __restrict__ z, bf16_t* __restrict__ y, float* __restrict__ ssq, const float* __restrict__ sinks, unsigned* ctr, LAS int* ubox) {
    const int tid = threadIdx.x, lane = tid & 63, r = lane & 31, h = lane >> 5, wid = __builtin_amdgcn_readfirstlane(tid >> 6);
    if (tid == 0) ubox[0] = (int)atomicAdd(ctr, 1u);
    __syncthreads();
    int u = ubox[0];
    if (u >= NUNITS) return;
    u32x4 kreg[3], vreg[3]; bf16x8 qn[4];
    load_kvq(kreg, vreg, qn, z, u, tid, wid, r, h);
    if (tid == 0) ubox[1] = (int)atomicAdd(ctr, 1u);
    for (int n = 0;; ++n) {
        const int b = u >> 8, kvh = (u >> 6) & 3, q0 = (u & 63) * 64; const size_t rowbase = (size_t)b * SEQ;
        const int head = kvh * 4 + (wid >> 1), qs = q0 + 32 * (wid & 1);
        bf16x8 qr[4];
#pragma unroll
        for (int d0 = 0; d0 < 4; ++d0) qr[d0] = qn[d0];
#pragma unroll
        for (int i = 0; i < 3; ++i) { const int pidx = tid + 512 * i, row = pidx >> 3, ch = pidx & 7;
            *(LAS u32x4*)(lds + L_K + row * RS + ch * 16) = kreg[i]; *(LAS u32x4*)(lds + L_V + row * RS + ch * 16) = vreg[i]; }
        __syncthreads();
        const int un = ubox[(n + 1) & 1];
        if (un < NUNITS) load_kvq(kreg, vreg, qn, z, un, tid, wid, r, h);
        unsigned nxt2 = 0u;
        if (tid == 0) nxt2 = atomicAdd(ctr, 1u);
        u32x4 gv[4];
#pragma unroll
        for (int it = 0; it < 4; ++it) gv[it] = *(const u32x4*)(z + (rowbase + qs + it * 8 + (lane >> 3)) * NIN + COL_GA + head * 64 + (lane & 7) * 8);
        f32x16 s[5];
        const LAS unsigned char* kb = lds + L_K + (32 * (wid & 1) + r) * RS + h * 16;
#pragma unroll
        for (int c = 0; c < 5; ++c) { f32x16 a = {0.f, 0.f, 0.f, 0.f, 0.f, 0.f, 0.f, 0.f, 0.f, 0.f, 0.f, 0.f, 0.f, 0.f, 0.f, 0.f};
#pragma unroll
            for (int d0 = 0; d0 < 4; ++d0) { const bf16x8 kf = *(const LAS bf16x8*)(kb + c * 32 * RS + d0 * 32); a = __builtin_amdgcn_mfma_f32_32x32x16_bf16(kf, qr[d0], a, 0, 0, 0); }
            s[c] = a; }
        const float sink2 = sinks[head] * LOG2E;
        float mx = -1e30f;
        if (q0 < 128) {
#pragma unroll
            for (int c = 0; c < 5; ++c)
#pragma unroll
                for (int i = 0; i < 16; ++i) { const int cr = crow(i, h), diff = 128 - 32 * c + r - cr, kp = qs - 128 + 32 * c + cr;
                    const bool valid = (diff >= 0) && (diff < 128) && (kp >= 0); const float v = valid ? s[c][i] : -1e30f; s[c][i] = v; mx = fmaxf(mx, v); }
        } else {
#pragma unroll
            for (int i = 0; i < 16; ++i) { const int cr = crow(i, h); const float v0 = (cr > r) ? s[0][i] : -1e30f, v4 = (cr <= r) ? s[4][i] : -1e30f; s[0][i] = v0; s[4][i] = v4; mx = fmaxf(mx, fmaxf(v0, v4)); }
#pragma unroll
            for (int c = 1; c < 4; ++c)
#pragma unroll
                for (int i = 0; i < 16; ++i) mx = fmaxf(mx, s[c][i]);
        }
        mx = fmaxf(mx, __shfl_xor(mx, 32));
        const float mref = fmaxf(mx, sink2);
        float lsum = 0.f;
#pragma unroll
        for (int c = 0; c < 5; ++c)
#pragma unroll
            for (int i = 0; i < 16; ++i) { const float pv = __builtin_amdgcn_exp2f(s[c][i] - mref); s[c][i] = pv; lsum += pv; }
        lsum += __shfl_xor(lsum, 32);
        const float l = lsum + __builtin_amdgcn_exp2f(sink2 - mref);
        f32x16 o[2];
        o[0] = (f32x16){0.f, 0.f, 0.f, 0.f, 0.f, 0.f, 0.f, 0.f, 0.f, 0.f, 0.f, 0.f, 0.f, 0.f, 0.f, 0.f}; o[1] = o[0];
        const LAS unsigned char* vb = lds + L_V + (32 * (wid & 1) + 4 * h + ((lane & 15) >> 2)) * RS + ((lane >> 4) & 1) * 32 + (lane & 3) * 8;
#pragma unroll
        for (int c = 0; c < 5; ++c)
#pragma unroll
            for (int s2 = 0; s2 < 2; ++s2) {
                u32x4 pw; pw.x = cvt_pk_bf16(s[c][8 * s2 + 0], s[c][8 * s2 + 1]); pw.y = cvt_pk_bf16(s[c][8 * s2 + 2], s[c][8 * s2 + 3]); pw.z = cvt_pk_bf16(s[c][8 * s2 + 4], s[c][8 * s2 + 5]); pw.w = cvt_pk_bf16(s[c][8 * s2 + 6], s[c][8 * s2 + 7]);
                const bf16x8 pa = __builtin_bit_cast(bf16x8, pw);
#pragma unroll
                for (int dh = 0; dh < 2; ++dh) { const LAS unsigned char* ap = vb + (32 * c + 16 * s2) * RS + dh * 64;
                    const s16x4 lo = vtr(ap), hi = vtr(ap + 8 * RS);
                    const bf16x8 vf = __builtin_shufflevector(lo, hi, 0, 1, 2, 3, 4, 5, 6, 7);
                    o[dh] = __builtin_amdgcn_mfma_f32_32x32x16_bf16(pa, vf, o[dh], 0, 0, 0); }
            }
        LAS float* lw = (LAS float*)(lds + L_LW + wid * 128);
        if (h == 0) lw[r] = l;
        LAS unsigned char* stg = lds + L_STG + wid * STG_W;
#pragma unroll
        for (int i = 0; i < 16; ++i) { const int cr = crow(i, h); const float rl = __builtin_amdgcn_rcpf(lw[cr]);
            *(LAS float*)(stg + cr * STG_RS + r * 4) = o[0][i] * rl; *(LAS float*)(stg + cr * STG_RS + (32 + r) * 4) = o[1][i] * rl; }
#pragma unroll
        for (int it = 0; it < 4; ++it) { const int row = it * 8 + (lane >> 3), ch = lane & 7;
            const f32x4 a0 = *(const LAS f32x4*)(stg + row * STG_RS + ch * 32), a1 = *(const LAS f32x4*)(stg + row * STG_RS + ch * 32 + 16);
            const size_t grow = rowbase + qs + row;
            const u32x4 g = gv[it];
            const float g0 = bf_lo(g.x), g1 = bf_hi(g.x), g2 = bf_lo(g.y), g3 = bf_hi(g.y), g4 = bf_lo(g.z), g5 = bf_hi(g.z), g6 = bf_lo(g.w), g7 = bf_hi(g.w);
            const float y0 = a0[0] * g0, y1 = a0[1] * g1, y2 = a0[2] * g2, y3 = a0[3] * g3;
            const float y4 = a1[0] * g4, y5 = a1[1] * g5, y6 = a1[2] * g6, y7 = a1[3] * g7;
            float ss = (y0 * y0 + y1 * y1) + (y2 * y2 + y3 * y3) + (y4 * y4 + y5 * y5) + (y6 * y6 + y7 * y7);
            ss += __shfl_xor(ss, 1); ss += __shfl_xor(ss, 2); ss += __shfl_xor(ss, 4);
            u32x4 w; w.x = cvt_pk_bf16(y0, y1); w.y = cvt_pk_bf16(y2, y3); w.z = cvt_pk_bf16(y4, y5); w.w = cvt_pk_bf16(y6, y7);
            *(u32x4*)(y + grow * KOUT + head * 64 + ch * 8) = w;
            if (ch == 0) ssq[grow * 16 + head] = ss; }
        if (tid == 0) ubox[n & 1] = (int)nxt2;
        __syncthreads();
        u = un;
        if (u >= NUNITS) break;
    }
}
}

namespace lru {
constexpr int L_CW = 0, L_WT = 2048, L_STG = L_WT + 8192, STG_RS = 272, STG_W = 16 * STG_RS, L_END = L_STG + 8 * STG_W;
static_assert(L_END <= RING_BYTES, "lru LDS");
constexpr int NCH = SEQ / 128;

template <bool FIRST> __device__ __forceinline__ void load_x(u32x4 (&xv)[4][2], const bf16_t* __restrict__ z, size_t rowbase, int tok, int cbase) {
#pragma unroll
    for (int tap = 0; tap < 4; ++tap) { const int pos = tok - 3 + tap, posc = (FIRST && pos < 0) ? 0 : pos;
#pragma unroll
        for (int ks = 0; ks < 2; ++ks) xv[tap][ks] = *(const u32x4*)(z + (rowbase + posc) * NIN + cbase + 32 * ks); }
    if (FIRST) {
#pragma unroll
        for (int tap = 0; tap < 3; ++tap) if (tok - 3 + tap < 0) { xv[tap][0] = (u32x4){0u, 0u, 0u, 0u}; xv[tap][1] = (u32x4){0u, 0u, 0u, 0u}; }
    }
}

template <bool PAIRED>
__device__ __forceinline__ void unit(LAS unsigned char* lds, const bf16_t* __restrict__ z, bf16_t* __restrict__ y, float* __restrict__ ssq,
                                     const float* __restrict__ conv_w, const float* __restrict__ conv_b, const float* __restrict__ w_r, const float* __restrict__ b_r,
                                     const float* __restrict__ w_i, const float* __restrict__ b_i, const float* __restrict__ lam, int b, int blk,
                                     int half, unsigned* myseq, unsigned* pseq, float* mydata, float* pdata) {
    constexpr int STEP = PAIRED ? 2 : 1, NIT = NCH / STEP;
    const int tid = threadIdx.x, lane = tid & 63, fr = lane & 15, fq = lane >> 4, wid = __builtin_amdgcn_readfirstlane(tid >> 6);
    const size_t rowbase = (size_t)b * SEQ;
    LAS float* cw = (LAS float*)(lds + L_CW);
    if (tid < 320) { const int tap = tid >> 6, c = tid & 63; cw[tid] = (tap < 4) ? conv_w[tap * 1024 + blk * 64 + c] : conv_b[blk * 64 + c]; }
    bf16x8 bfr[2][4], bfi[2][4];
#pragma unroll
    for (int ks = 0; ks < 2; ++ks)
#pragma unroll
        for (int nt = 0; nt < 4; ++nt) {
            u32x4 wr_, wi_; unsigned* pr = (unsigned*)&wr_; unsigned* pi = (unsigned*)&wi_;
#pragma unroll
            for (int j = 0; j < 8; j += 2) { const size_t o0 = ((size_t)blk * 64 + 8 * fq + j + 32 * ks) * 64 + fr + 16 * nt;
                pr[j >> 1] = pk2(w_r[o0], w_r[o0 + 64]); pi[j >> 1] = pk2(w_i[o0], w_i[o0 + 64]); }
            bfr[ks][nt] = __builtin_bit_cast(bf16x8, wr_); bfi[ks][nt] = __builtin_bit_cast(bf16x8, wi_);
        }
    float nbr[4], nbi[4], sp[4], carry[4], Aown[4], Hown[4];
#pragma unroll
    for (int nt = 0; nt < 4; ++nt) { const int c = blk * 64 + fr + 16 * nt; nbr[nt] = -b_r[c] * LOG2E; nbi[nt] = -b_i[c] * LOG2E; sp[nt] = -8.0f * log1pf(expf(-lam[c])) * LOG2E; carry[nt] = 0.f; Aown[nt] = 1.f; Hown[nt] = 0.f; }
    __syncthreads();
    const int cbaseA = COL_XL + blk * 64 + 8 * fq;
    LAS unsigned char* stg = lds + L_STG + wid * STG_W;
    u32x4 xn[4][2], gn[2];
    if (wid == 0 && half == 0) load_x<true>(xn, z, rowbase, fr, cbaseA); else load_x<false>(xn, z, rowbase, 128 * half + 16 * wid + fr, cbaseA);
    const bf16_t* gbase = z + (rowbase + 128 * half + 16 * wid + (lane >> 3)) * NIN + COL_GL + blk * 64 + (lane & 7) * 8;
    gn[0] = *(const u32x4*)gbase; gn[1] = *(const u32x4*)(gbase + (size_t)8 * NIN);
    for (int kk = 0; kk < NIT; ++kk) {
        asm volatile("" ::: "memory");
        const int k = half + STEP * kk;
        const int tw = 128 * k + 16 * wid;
        bf16x8 uA[2];
#pragma unroll
        for (int ks = 0; ks < 2; ++ks) {
            float u[8];
            { const f32x4 b0 = *(const LAS f32x4*)(cw + 4 * 64 + 32 * ks + 8 * fq), b1 = *(const LAS f32x4*)(cw + 4 * 64 + 32 * ks + 8 * fq + 4);
              u[0] = b0[0]; u[1] = b0[1]; u[2] = b0[2]; u[3] = b0[3]; u[4] = b1[0]; u[5] = b1[1]; u[6] = b1[2]; u[7] = b1[3]; }
#pragma unroll
            for (int tap = 0; tap < 4; ++tap) { const f32x4 w0 = *(const LAS f32x4*)(cw + tap * 64 + 32 * ks + 8 * fq), w1 = *(const LAS f32x4*)(cw + tap * 64 + 32 * ks + 8 * fq + 4); const u32x4 xx = xn[tap][ks];
                u[0] += w0[0] * bf_lo(xx.x); u[1] += w0[1] * bf_hi(xx.x); u[2] += w0[2] * bf_lo(xx.y); u[3] += w0[3] * bf_hi(xx.y);
                u[4] += w1[0] * bf_lo(xx.z); u[5] += w1[1] * bf_hi(xx.z); u[6] += w1[2] * bf_lo(xx.w); u[7] += w1[3] * bf_hi(xx.w); }
            u32x4 pw; pw.x = cvt_pk_bf16(u[0], u[1]); pw.y = cvt_pk_bf16(u[2], u[3]); pw.z = cvt_pk_bf16(u[4], u[5]); pw.w = cvt_pk_bf16(u[6], u[7]);
            uA[ks] = __builtin_bit_cast(bf16x8, pw);
            *(LAS f32x4*)(stg + fr * STG_RS + (32 * ks + 8 * fq) * 4) = (f32x4){u[0], u[1], u[2], u[3]};
            *(LAS f32x4*)(stg + fr * STG_RS + (32 * ks + 8 * fq) * 4 + 16) = (f32x4){u[4], u[5], u[6], u[7]};
        }
        const u32x4 gc0 = gn[0], gc1 = gn[1];
        if (kk + 1 < NIT) { load_x<false>(xn, z, rowbase, tw + 128 * STEP + fr, cbaseA); const bf16_t* gp = gbase + (size_t)(128 * STEP * (kk + 1)) * NIN; gn[0] = *(const u32x4*)gp; gn[1] = *(const u32x4*)(gp + (size_t)8 * NIN); }
        unsigned long long ev[4] = {0ull, 0ull, 0ull, 0ull};
        if constexpr (PAIRED) { if (k > 0) { const unsigned need0 = half ? (unsigned)(kk + 1) : (unsigned)kk; const unsigned long long* pd0 = (const unsigned long long*)pdata + ((need0 - 1u) & 3u) * 64 + fr;
#pragma unroll
            for (int nt = 0; nt < 4; ++nt) ev[nt] = __hip_atomic_load(pd0 + nt * 16, __ATOMIC_RELAXED, __HIP_MEMORY_SCOPE_AGENT); } }
        float Al[4][4], Hl[4][4], At_[4], Ht_[4];
#pragma unroll
        for (int nt = 0; nt < 4; ++nt) {
            f32x4 R = {0.f, 0.f, 0.f, 0.f}, I = R;
            R = __builtin_amdgcn_mfma_f32_16x16x32_bf16(uA[0], bfr[0][nt], R, 0, 0, 0); R = __builtin_amdgcn_mfma_f32_16x16x32_bf16(uA[1], bfr[1][nt], R, 0, 0, 0);
            I = __builtin_amdgcn_mfma_f32_16x16x32_bf16(uA[0], bfi[0][nt], I, 0, 0, 0); I = __builtin_amdgcn_mfma_f32_16x16x32_bf16(uA[1], bfi[1][nt], I, 0, 0, 0);
            float A = 1.f, H = 0.f;
#pragma unroll
            for (int ip = 0; ip < 2; ++ip) {
                const f32x2 uc = {*(const LAS float*)(stg + (4 * fq + 2 * ip) * STG_RS + (fr + 16 * nt) * 4), *(const LAS float*)(stg + (4 * fq + 2 * ip + 1) * STG_RS + (fr + 16 * nt) * 4)};
                const f32x2 R2 = {R[2 * ip], R[2 * ip + 1]}, I2 = {I[2 * ip], I[2 * ip + 1]};
                const f32x2 t1 = R2 * (-LOG2E) + nbr[nt], t2 = I2 * (-LOG2E) + nbi[nt];
                f32x2 d1 = {__builtin_amdgcn_exp2f(t1.x), __builtin_amdgcn_exp2f(t1.y)}, d2 = {__builtin_amdgcn_exp2f(t2.x), __builtin_amdgcn_exp2f(t2.y)};
                d1 = d1 + 1.0f; d2 = d2 + 1.0f;
                const f32x2 dd = d1 * d2; const f32x2 inv = {__builtin_amdgcn_rcpf(dd.x), __builtin_amdgcn_rcpf(dd.y)};
                const f32x2 rg = d2 * inv, ig = d1 * inv, la = rg * sp[nt];
                const f32x2 a = {__builtin_amdgcn_exp2f(la.x), __builtin_amdgcn_exp2f(la.y)};
                const f32x2 om = 1.0f - a * a; const f32x2 sq = {__builtin_amdgcn_sqrtf(om.x), __builtin_amdgcn_sqrtf(om.y)};
                const f32x2 bb = sq * (ig * uc);
                H = a.x * H + bb.x; A = A * a.x; Al[nt][2 * ip] = A; Hl[nt][2 * ip] = H;
                H = a.y * H + bb.y; A = A * a.y; Al[nt][2 * ip + 1] = A; Hl[nt][2 * ip + 1] = H;
            }
            float pA = __shfl_up(A, 16), pH = __shfl_up(H, 16);
            if (fq >= 1) { H = A * pH + H; A = A * pA; }
            pA = __shfl_up(A, 32); pH = __shfl_up(H, 32);
            if (fq >= 2) { H = A * pH + H; A = A * pA; }
            At_[nt] = A; Ht_[nt] = H;
            if (fq == 3) *(LAS f32x2*)(lds + L_WT + (((kk & 1) * 8 + wid) * 64 + nt * 16 + fr) * 8) = (f32x2){A, H};
        }
        __syncthreads();
        float Ap[4], Hp[4];
        if constexpr (PAIRED) {
            if (wid < 4 && k + 1 < NCH) {
                const int nt = wid; const unsigned tag = 0x11u + (unsigned)kk;
                unsigned long long* slotp = (unsigned long long*)mydata + (kk & 3) * 64 + nt * 16 + fr;
                float Ar = 1.f, Hr = 0.f;
#pragma unroll
                for (int w = 0; w < 8; ++w) { const f32x2 t = *(const LAS f32x2*)(lds + L_WT + (((kk & 1) * 8 + w) * 64 + nt * 16 + fr) * 8); Hr = t.x * Hr + t.y; Ar = Ar * t.x; }
                if (fq == 0) __hip_atomic_store(slotp, ((unsigned long long)__float_as_uint(Hr) << 32) | (unsigned long long)((__float_as_uint(Ar) & 0xffffff00u) | tag), __ATOMIC_RELAXED, __HIP_MEMORY_SCOPE_AGENT);
            }
            if (k > 0) {
                const unsigned need = half ? (unsigned)(kk + 1) : (unsigned)kk, tag = 0x10u + need; unsigned spn = 0;
                const unsigned long long* pd = (const unsigned long long*)pdata + ((need - 1u) & 3u) * 64 + fr;
                for (;;) {
                    bool ok = true;
#pragma unroll
                    for (int nt = 0; nt < 4; ++nt) ok = ok && (((unsigned)ev[nt] & 0xffu) == tag);
                    if (__all(ok) || ++spn > (1u << 20)) break;
                    __builtin_amdgcn_s_sleep(1);
#pragma unroll
                    for (int nt = 0; nt < 4; ++nt) ev[nt] = __hip_atomic_load(pd + nt * 16, __ATOMIC_RELAXED, __HIP_MEMORY_SCOPE_AGENT);
                }
#pragma unroll
                for (int nt = 0; nt < 4; ++nt) { Ap[nt] = __uint_as_float((unsigned)ev[nt] & 0xffffff00u); Hp[nt] = __uint_as_float((unsigned)(ev[nt] >> 32)); }
            } else {
#pragma unroll
                for (int nt = 0; nt < 4; ++nt) { Ap[nt] = 0.f; Hp[nt] = 0.f; }
            }
        }
#pragma unroll
        for (int nt = 0; nt < 4; ++nt) {
            float Ar = 1.f, Hr = 0.f, Ain = 1.f, Hin = 0.f;
#pragma unroll
            for (int w = 0; w < 8; ++w) { const f32x2 t = *(const LAS f32x2*)(lds + L_WT + (((kk & 1) * 8 + w) * 64 + nt * 16 + fr) * 8); if (w == wid) { Ain = Ar; Hin = Hr; } Hr = t.x * Hr + t.y; Ar = Ar * t.x; }
            float cc;
            if constexpr (PAIRED) { cc = Ap[nt] * (Aown[nt] * carry[nt] + Hown[nt]) + Hp[nt]; carry[nt] = cc; Aown[nt] = Ar; Hown[nt] = Hr; }
            else { cc = carry[nt]; carry[nt] = Ar * cc + Hr; }
            const float cin = Ain * cc + Hin;
            float eA = __shfl_up(At_[nt], 16), eH = __shfl_up(Ht_[nt], 16);
            if (fq == 0) { eA = 1.f; eH = 0.f; }
            const float hin = eA * cin + eH;
#pragma unroll
            for (int i = 0; i < 4; ++i) *(LAS float*)(stg + (4 * fq + i) * STG_RS + (fr + 16 * nt) * 4) = Hl[nt][i] + Al[nt][i] * hin;
        }
#pragma unroll
        for (int it = 0; it < 2; ++it) { const int row = it * 8 + (lane >> 3), ch = lane & 7;
            const f32x4 a0 = *(const LAS f32x4*)(stg + row * STG_RS + ch * 32), a1 = *(const LAS f32x4*)(stg + row * STG_RS + ch * 32 + 16);
            const size_t grow = rowbase + tw + row;
            const u32x4 g = it ? gc1 : gc0;
            const float y0 = a0[0] * bf_lo(g.x), y1 = a0[1] * bf_hi(g.x), y2 = a0[2] * bf_lo(g.y), y3 = a0[3] * bf_hi(g.y);
            const float y4 = a1[0] * bf_lo(g.z), y5 = a1[1] * bf_hi(g.z), y6 = a1[2] * bf_lo(g.w), y7 = a1[3] * bf_hi(g.w);
            float ss = (y0 * y0 + y1 * y1) + (y2 * y2 + y3 * y3) + (y4 * y4 + y5 * y5) + (y6 * y6 + y7 * y7);
            ss += __shfl_xor(ss, 1); ss += __shfl_xor(ss, 2); ss += __shfl_xor(ss, 4);
            u32x4 w; w.x = cvt_pk_bf16(y0, y1); w.y = cvt_pk_bf16(y2, y3); w.z = cvt_pk_bf16(y4, y5); w.w = cvt_pk_bf16(y6, y7);
            *(u32x4*)(y + grow * KOUT + 1024 + blk * 64 + ch * 8) = w;
            if (ch == 0) ssq[grow * 16 + blk] = ss; }
    }
    __syncthreads();
}
}

#define XB_TMO      128
#define XB_XCNT(j)  (256  + 64 * (j))
#define XB_XSUB(j)  (1280 + 64 * (j))
#define XB_XGEN(j)  (2304 + 64 * (j))
#define XB_TOP      3328
#define XB_TOPGEN   3392
#define XCD_BAR_WORDS 3456
#define XB_SPIN_CAP (1u << 18)
__device__ __forceinline__ unsigned xb_ld(unsigned* p)              { return __hip_atomic_load(p, __ATOMIC_RELAXED, __HIP_MEMORY_SCOPE_AGENT); }
__device__ __forceinline__ unsigned xb_add(unsigned* p, unsigned v) { return __hip_atomic_fetch_add(p, v, __ATOMIC_RELAXED, __HIP_MEMORY_SCOPE_AGENT); }
__device__ __forceinline__ unsigned xb_xcc_id() { return (unsigned)__builtin_amdgcn_s_getreg((3 << 11) | 20) & 0xFu; }
#define XB_SPIN(cond, bar) do { unsigned _sp = 0; while (cond) { __builtin_amdgcn_s_sleep(1); \
    if ((++_sp & 255u) == 0u) { if (xb_ld(&(bar)[XB_TMO])) break; if (_sp > XB_SPIN_CAP) { atomicAdd(&(bar)[XB_TMO], 1u); break; } } } } while (0)
struct XcdBarrier { unsigned* bar; unsigned x; volatile LAS unsigned* st; };
__device__ __forceinline__ XcdBarrier xcd_barrier_post(unsigned* bar, volatile LAS unsigned* st) {
    XcdBarrier b; b.bar = bar; b.x = xb_xcc_id(); b.st = st;
    if (threadIdx.x == 0) (void)xb_add(&bar[XB_XCNT(b.x)], 1u);
    return b;
}
__device__ __forceinline__ void xcd_barrier_complete(unsigned* bar, unsigned x, unsigned& nloc, unsigned& nx) {
    const unsigned G = gridDim.x * gridDim.y * gridDim.z;
    unsigned sum, cnt, mine, sp = 0u;
    for (;;) {
        sum = 0u; cnt = 0u; mine = 0u;
#pragma unroll
        for (unsigned j = 0; j < 16; ++j) { const unsigned c = xb_ld(&bar[XB_XCNT(j)]); sum += c; cnt += (c > 0u) ? 1u : 0u; mine = (j == x) ? c : mine; }
        if (sum == G) break;
        __builtin_amdgcn_s_sleep(1);
        if ((++sp & 255u) == 0u) { if (xb_ld(&bar[XB_TMO])) break; if (sp > XB_SPIN_CAP) { atomicAdd(&bar[XB_TMO], 1u); break; } }
    }
    nloc = mine > 0u ? mine : 1u; nx = cnt > 0u ? cnt : 1u;
}
__device__ __forceinline__ void xcd_barrier(const XcdBarrier& b) {
    asm volatile("s_waitcnt vmcnt(0)" ::: "memory");
    __syncthreads();
    if (threadIdx.x == 0) {
        unsigned* bar = b.bar;
        __builtin_amdgcn_s_waitcnt(0);
        unsigned nloc = b.st[0], nx = b.st[1];
        if (nloc == 0u) { xcd_barrier_complete(bar, b.x, nloc, nx); b.st[0] = nloc; b.st[1] = nx; }
        const unsigned old = xb_add(&bar[XB_XSUB(b.x)], 1u);
        const unsigned gen = old / nloc;
        if (old + 1u == (gen + 1u) * nloc) {
            __builtin_amdgcn_fence(__ATOMIC_RELEASE, "agent");
            asm volatile("s_waitcnt vmcnt(0)" ::: "memory");
            const unsigned og = xb_add(&bar[XB_TOP], 1u);
            const unsigned tg = og / nx;
            if (og + 1u == (tg + 1u) * nx) xb_add(&bar[XB_TOPGEN], 1u);
            else XB_SPIN(xb_ld(&bar[XB_TOPGEN]) == tg, bar);
            __builtin_amdgcn_fence(__ATOMIC_ACQUIRE, "agent");
            xb_add(&bar[XB_XGEN(b.x)], 1u);
            asm volatile("s_waitcnt vmcnt(0)" ::: "memory");
        } else {
            XB_SPIN(xb_ld(&bar[XB_XGEN(b.x)]) == gen, bar);
            __builtin_amdgcn_fence(__ATOMIC_ACQUIRE, "agent");
            asm volatile("s_waitcnt vmcnt(0)" ::: "memory");
        }
    }
    __syncthreads();
}

struct Params {
    const float* x; const float* ln_gain; const float* w_in; const float* sinks; const float* conv_w; const float* conv_b;
    const float* w_r; const float* b_r; const float* w_i; const float* b_i; const float* lam; const float* ga; const float* gl; const float* w_out; const float* fg;
    float* out; unsigned char* ws; int ph_lo, ph_hi;
};

__global__ void __launch_bounds__(512, 2) mega(Params p) {
    extern __shared__ __attribute__((aligned(16))) unsigned char lds_raw[];
    LAS unsigned char* lds = (LAS unsigned char*)lds_raw;
    const int tid = threadIdx.x, lane = tid & 63, wave = __builtin_amdgcn_readfirstlane(tid >> 6);
    const int G = gridDim.x, bx = blockIdx.x;
    unsigned char* ws = p.ws;
    unsigned* ctl = (unsigned*)(ws + WS_CTL);
    bf16_t* WinT = (bf16_t*)(ws + WS_WIN); bf16_t* WoutT = (bf16_t*)(ws + WS_WOUT);
    float* cs = (float*)(ws + WS_CS); float* sn = (float*)(ws + WS_SN);
    float* ssqa = (float*)(ws + WS_SSQA); float* ssql = (float*)(ws + WS_SSQL); float* pss = (float*)(ws + WS_PSS);
    bf16_t* XN = (bf16_t*)(ws + WS_XN); bf16_t* Y = (bf16_t*)(ws + WS_Y); bf16_t* Z = (bf16_t*)(ws + WS_Z);
    const int lo = p.ph_lo, hi = p.ph_hi;
#define IN(k) (lo <= (k) && (k) < hi)
    if (tid < 32) ((LAS unsigned*)(lds + MISC_OFF))[tid] = 0u;
    __syncthreads();
    XcdBarrier bar; bar.bar = ctl + CW_BAR; bar.x = 0; bar.st = nullptr;
    if (hi - lo > 1) bar = xcd_barrier_post(ctl + CW_BAR, (volatile LAS unsigned*)(lds + MISC_OFF) + 8);
    if (hi > 1000) cg::this_grid().sync();
#define SEAM(k) do { if (IN(k) && IN((k) + 1)) { for (int rs_ = 0; rs_ < REP_SYNC; ++rs_) xcd_barrier(bar); } } while (0)

    if (IN(0)) for (int rep = 0; rep < REP_P0; ++rep) {
        LAS float* scr = (LAS float*)(lds + wave * 16384);
        const int gw = bx * 8 + wave, NGW = G * 8;
        constexpr int I_IN = (DM / 64) * (NIN / 32), I_OUT = (KOUT / 64) * (DM / 32);
        for (int it = gw; it < I_IN + I_OUT; it += NGW) {
            if (it < I_IN) p0_transpose_item(p.w_in, DM, NIN, WinT, nullptr, scr, it, lane);
            else { const int r = it - I_IN; const int kb = r / (DM / 32); p0_transpose_item(p.w_out, KOUT, DM, WoutT, (kb < 16) ? p.ga : (p.gl - 1024), scr, r, lane); }
        }
        for (int e = bx * 512 + tid; e < SEQ * 8; e += G * 512) {
            const int pos = e >> 3, i = e & 7;
            const double invf = (i == 0) ? 1.0 : (i == 1) ? 0.19392274474868576 : (i == 2) ? 0.03760603093086393 : (i == 3) ? 0.007292664737217109 : (i == 4) ? 0.001414213562373095
                              : (i == 5) ? 0.0002742481756762073 : (i == 6) ? 5.318295896944988e-05 : 1.031338537721246e-05;
            double s, c; sincos_d((double)pos * invf, s, c); cs[e] = (float)c; sn[e] = (float)s;
        }
        {
            const f32x4* gr = (const f32x4*)p.ln_gain + lane;
            f32x4 gq[4];
#pragma unroll
            for (int j = 0; j < 4; ++j) gq[j] = gr[64 * j];
            for (int m0 = gw * 4; m0 < M_TOK; m0 += NGW * 4) {
                f32x4 v[4][4]; float s2[4];
#pragma unroll
                for (int rr = 0; rr < 4; ++rr) { const f32x4* xr = (const f32x4*)(p.x + (size_t)(m0 + rr) * DM) + lane;
#pragma unroll
                    for (int j = 0; j < 4; ++j) v[rr][j] = __builtin_nontemporal_load(xr + 64 * j); }
#pragma unroll
                for (int rr = 0; rr < 4; ++rr) { float t = 0.f;
#pragma unroll
                    for (int j = 0; j < 4; ++j) t += (v[rr][j].x * v[rr][j].x + v[rr][j].y * v[rr][j].y) + (v[rr][j].z * v[rr][j].z + v[rr][j].w * v[rr][j].w);
                    s2[rr] = t; }
#pragma unroll
                for (int o = 1; o < 64; o <<= 1) {
#pragma unroll
                    for (int rr = 0; rr < 4; ++rr) s2[rr] += __shfl_xor(s2[rr], o); }
#pragma unroll
                for (int rr = 0; rr < 4; ++rr) { const float rstd = 1.0f / sqrtf(s2[rr] * (1.f / DM) + EPS);
                    u32x2* o8 = (u32x2*)(XN + (size_t)(m0 + rr) * DM) + lane;
#pragma unroll
                    for (int j = 0; j < 4; ++j) { const f32x4 g = gq[j]; u32x2 w; w.x = cvt_pk_bf16(v[rr][j].x * rstd * g.x, v[rr][j].y * rstd * g.y); w.y = cvt_pk_bf16(v[rr][j].z * rstd * g.z, v[rr][j].w * rstd * g.w); o8[64 * j] = w; } }
            }
        }
    }
    SEAM(0);

    if (IN(1)) {
        pg8::Gemm g{XN, WinT, M_TOK, NIN, DM}; pg8::StaticOrder S; S.init(M_TOK, NIN, G, bx, REP_P1);
        EpiZ E{Z, cs, sn};
        pg8::gemm_phase<EpiZ, pg8::StaticOrder, true>(lds, g, S, E);
    }
    SEAM(1);

    if (IN(2)) {
        {
            const int uu = bx & 127, half = (bx >> 7) & 1;
            unsigned* sq = ctl + CW_LRU + uu * 128; float* mb = (float*)(ws + WS_MB) + uu * 1024;
            lru::unit<true>(lds, Z, Y, ssql, p.conv_w, p.conv_b, p.w_r, p.b_r, p.w_i, p.b_i, p.lam, uu >> 4, uu & 15, half, sq + 64 * half, sq + 64 * (half ^ 1), mb + 512 * half, mb + 512 * (half ^ 1));
        }
        LAS int* ubox = (LAS int*)(lds + MISC_OFF);
        for (int rep = 0; rep < REP_P2A; ++rep) { att::run(lds, Z, Y, ssqa, p.sinks, ctl + 64 + 64 * rep, ubox); __syncthreads(); }
    }
    SEAM(2);

    if (IN(3)) {
        pg8::Gemm g{Y, WoutT, M_TOK, DM, KOUT}; pg8::StaticOrder S; S.init(M_TOK, DM, G, bx, REP_P3);
        LAS f32x2* RS = (LAS f32x2*)(lds + RS_OFF);
        pg8::Unit u;
        for (int i = 0; i < 4 && S.next(i, u); ++i) {
            if (tid < 256) { const size_t row = (size_t)u.pm * 256 + tid; const f32x4* pa = (const f32x4*)(ssqa + row * 16); const f32x4* pl = (const f32x4*)(ssql + row * 16);
                float sa = 0.f, sl = 0.f;
#pragma unroll
                for (int j = 0; j < 4; ++j) { const f32x4 a = pa[j], l = pl[j]; sa += (a.x + a.y) + (a.z + a.w); sl += (l.x + l.y) + (l.z + l.w); }
                const float rA = 1.0f / sqrtf(sa * (1.f / 1024.f) + EPS), rB = 1.0f / sqrtf(sl * (1.f / 1024.f) + EPS);
                RS[i * 256 + tid] = (f32x2){rA / rB, rB}; }
        }
        __syncthreads();
        EpiOutF E{p.x, p.out, p.fg, pss, ctl + CW_PANEL, RS, (LAS float*)(lds + RS_OFF + 8192), (LAS float*)(lds + RS_OFF + 8192 + 4096)};
        pg8::gemm_phase<EpiOutF, pg8::StaticOrder, true>(lds, g, S, E);
    }
    SEAM(3);

    if (IN(4)) {
        const int gw = bx * 8 + wave, NGW = G * 8;
        const f32x4* fgr = (const f32x4*)p.fg + lane;
        for (int rep = 0; rep < REP_P4; ++rep)
        for (int m = gw; m < M_TOK; m += NGW) {
            float s2 = (lane < 16) ? pss[(size_t)m * 16 + lane] : 0.f;
            s2 += __shfl_xor(s2, 1); s2 += __shfl_xor(s2, 2); s2 += __shfl_xor(s2, 4); s2 += __shfl_xor(s2, 8);
            s2 = __shfl(s2, 0);
            float rstd = 1.0f / sqrtf(s2 * (1.f / DM) + EPS);
            if (rep > 0) rstd = 1.0f;
            f32x4* orow = (f32x4*)(p.out + (size_t)m * DM) + lane;
#pragma unroll
            for (int j = 0; j < 4; ++j) { const f32x4 t = orow[64 * j]; f32x4 g = fgr[64 * j]; if (rep > 0) g = (f32x4){1.f, 1.f, 1.f, 1.f}; orow[64 * j] = t * rstd * g; }
        }
    }
#undef IN
#undef SEAM
}

extern "C" void kernel_launch(void* const* d_in, const int* in_sizes, int n_in, void* d_out, int out_size, void* d_ws, size_t ws_size, hipStream_t stream) {
    static int grid = 0;
    if (grid == 0) {
        if (n_in != 15 || in_sizes[0] != M_TOK * DM || out_size != M_TOK * DM || ws_size < WS_END) { fprintf(stderr, "kernel_launch: unexpected shapes (n_in %d, ws %zu)\n", n_in, ws_size); grid = -1; return; }
        int dev = 0, cus = 0, per_cu = 0;
        (void)hipGetDevice(&dev); (void)hipDeviceGetAttribute(&cus, hipDeviceAttributeMultiprocessorCount, dev);
        if (hipFuncSetAttribute((const void*)mega, hipFuncAttributeMaxDynamicSharedMemorySize, LDS_BYTES) != hipSuccess) { fprintf(stderr, "kernel_launch: hipFuncSetAttribute failed\n"); grid = -1; return; }
        if (hipOccupancyMaxActiveBlocksPerMultiprocessor(&per_cu, (const void*)mega, 512, LDS_BYTES) != hipSuccess || per_cu < 1) { fprintf(stderr, "kernel_launch: occupancy query says %d\n", per_cu); per_cu = 1; }
        (void)hipGetLastError();
        grid = 256;
        if (cus * per_cu < 256) fprintf(stderr, "kernel_launch: device capacity %d x %d < 256 workgroups\n", cus, per_cu);
    }
    if (grid < 0) return;
    (void)hipMemsetAsync((char*)d_ws + WS_CTL, 0, 131072 + 524288, stream);
    Params p{};
    p.x = (const float*)d_in[0]; p.ln_gain = (const float*)d_in[1]; p.w_in = (const float*)d_in[2]; p.sinks = (const float*)d_in[3]; p.conv_w = (const float*)d_in[4]; p.conv_b = (const float*)d_in[5];
    p.w_r = (const float*)d_in[6]; p.b_r = (const float*)d_in[7]; p.w_i = (const float*)d_in[8]; p.b_i = (const float*)d_in[9]; p.lam = (const float*)d_in[10]; p.ga = (const float*)d_in[11]; p.gl = (const float*)d_in[12];
    p.w_out = (const float*)d_in[13]; p.fg = (const float*)d_in[14]; p.out = (float*)d_out; p.ws = (unsigned char*)d_ws;
    if (MK_N_LAUNCHES == 1) {
        p.ph_lo = 0; p.ph_hi = 4; void* args[] = {&p};
        hipError_t e = hipLaunchCooperativeKernel((const void*)mega, dim3(grid), dim3(512), args, LDS_BYTES, stream);
        if (e != hipSuccess) fprintf(stderr, "kernel_launch: cooperative launch failed: %s (grid %d)\n", hipGetErrorString(e), grid);
    } else {
        for (int ph = 0; ph < 4; ++ph) { p.ph_lo = ph; p.ph_hi = ph + 1; hipLaunchKernelGGL(mega, dim3(grid), dim3(512), LDS_BYTES, stream, p); }
    }
}
```

```cpp
#include <hip/hip_runtime.h>
#include <hip/hip_cooperative_groups.h>
#include <cstdio>
#include <cstdint>
namespace cg = cooperative_groups;

#ifndef MK_N_LAUNCHES
#define MK_N_LAUNCHES 1
#endif

#ifndef REP_P0
#define REP_P0 1
#endif
#ifndef REP_P1
#define REP_P1 1
#endif
#ifndef REP_P2L
#define REP_P2L 1
#endif
#ifndef REP_P2A
#define REP_P2A 1
#endif
#ifndef REP_P3
#define REP_P3 1
#endif
#ifndef REP_P4
#define REP_P4 1
#endif
#ifndef REP_SYNC
#define REP_SYNC 1
#endif

#define LAS __attribute__((address_space(3)))
typedef unsigned short bf16_t;
typedef short bf16x8 __attribute__((ext_vector_type(8)));
typedef short s16x4 __attribute__((ext_vector_type(4)));
typedef float f32x4 __attribute__((ext_vector_type(4)));
typedef float f32x2 __attribute__((ext_vector_type(2)));
typedef float f32x16 __attribute__((ext_vector_type(16)));
typedef unsigned u32x4 __attribute__((ext_vector_type(4)));
typedef unsigned u32x2 __attribute__((ext_vector_type(2)));

constexpr int SEQ = 4096, NB = 8, M_TOK = NB * SEQ, DM = 1024, NIN = 4608, KOUT = 2048;
constexpr int COL_Q = 0, COL_K = 1024, COL_V = 1280, COL_GA = 1536, COL_XL = 2560, COL_GL = 3584;
constexpr float EPS = 1e-6f;
constexpr float LOG2E = 1.4426950408889634f;
constexpr float C2 = 0.125f * LOG2E;

constexpr size_t MiB = 1u << 20;
constexpr size_t WS_CTL = 0;
constexpr int CW_BAR = 1024;
constexpr int CW_PANEL = 8192;
constexpr int CW_LRU = 16384;
constexpr size_t WS_WIN = 2 * MiB;
constexpr size_t WS_WOUT = 12 * MiB;
constexpr size_t WS_CS = 16 * MiB;
constexpr size_t WS_SN = 16 * MiB + 128 * 1024;
constexpr size_t WS_MB = 128 * 1024;
constexpr size_t WS_SSQA = 17 * MiB;
constexpr size_t WS_SSQL = 19 * MiB;
constexpr size_t WS_PSS = 21 * MiB;
constexpr size_t WS_XN = 32 * MiB;
constexpr size_t WS_Y = 32 * MiB;
constexpr size_t WS_Z = 160 * MiB;
constexpr size_t WS_END = 448 * MiB;

constexpr int RING_BYTES = 131072;
constexpr int MISC_OFF = RING_BYTES;
constexpr int RS_OFF = RING_BYTES + 512;
constexpr int LDS_BYTES = 147456;

__device__ __forceinline__ unsigned cvt_pk_bf16(float lo, float hi) { unsigned r; asm volatile("v_cvt_pk_bf16_f32 %0, %1, %2" : "=v"(r) : "v"(lo), "v"(hi)); return r; }
__device__ __forceinline__ float bf_lo(unsigned w) { return __uint_as_float(w << 16); }
__device__ __forceinline__ float bf_hi(unsigned w) { return __uint_as_float(w & 0xffff0000u); }
__device__ __forceinline__ unsigned f2bf(float f) { unsigned u = __float_as_uint(f); return (u + 0x7fffu + ((u >> 16) & 1u)) >> 16; }
__device__ __forceinline__ unsigned pk2(float lo, float hi) { return f2bf(lo) | (f2bf(hi) << 16); }
__device__ __forceinline__ float fast_sigmoid(float v) { return __builtin_amdgcn_rcpf(1.0f + __builtin_amdgcn_exp2f(-v * LOG2E)); }

namespace pg8 {
constexpr int BM = 256, BK = 64, HALF = 128, HTB = HALF * BK * 2, STAGE_BYTES = 8 * HTB, NXCD = 8, WGM = 8;
__host__ __device__ __forceinline__ int lds_byte(int r, int c) { const int st = (r >> 4) * 2 + (c >> 5), rr = r & 15, cc = c & 31, ob = rr * 64 + cc * 2; return st * 1024 + (ob ^ (((ob >> 9) & 1) << 5)); }
__host__ __device__ __forceinline__ void stage_rc(int b, int& R, int& C) { const int st = b / 1024, sb = b % 1024, swz = sb ^ (((sb >> 9) & 1) << 5); R = (st >> 1) * 16 + swz / 64; C = (st & 1) * 32 + (swz % 64) / 2; }
__host__ __device__ __forceinline__ int perm32(int rho) { const int n = rho >> 4, i = rho & 15; return 8 * (i >> 2) + 4 * n + (i & 3); }

struct Unit { int pm, pn; };
struct Gemm { const bf16_t* A; const bf16_t* Bt; int M, N, K; };

struct StaticOrder {
    int nM, nN, nwg, G, c, rep;
    __host__ __device__ void init(int M, int N, int G_, int c_, int rep_ = 1) { nM = M / BM; nN = N / BM; nwg = nM * nN; G = G_; c = c_; rep = rep_; }
    __host__ __device__ bool next(int i, Unit& u) const {
        const long L = (long)i * G + c; if (L >= (long)nwg * rep) return false;
        int wgid = (int)(L % nwg); { const int q = nwg / NXCD, r = nwg % NXCD, xcd = wgid % NXCD, off = wgid / NXCD; wgid = (xcd < r ? xcd * (q + 1) : r * (q + 1) + (xcd - r) * q) + off; }
        const int nig = WGM * nN, gid = wgid / nig, fm = gid * WGM, gsz = (nM - fm) < WGM ? (nM - fm) : WGM;
        u.pm = fm + ((wgid % nig) % gsz); u.pn = (wgid % nig) / gsz; return true;
    }
};

template <class Epi, class Sched, bool ALIGN_EPI>
__device__ __forceinline__ void gemm_phase(LAS unsigned char* lds, const Gemm g, const Sched& S, const Epi& E) {
    const int tid = threadIdx.x, wid = __builtin_amdgcn_readfirstlane(tid >> 6), lane = tid & 63, wr = wid >> 2, wc = wid & 3, fr = lane & 15, fq = lane >> 4;
    const int K = g.K, nt = K / BK;
    unsigned voffA[2], voffB[2];
#pragma unroll
    for (int i = 0; i < 2; ++i) { int R, C; stage_rc(tid * 16 + i * 8192, R, C); const int Rb = Epi::PERM ? ((R & ~31) + perm32(R & 31)) : R;
        voffA[i] = (unsigned)(R * K + C) * 2u; voffB[i] = (unsigned)(Rb * K + C) * 2u; }
    const size_t kstep = (size_t)(BK * 2);
    const size_t hstep = (size_t)HALF * K * 2;
    const size_t tstep = 2 * hstep;
    const unsigned ldsw = (unsigned)wid * 1024u;
    const int aoff = lds_byte(wr * 64 + fr, fq * 8), boff = lds_byte(wc * 32 + fr, fq * 8);
#define PG8_SA(b, h) (((b) * 2 + (h)) * HTB)
#define PG8_SB(b, h) ((4 + (b) * 2 + (h)) * HTB)
#define PG8_STAGE(bufoff, gbase, voff) do { _Pragma("unroll") for (int _i = 0; _i < 2; ++_i) \
        __builtin_amdgcn_global_load_lds((const unsigned*)((const char*)(gbase) + (voff)[_i]), (LAS unsigned*)(lds + (bufoff) + ldsw + _i * 8192), 16, 0, 0); } while (0)
#define PG8_LDA(dst, b, h) do { _Pragma("unroll") for (int m = 0; m < 4; ++m) _Pragma("unroll") for (int k = 0; k < 2; ++k) dst[m][k] = *(const LAS bf16x8*)(lds + PG8_SA(b, h) + aoff + m * 2048 + k * 1024); } while (0)
#define PG8_LDB(dst, b, h) do { _Pragma("unroll") for (int n = 0; n < 2; ++n) _Pragma("unroll") for (int k = 0; k < 2; ++k) dst[n][k] = *(const LAS bf16x8*)(lds + PG8_SB(b, h) + boff + n * 2048 + k * 1024); } while (0)
#define PG8_MMA(ai, bj, At, Bt) do { __builtin_amdgcn_s_setprio(1); _Pragma("unroll") for (int m = 0; m < 4; ++m) _Pragma("unroll") for (int n = 0; n < 2; ++n) _Pragma("unroll") for (int k = 0; k < 2; ++k) \
        acc[ai][bj][m][n] = __builtin_amdgcn_mfma_f32_16x16x32_bf16(Bt[n][k], At[m][k], acc[ai][bj][m][n], 0, 0, 0); __builtin_amdgcn_s_setprio(0); } while (0)
#define PG8_WAIT_V(n) asm volatile("s_waitcnt vmcnt(" #n ")" ::: "memory")
#define PG8_WAIT_L(n) asm volatile("s_waitcnt lgkmcnt(" #n ")" ::: "memory")
#define PG8_BAR __builtin_amdgcn_s_barrier()
#define PG8_SCHED __builtin_amdgcn_sched_barrier(0)
    Unit cur, nxt; int ui = 0;
    if (!S.next(0, cur)) return;
    f32x4 acc[2][2][4][2];
#pragma unroll
    for (int a = 0; a < 2; ++a)
#pragma unroll
        for (int b = 0; b < 2; ++b)
#pragma unroll
            for (int m = 0; m < 4; ++m)
#pragma unroll
                for (int n = 0; n < 2; ++n) acc[a][b][m][n] = (f32x4){0.f, 0.f, 0.f, 0.f};
    bf16x8 At[4][2], B0[2][2], B1[2][2];
    const char* cA = (const char*)g.A + (size_t)cur.pm * tstep; const char* cB = (const char*)g.Bt + (size_t)cur.pn * tstep;
    PG8_STAGE(PG8_SB(0, 0), cB, voffB); PG8_STAGE(PG8_SB(0, 1), cB + hstep, voffB); PG8_STAGE(PG8_SA(0, 0), cA, voffA); PG8_STAGE(PG8_SA(0, 1), cA + hstep, voffA);
    if (wr == 1) PG8_BAR;
    PG8_WAIT_V(2); PG8_BAR;
    PG8_STAGE(PG8_SB(1, 0), cB + kstep, voffB); PG8_STAGE(PG8_SA(1, 0), cA + kstep, voffA); PG8_STAGE(PG8_SB(1, 1), cB + hstep + kstep, voffB);
    PG8_WAIT_V(6); PG8_BAR;
    for (;;) {
        const bool has_next = S.next(ui + 1, nxt);
        const char* nA = has_next ? (const char*)g.A + (size_t)nxt.pm * tstep : cA; const char* nB = has_next ? (const char*)g.Bt + (size_t)nxt.pn * tstep : cB;
        for (int t = 0; t < nt; t += 2) {
            const bool last = (t == nt - 2);
            const char* a1 = cA + (size_t)(t + 1) * kstep;
            const char* a2 = last ? nA : cA + (size_t)(t + 2) * kstep; const char* b2 = last ? nB : cB + (size_t)(t + 2) * kstep;
            const char* a3 = a2 + kstep; const char* b3 = b2 + kstep;
            if constexpr (Epi::MIDK > 0) { if (t == Epi::MIDK) E.mid(acc, ui, wr, fr); }
            PG8_LDB(B0, 0, 0); PG8_LDB(B1, 0, 1); PG8_SCHED; PG8_LDA(At, 0, 0); PG8_STAGE(PG8_SA(1, 1), a1 + hstep, voffA);
            PG8_WAIT_V(8); PG8_WAIT_L(0); PG8_BAR; PG8_MMA(0, 0, At, B0); PG8_MMA(0, 1, At, B1); PG8_BAR; PG8_SCHED;
            PG8_LDA(At, 0, 1); PG8_STAGE(PG8_SB(0, 0), b2, voffB); PG8_STAGE(PG8_SB(0, 1), b2 + hstep, voffB); PG8_STAGE(PG8_SA(0, 0), a2, voffA);
            PG8_WAIT_V(8); PG8_WAIT_L(0); PG8_BAR; PG8_MMA(1, 0, At, B0); PG8_MMA(1, 1, At, B1); PG8_BAR; PG8_SCHED;
            PG8_LDB(B0, 1, 0); PG8_LDB(B1, 1, 1); PG8_SCHED; PG8_LDA(At, 1, 0); PG8_STAGE(PG8_SA(0, 1), a2 + hstep, voffA);
            PG8_WAIT_V(8); PG8_WAIT_L(0); PG8_BAR; PG8_MMA(0, 0, At, B0); PG8_MMA(0, 1, At, B1); PG8_BAR; PG8_SCHED;
            PG8_LDA(At, 1, 1); PG8_STAGE(PG8_SB(1, 0), b3, voffB); PG8_STAGE(PG8_SB(1, 1), b3 + hstep, voffB); PG8_STAGE(PG8_SA(1, 0), a3, voffA);
            PG8_WAIT_V(8); PG8_WAIT_L(0); PG8_BAR; PG8_MMA(1, 0, At, B0); PG8_MMA(1, 1, At, B1); PG8_BAR; PG8_SCHED;
        }
        if constexpr (ALIGN_EPI) { if (wr == 0) PG8_BAR; }
        E(acc, cur, ui, wr, wc, fr, fq);
        if (!has_next) break;
#pragma unroll
        for (int a = 0; a < 2; ++a)
#pragma unroll
            for (int b = 0; b < 2; ++b)
#pragma unroll
                for (int m = 0; m < 4; ++m)
#pragma unroll
                    for (int n = 0; n < 2; ++n) acc[a][b][m][n] = (f32x4){0.f, 0.f, 0.f, 0.f};
        cur = nxt; cA = nA; cB = nB; ++ui;
        if constexpr (ALIGN_EPI) { if (wr == 1) PG8_BAR; }
    }
    PG8_WAIT_V(0);
    if constexpr (!ALIGN_EPI) { if (wr == 0) PG8_BAR; }
    PG8_BAR;
#undef PG8_SA
#undef PG8_SB
#undef PG8_STAGE
#undef PG8_LDA
#undef PG8_LDB
#undef PG8_MMA
#undef PG8_WAIT_V
#undef PG8_WAIT_L
#undef PG8_BAR
#undef PG8_SCHED
}
}

struct EpiZ {
    static constexpr bool PERM = true; static constexpr int MIDK = 0;
    bf16_t* Z; const float* cs; const float* sn;
    __device__ __forceinline__ void mid(f32x4 (&acc)[2][2][4][2], int ui, int wr, int fr) const {}
    __device__ __forceinline__ void operator()(const f32x4 (&acc)[2][2][4][2], const pg8::Unit& u, int ui, int wr, int wc, int fr, int fq) const {
        const int row0 = u.pm * 256 + wr * 64 + fr, col0 = u.pn * 256 + wc * 32 + 8 * fq, pn = u.pn;
        const int mode = (pn <= 4) ? 2 : (pn == 5 ? 0 : (pn <= 9 ? 1 : (pn <= 13 ? 0 : 1)));
        const bool rope = (mode == 2) && ((wc & 1) == 0);
        const float sc = (pn <= 3) ? C2 : 1.f;
        const float sgn = (fq == 0) ? -1.f : 1.f;
#pragma unroll
        for (int ai = 0; ai < 2; ++ai)
#pragma unroll
            for (int m = 0; m < 4; ++m) {
                const int row = row0 + ai * 128 + m * 16;
                bf16_t* rowp = Z + (size_t)row * NIN + col0;
                f32x4 c0 = {1.f, 1.f, 1.f, 1.f}, c1 = c0, s0 = {0.f, 0.f, 0.f, 0.f}, s1 = s0;
                if (rope && fq < 2) { const int pos = row & (SEQ - 1); c0 = *(const f32x4*)(cs + pos * 8); c1 = *(const f32x4*)(cs + pos * 8 + 4); s0 = *(const f32x4*)(sn + pos * 8) * sgn; s1 = *(const f32x4*)(sn + pos * 8 + 4) * sgn; }
#pragma unroll
                for (int bj = 0; bj < 2; ++bj) {
                    f32x4 v0 = acc[ai][bj][m][0], v1 = acc[ai][bj][m][1];
                    if (rope) {
                        f32x4 p0, p1;
#pragma unroll
                        for (int k = 0; k < 4; ++k) { p0[k] = __shfl_xor(v0[k], 16); p1[k] = __shfl_xor(v1[k], 16); }
                        v0 = v0 * c0 + p0 * s0; v1 = v1 * c1 + p1 * s1;
                    } else if (mode == 1) {
#pragma unroll
                        for (int k = 0; k < 4; ++k) {
                            const float da = 1.0f + __builtin_amdgcn_exp2f(fminf(-v0[k] * LOG2E, 60.f)), db = 1.0f + __builtin_amdgcn_exp2f(fminf(-v1[k] * LOG2E, 60.f));
                            const float inv = __builtin_amdgcn_rcpf(da * db); v0[k] = v0[k] * (db * inv); v1[k] = v1[k] * (da * inv); }
                    }
                    v0 = v0 * sc; v1 = v1 * sc;
                    u32x4 w; w.x = cvt_pk_bf16(v0[0], v0[1]); w.y = cvt_pk_bf16(v0[2], v0[3]); w.z = cvt_pk_bf16(v1[0], v1[1]); w.w = cvt_pk_bf16(v1[2], v1[3]);
                    *(u32x4*)(rowp + bj * 128) = w;
                }
            }
    }
};

struct EpiOut {
    static constexpr bool PERM = false; static constexpr int MIDK = 16;
    const float* x; float* out; float* pss; LAS const f32x2* RS;
    __device__ __forceinline__ void mid(f32x4 (&acc)[2][2][4][2], int ui, int wr, int fr) const {
#pragma unroll
        for (int ai = 0; ai < 2; ++ai)
#pragma unroll
            for (int m = 0; m < 4; ++m) { const float ratio = RS[(ui & 3) * 256 + ai * 128 + wr * 64 + m * 16 + fr].x;
#pragma unroll
                for (int bj = 0; bj < 2; ++bj)
#pragma unroll
                    for (int n = 0; n < 2; ++n) acc[ai][bj][m][n] = acc[ai][bj][m][n] * ratio; }
    }
    __device__ __forceinline__ void operator()(const f32x4 (&acc)[2][2][4][2], const pg8::Unit& u, int ui, int wr, int wc, int fr, int fq) const {
        const int col0 = u.pn * 256 + wc * 32 + 4 * fq;
#pragma unroll
        for (int ai = 0; ai < 2; ++ai)
#pragma unroll
            for (int m = 0; m < 4; ++m) {
                const int lr = ai * 128 + wr * 64 + m * 16 + fr; const float rB = RS[(ui & 3) * 256 + lr].y;
                const size_t off = (size_t)(u.pm * 256 + lr) * DM + col0; float ss = 0.f;
#pragma unroll
                for (int bj = 0; bj < 2; ++bj)
#pragma unroll
                    for (int n = 0; n < 2; ++n) { const f32x4 xb = *(const f32x4*)(x + off + bj * 128 + n * 16); const f32x4 o = xb + acc[ai][bj][m][n] * rB;
                        ss += (o[0] * o[0] + o[1] * o[1]) + (o[2] * o[2] + o[3] * o[3]); *(f32x4*)(out + off + bj * 128 + n * 16) = o; }
                ss += __shfl_xor(ss, 16); ss += __shfl_xor(ss, 32);
                if (fq == 0) pss[(size_t)(u.pm * 256 + lr) * 16 + u.pn * 4 + wc] = ss;
            }
    }
};

struct EpiOutF {
    static constexpr bool PERM = false; static constexpr int MIDK = 16;
    const float* x; float* out; const float* fg; float* xbuf; unsigned* cnt; LAS const f32x2* RS; LAS float* PP; LAS float* SS;
    __device__ __forceinline__ void mid(f32x4 (&acc)[2][2][4][2], int ui, int wr, int fr) const {
#pragma unroll
        for (int ai = 0; ai < 2; ++ai)
#pragma unroll
            for (int m = 0; m < 4; ++m) { const float ratio = RS[(ui & 3) * 256 + ai * 128 + wr * 64 + m * 16 + fr].x;
#pragma unroll
                for (int bj = 0; bj < 2; ++bj)
#pragma unroll
                    for (int n = 0; n < 2; ++n) acc[ai][bj][m][n] = acc[ai][bj][m][n] * ratio; }
    }
    __device__ __forceinline__ void operator()(f32x4 (&acc)[2][2][4][2], const pg8::Unit& u, int ui, int wr, int wc, int fr, int fq) const {
        const int tid = threadIdx.x, lane = tid & 63, wid = __builtin_amdgcn_readfirstlane(tid >> 6);
        const int col0 = u.pn * 256 + wc * 32 + 4 * fq;
#pragma unroll
        for (int ai = 0; ai < 2; ++ai)
#pragma unroll
            for (int m = 0; m < 4; ++m) {
                const int lr = ai * 128 + wr * 64 + m * 16 + fr; const float rB = RS[(ui & 3) * 256 + lr].y;
                const size_t off = (size_t)(u.pm * 256 + lr) * DM + col0; float ss = 0.f;
#pragma unroll
                for (int bj = 0; bj < 2; ++bj)
#pragma unroll
                    for (int n = 0; n < 2; ++n) { const f32x4 xb = *(const f32x4*)(x + off + bj * 128 + n * 16); const f32x4 o = xb + acc[ai][bj][m][n] * rB;
                        ss += (o[0] * o[0] + o[1] * o[1]) + (o[2] * o[2] + o[3] * o[3]); acc[ai][bj][m][n] = o; }
                ss += __shfl_xor(ss, 16); ss += __shfl_xor(ss, 32);
                if (fq == 0) PP[lr * 4 + wc] = ss;
            }
        asm volatile("s_waitcnt lgkmcnt(0)" ::: "memory"); __builtin_amdgcn_s_barrier(); asm volatile("" ::: "memory");
        unsigned* pc = cnt + 64 * u.pm;
        if (tid < 256) { const f32x4 pp = *(const LAS f32x4*)(PP + tid * 4); const float tp = (pp[0] + pp[1]) + (pp[2] + pp[3]);
            __hip_atomic_store(xbuf + (size_t)(u.pm * 256 + tid) * 4 + u.pn, tp, __ATOMIC_RELAXED, __HIP_MEMORY_SCOPE_AGENT); }
        asm volatile("s_waitcnt vmcnt(0)" ::: "memory");
        if (tid < 256 && lane == 0) __hip_atomic_fetch_add(pc, 1u, __ATOMIC_RELAXED, __HIP_MEMORY_SCOPE_AGENT);
        if (wid == 0) {
            unsigned sp = 0;
            while ((unsigned)__builtin_amdgcn_readfirstlane(__hip_atomic_load(pc, __ATOMIC_RELAXED, __HIP_MEMORY_SCOPE_AGENT)) < 16u) { __builtin_amdgcn_s_sleep(2); if (++sp > (1u << 22)) break; }
            __builtin_amdgcn_fence(__ATOMIC_ACQUIRE, "agent");
        }
        asm volatile("s_waitcnt vmcnt(0) lgkmcnt(0)" ::: "memory"); __builtin_amdgcn_s_barrier(); asm volatile("" ::: "memory");
        if (tid < 256) { const float* slot = xbuf + (size_t)(u.pm * 256 + tid) * 4; float q = 0.f;
#pragma unroll
            for (int t = 0; t < 4; ++t) q += __hip_atomic_load(slot + t, __ATOMIC_RELAXED, __HIP_MEMORY_SCOPE_AGENT);
            SS[tid] = 1.0f / sqrtf(q * (1.f / DM) + EPS); }
        asm volatile("s_waitcnt lgkmcnt(0)" ::: "memory"); __builtin_amdgcn_s_barrier(); asm volatile("" ::: "memory");
        f32x4 gv[2][2];
#pragma unroll
        for (int bj = 0; bj < 2; ++bj)
#pragma unroll
            for (int n = 0; n < 2; ++n) gv[bj][n] = *(const f32x4*)(fg + col0 + bj * 128 + n * 16);
#pragma unroll
        for (int ai = 0; ai < 2; ++ai)
#pragma unroll
            for (int m = 0; m < 4; ++m) {
                const int lr = ai * 128 + wr * 64 + m * 16 + fr; const float rs = SS[lr];
                const size_t off = (size_t)(u.pm * 256 + lr) * DM + col0;
#pragma unroll
                for (int bj = 0; bj < 2; ++bj)
#pragma unroll
                    for (int n = 0; n < 2; ++n) *(f32x4*)(out + off + bj * 128 + n * 16) = acc[ai][bj][m][n] * rs * gv[bj][n];
            }
        asm volatile("s_waitcnt lgkmcnt(0)" ::: "memory"); __builtin_amdgcn_s_barrier(); asm volatile("" ::: "memory");
    }
};

__device__ __forceinline__ float wave_sum(float v) {
#pragma unroll
    for (int o = 1; o < 64; o <<= 1) v += __shfl_xor(v, o);
    return v;
}
__device__ __forceinline__ void p0_transpose_item(const float* W, int K, int N, bf16_t* WT, const float* kscale, LAS float* scr, int item, int lane) {
    const int nblk = N / 32, kb = item / nblk, nb = item % nblk, k0 = 64 * kb, n0 = 32 * nb;
#pragma unroll
    for (int i = 0; i < 32; ++i) { const int kk = 2 * i + (lane >> 5); float v = W[(size_t)(k0 + kk) * N + n0 + (lane & 31)]; if (kscale) v *= kscale[k0 + kk]; scr[kk * 33 + (lane & 31)] = v; }
    asm volatile("s_waitcnt lgkmcnt(0)" ::: "memory");
    const int c = lane & 7;
#pragma unroll
    for (int j = 0; j < 4; ++j) { const int n = (lane >> 3) + 8 * j; const LAS float* s = scr + (8 * c) * 33 + n;
        u32x4 o; o.x = pk2(s[0 * 33], s[1 * 33]); o.y = pk2(s[2 * 33], s[3 * 33]); o.z = pk2(s[4 * 33], s[5 * 33]); o.w = pk2(s[6 * 33], s[7 * 33]);
        *(u32x4*)(WT + (size_t)(n0 + n) * K + k0 + 8 * c) = o; }
    asm volatile("s_waitcnt lgkmcnt(0)" ::: "memory");
}
__device__ __forceinline__ void sincos_d(double xx, double& s, double& c) {
    const double kq = rint(xx * 0.63661977236758134308);
    double r = fma(-kq, 1.57079632679489655800e+00, xx); r = fma(-kq, 6.12323399573676603587e-17, r);
    const int q = ((int)kq) & 3; const double r2 = r * r;
    const double sp = r * (1.0 + r2 * (-1.0 / 6.0 + r2 * (1.0 / 120.0 + r2 * (-1.0 / 5040.0 + r2 * (1.0 / 362880.0 + r2 * (-1.0 / 39916800.0 + r2 * (1.0 / 6227020800.0 + r2 * (-1.0 / 1307674368000.0))))))));
    const double cp = 1.0 + r2 * (-0.5 + r2 * (1.0 / 24.0 + r2 * (-1.0 / 720.0 + r2 * (1.0 / 40320.0 + r2 * (-1.0 / 3628800.0 + r2 * (1.0 / 479001600.0 + r2 * (-1.0 / 87178291200.0 + r2 * (1.0 / 20922789888000.0))))))));
    s = (q == 0) ? sp : (q == 1) ? cp : (q == 2) ? -sp : -cp;
    c = (q == 0) ? cp : (q == 1) ? -sp : (q == 2) ? -cp : sp;
}

namespace att {
constexpr int KV_ROWS = 192, RS = 144;
constexpr int L_K = 0, L_V = KV_ROWS * RS, L_STG = 2 * KV_ROWS * RS, STG_RS = 272, STG_W = 32 * STG_RS, L_LW = L_STG + 8 * STG_W, L_END = L_LW + 8 * 128;
static_assert(L_END <= RING_BYTES, "attention LDS");
__device__ __forceinline__ int crow(int i, int h) { return (i & 3) + 8 * (i >> 2) + 4 * h; }
__device__ __forceinline__ s16x4 vtr(LAS const unsigned char* p) { return __builtin_bit_cast(s16x4, __builtin_amdgcn_ds_read_tr16_b64_v4i16((LAS s16x4*)p)); }

constexpr int NUNITS = NB * 4 * 64;
__device__ __forceinline__ void load_kvq(u32x4 (&kreg)[3], u32x4 (&vreg)[3], bf16x8 (&qr)[4], const bf16_t* __restrict__ z, int u, int tid, int wid, int r, int h) {
    const int b = u >> 8, kvh = (u >> 6) & 3, q0 = (u & 63) * 64; const size_t rowbase = (size_t)b * SEQ;
    const int head = kvh * 4 + (wid >> 1), qs = q0 + 32 * (wid & 1);
#pragma unroll
    for (int i = 0; i < 3; ++i) { const int pidx = tid + 512 * i, row = pidx >> 3, ch = pidx & 7, pos = q0 - 128 + row;
        if (pos >= 0) { const bf16_t* src = z + (rowbase + pos) * NIN + COL_K + kvh * 64 + ch * 8; kreg[i] = *(const u32x4*)src; vreg[i] = *(const u32x4*)(src + 256); }
        else { kreg[i] = (u32x4){0u, 0u, 0u, 0u}; vreg[i] = (u32x4){0u, 0u, 0u, 0u}; } }
#pragma unroll
    for (int d0 = 0; d0 < 4; ++d0) qr[d0] = *(const bf16x8*)(z + (rowbase + qs + r) * NIN + COL_Q + head * 64 + d0 * 16 + h * 8);
}

__device__ __forceinline__ void run(LAS unsigned char* lds, const bf16_t* __restrict__ z, bf16_t* __restrict__ y, float* __restrict__ ssq, const float* __restrict__ sinks, unsigned* ctr, LAS int* ubox) {
    const int tid = threadIdx.x, lane = tid & 63, r = lane & 31, h = lane >> 5, wid = __builtin_amdgcn_readfirstlane(tid >> 6);
    if (tid == 0) ubox[0] = (int)atomicAdd(ctr, 1u);
    __syncthreads();
    int u = ubox[0];
    if (u >= NUNITS) return;
    u32x4 kreg[3], vreg[3]; bf16x8 qn[4];
    load_kvq(kreg, vreg, qn, z, u, tid, wid, r, h);
    if (tid == 0) ubox[1] = (int)atomicAdd(ctr, 1u);
    for (int n = 0;; ++n) {
        const int b = u >> 8, kvh = (u >> 6) & 3, q0 = (u & 63) * 64; const size_t rowbase = (size_t)b * SEQ;
        const int head = kvh * 4 + (wid >> 1), qs = q0 + 32 * (wid & 1);
        bf16x8 qr[4];
#pragma unroll
        for (int d0 = 0; d0 < 4; ++d0) qr[d0] = qn[d0];
#pragma unroll
        for (int i = 0; i < 3; ++i) { const int pidx = tid + 512 * i, row = pidx >> 3, ch = pidx & 7;
            *(LAS u32x4*)(lds + L_K + row * RS + ch * 16) = kreg[i]; *(LAS u32x4*)(lds + L_V + row * RS + ch * 16) = vreg[i]; }
        __syncthreads();
        const int un = ubox[(n + 1) & 1];
        if (un < NUNITS) load_kvq(kreg, vreg, qn, z, un, tid, wid, r, h);
        unsigned nxt2 = 0u;
        if (tid == 0) nxt2 = atomicAdd(ctr, 1u);
        u32x4 gv[4];
#pragma unroll
        for (int it = 0; it < 4; ++it) gv[it] = *(const u32x4*)(z + (rowbase + qs + it * 8 + (lane >> 3)) * NIN + COL_GA + head * 64 + (lane & 7) * 8);
        f32x16 s[5];
        const LAS unsigned char* kb = lds + L_K + (32 * (wid & 1) + r) * RS + h * 16;
#pragma unroll
        for (int c = 0; c < 5; ++c) { f32x16 a = {0.f, 0.f, 0.f, 0.f, 0.f, 0.f, 0.f, 0.f, 0.f, 0.f, 0.f, 0.f, 0.f, 0.f, 0.f, 0.f};
#pragma unroll
            for (int d0 = 0; d0 < 4; ++d0) { const bf16x8 kf = *(const LAS bf16x8*)(kb + c * 32 * RS + d0 * 32); a = __builtin_amdgcn_mfma_f32_32x32x16_bf16(kf, qr[d0], a, 0, 0, 0); }
            s[c] = a; }
        const float sink2 = sinks[head] * LOG2E;
        float mx = -1e30f;
        if (q0 < 128) {
#pragma unroll
            for (int c = 0; c < 5; ++c)
#pragma unroll
                for (int i = 0; i < 16; ++i) { const int cr = crow(i, h), diff = 128 - 32 * c + r - cr, kp = qs - 128 + 32 * c + cr;
                    const bool valid = (diff >= 0) && (diff < 128) && (kp >= 0); const float v = valid ? s[c][i] : -1e30f; s[c][i] = v; mx = fmaxf(mx, v); }
        } else {
#pragma unroll
            for (int i = 0; i < 16; ++i) { const int cr = crow(i, h); const float v0 = (cr > r) ? s[0][i] : -1e30f, v4 = (cr <= r) ? s[4][i] : -1e30f; s[0][i] = v0; s[4][i] = v4; mx = fmaxf(mx, fmaxf(v0, v4)); }
#pragma unroll
            for (int c = 1; c < 4; ++c)
#pragma unroll
                for (int i = 0; i < 16; ++i) mx = fmaxf(mx, s[c][i]);
        }
        mx = fmaxf(mx, __shfl_xor(mx, 32));
        const float mref = fmaxf(mx, sink2);
        float lsum = 0.f;
#pragma unroll
        for (int c = 0; c < 5; ++c)
#pragma unroll
            for (int i = 0; i < 16; ++i) { const float pv = __builtin_amdgcn_exp2f(s[c][i] - mref); s[c][i] = pv; lsum += pv; }
        lsum += __shfl_xor(lsum, 32);
        const float l = lsum + __builtin_amdgcn_exp2f(sink2 - mref);
        f32x16 o[2];
        o[0] = (f32x16){0.f, 0.f, 0.f, 0.f, 0.f, 0.f, 0.f, 0.f, 0.f, 0.f, 0.f, 0.f, 0.f, 0.f, 0.f, 0.f}; o[1] = o[0];
        const LAS unsigned char* vb = lds + L_V + (32 * (wid & 1) + 4 * h + ((lane & 15) >> 2)) * RS + ((lane >> 4) & 1) * 32 + (lane & 3) * 8;
#pragma unroll
        for (int c = 0; c < 5; ++c)
#pragma unroll
            for (int s2 = 0; s2 < 2; ++s2) {
                u32x4 pw; pw.x = cvt_pk_bf16(s[c][8 * s2 + 0], s[c][8 * s2 + 1]); pw.y = cvt_pk_bf16(s[c][8 * s2 + 2], s[c][8 * s2 + 3]); pw.z = cvt_pk_bf16(s[c][8 * s2 + 4], s[c][8 * s2 + 5]); pw.w = cvt_pk_bf16(s[c][8 * s2 + 6], s[c][8 * s2 + 7]);
                const bf16x8 pa = __builtin_bit_cast(bf16x8, pw);
#pragma unroll
                for (int dh = 0; dh < 2; ++dh) { const LAS unsigned char* ap = vb + (32 * c + 16 * s2) * RS + dh * 64;
                    const s16x4 lo = vtr(ap), hi = vtr(ap + 8 * RS);
                    const bf16x8 vf = __builtin_shufflevector(lo, hi, 0, 1, 2, 3, 4, 5, 6, 7);
                    o[dh] = __builtin_amdgcn_mfma_f32_32x32x16_bf16(pa, vf, o[dh], 0, 0, 0); }
            }
        LAS float* lw = (LAS float*)(lds + L_LW + wid * 128);
        if (h == 0) lw[r] = __builtin_amdgcn_rcpf(l);
        LAS unsigned char* stg = lds + L_STG + wid * STG_W;
#pragma unroll
        for (int i = 0; i < 16; ++i) { const int cr = crow(i, h); const float rl = lw[cr];
            *(LAS float*)(stg + cr * STG_RS + r * 4) = o[0][i] * rl; *(LAS float*)(stg + cr * STG_RS + (32 + r) * 4) = o[1][i] * rl; }
#pragma unroll
        for (int it = 0; it < 4; ++it) { const int row = it * 8 + (lane >> 3), ch = lane & 7;
            const f32x4 a0 = *(const LAS f32x4*)(stg + row * STG_RS + ch * 32), a1 = *(const LAS f32x4*)(stg + row * STG_RS + ch * 32 + 16);
            const size_t grow = rowbase + qs + row;
            const u32x4 g = gv[it];
            const float g0 = bf_lo(g.x), g1 = bf_hi(g.x), g2 = bf_lo(g.y), g3 = bf_hi(g.y), g4 = bf_lo(g.z), g5 = bf_hi(g.z), g6 = bf_lo(g.w), g7 = bf_hi(g.w);
            const float y0 = a0[0] * g0, y1 = a0[1] * g1, y2 = a0[2] * g2, y3 = a0[3] * g3;
            const float y4 = a1[0] * g4, y5 = a1[1] * g5, y6 = a1[2] * g6, y7 = a1[3] * g7;
            float ss = (y0 * y0 + y1 * y1) + (y2 * y2 + y3 * y3) + (y4 * y4 + y5 * y5) + (y6 * y6 + y7 * y7);
            ss += __shfl_xor(ss, 1); ss += __shfl_xor(ss, 2); ss += __shfl_xor(ss, 4);
            u32x4 w; w.x = cvt_pk_bf16(y0, y1); w.y = cvt_pk_bf16(y2, y3); w.z = cvt_pk_bf16(y4, y5); w.w = cvt_pk_bf16(y6, y7);
            *(u32x4*)(y + grow * KOUT + head * 64 + ch * 8) = w;
            if (ch == 0) ssq[grow * 16 + head] = ss; }
        if (tid == 0) ubox[n & 1] = (int)nxt2;
        __syncthreads();
        u = un;
        if (u >= NUNITS) break;
    }
}
}

namespace lru {
constexpr int L_CW = 0, L_WT = 2048, L_STG = L_WT + 8192, STG_RS = 272, STG_W = 16 * STG_RS, L_END = L_STG + 8 * STG_W;
static_assert(L_END <= RING_BYTES, "lru LDS");
constexpr int NCH = SEQ / 128;

template <bool FIRST> __device__ __forceinline__ void load_x(u32x4 (&xv)[4][2], const bf16_t* __restrict__ z, size_t rowbase, int tok, int cbase) {
#pragma unroll
    for (int tap = 0; tap < 4; ++tap) { const int pos = tok - 3 + tap, posc = (FIRST && pos < 0) ? 0 : pos;
#pragma unroll
        for (int ks = 0; ks < 2; ++ks) xv[tap][ks] = *(const u32x4*)(z + (rowbase + posc) * NIN + cbase + 32 * ks); }
    if (FIRST) {
#pragma unroll
        for (int tap = 0; tap < 3; ++tap) if (tok - 3 + tap < 0) { xv[tap][0] = (u32x4){0u, 0u, 0u, 0u}; xv[tap][1] = (u32x4){0u, 0u, 0u, 0u}; }
    }
}

template <bool PAIRED>
__device__ __forceinline__ void unit(LAS unsigned char* lds, const bf16_t* __restrict__ z, bf16_t* __restrict__ y, float* __restrict__ ssq,
                                     const float* __restrict__ conv_w, const float* __restrict__ conv_b, const float* __restrict__ w_r, const float* __restrict__ b_r,
                                     const float* __restrict__ w_i, const float* __restrict__ b_i, const float* __restrict__ lam, int b, int blk,
                                     int half, unsigned* myseq, unsigned* pseq, float* mydata, float* pdata) {
    constexpr int STEP = PAIRED ? 2 : 1, NIT = NCH / STEP;
    const int tid = threadIdx.x, lane = tid & 63, fr = lane & 15, fq = lane >> 4, wid = __builtin_amdgcn_readfirstlane(tid >> 6);
    const size_t rowbase = (size_t)b * SEQ;
    LAS float* cw = (LAS float*)(lds + L_CW);
    if (tid < 320) { const int tap = tid >> 6, c = tid & 63; cw[tid] = (tap < 4) ? conv_w[tap * 1024 + blk * 64 + c] : conv_b[blk * 64 + c]; }
    bf16x8 bfr[2][4], bfi[2][4];
#pragma unroll
    for (int ks = 0; ks < 2; ++ks)
#pragma unroll
        for (int nt = 0; nt < 4; ++nt) {
            u32x4 wr_, wi_; unsigned* pr = (unsigned*)&wr_; unsigned* pi = (unsigned*)&wi_;
#pragma unroll
            for (int j = 0; j < 8; j += 2) { const size_t o0 = ((size_t)blk * 64 + 8 * fq + j + 32 * ks) * 64 + fr + 16 * nt;
                pr[j >> 1] = pk2(w_r[o0], w_r[o0 + 64]); pi[j >> 1] = pk2(w_i[o0], w_i[o0 + 64]); }
            bfr[ks][nt] = __builtin_bit_cast(bf16x8, wr_); bfi[ks][nt] = __builtin_bit_cast(bf16x8, wi_);
        }
    float nbr[4], nbi[4], sp[4], carry[4], Aown[4], Hown[4];
#pragma unroll
    for (int nt = 0; nt < 4; ++nt) { const int c = blk * 64 + fr + 16 * nt; nbr[nt] = -b_r[c] * LOG2E; nbi[nt] = -b_i[c] * LOG2E; sp[nt] = -8.0f * log1pf(expf(-lam[c])) * LOG2E; carry[nt] = 0.f; Aown[nt] = 1.f; Hown[nt] = 0.f; }
    __syncthreads();
    const int cbaseA = COL_XL + blk * 64 + 8 * fq;
    LAS unsigned char* stg = lds + L_STG + wid * STG_W;
    u32x4 xn[4][2], gn[2];
    if (wid == 0 && half == 0) load_x<true>(xn, z, rowbase, fr, cbaseA); else load_x<false>(xn, z, rowbase, 128 * half + 16 * wid + fr, cbaseA);
    const bf16_t* gbase = z + (rowbase + 128 * half + 16 * wid + (lane >> 3)) * NIN + COL_GL + blk * 64 + (lane & 7) * 8;
    gn[0] = *(const u32x4*)gbase; gn[1] = *(const u32x4*)(gbase + (size_t)8 * NIN);
    for (int kk = 0; kk < NIT; ++kk) {
        asm volatile("" ::: "memory");
        const int k = half + STEP * kk;
        const int tw = 128 * k + 16 * wid;
        bf16x8 uA[2];
#pragma unroll
        for (int ks = 0; ks < 2; ++ks) {
            float u[8];
            { const f32x4 b0 = *(const LAS f32x4*)(cw + 4 * 64 + 32 * ks + 8 * fq), b1 = *(const LAS f32x4*)(cw + 4 * 64 + 32 * ks + 8 * fq + 4);
              u[0] = b0[0]; u[1] = b0[1]; u[2] = b0[2]; u[3] = b0[3]; u[4] = b1[0]; u[5] = b1[1]; u[6] = b1[2]; u[7] = b1[3]; }
#pragma unroll
            for (int tap = 0; tap < 4; ++tap) { const f32x4 w0 = *(const LAS f32x4*)(cw + tap * 64 + 32 * ks + 8 * fq), w1 = *(const LAS f32x4*)(cw + tap * 64 + 32 * ks + 8 * fq + 4); const u32x4 xx = xn[tap][ks];
                u[0] += w0[0] * bf_lo(xx.x); u[1] += w0[1] * bf_hi(xx.x); u[2] += w0[2] * bf_lo(xx.y); u[3] += w0[3] * bf_hi(xx.y);
                u[4] += w1[0] * bf_lo(xx.z); u[5] += w1[1] * bf_hi(xx.z); u[6] += w1[2] * bf_lo(xx.w); u[7] += w1[3] * bf_hi(xx.w); }
            u32x4 pw; pw.x = cvt_pk_bf16(u[0], u[1]); pw.y = cvt_pk_bf16(u[2], u[3]); pw.z = cvt_pk_bf16(u[4], u[5]); pw.w = cvt_pk_bf16(u[6], u[7]);
            uA[ks] = __builtin_bit_cast(bf16x8, pw);
            *(LAS f32x4*)(stg + fr * STG_RS + (32 * ks + 8 * fq) * 4) = (f32x4){u[0], u[1], u[2], u[3]};
            *(LAS f32x4*)(stg + fr * STG_RS + (32 * ks + 8 * fq) * 4 + 16) = (f32x4){u[4], u[5], u[6], u[7]};
        }
        const u32x4 gc0 = gn[0], gc1 = gn[1];
        if (kk + 1 < NIT) { load_x<false>(xn, z, rowbase, tw + 128 * STEP + fr, cbaseA); const bf16_t* gp = gbase + (size_t)(128 * STEP * (kk + 1)) * NIN; gn[0] = *(const u32x4*)gp; gn[1] = *(const u32x4*)(gp + (size_t)8 * NIN); }
        float Al[4][4], Hl[4][4], At_[4], Ht_[4];
#pragma unroll
        for (int nt = 0; nt < 4; ++nt) {
            f32x4 R = {0.f, 0.f, 0.f, 0.f}, I = R;
            R = __builtin_amdgcn_mfma_f32_16x16x32_bf16(uA[0], bfr[0][nt], R, 0, 0, 0); R = __builtin_amdgcn_mfma_f32_16x16x32_bf16(uA[1], bfr[1][nt], R, 0, 0, 0);
            I = __builtin_amdgcn_mfma_f32_16x16x32_bf16(uA[0], bfi[0][nt], I, 0, 0, 0); I = __builtin_amdgcn_mfma_f32_16x16x32_bf16(uA[1], bfi[1][nt], I, 0, 0, 0);
            float A = 1.f, H = 0.f;
#pragma unroll
            for (int ip = 0; ip < 2; ++ip) {
                const f32x2 uc = {*(const LAS float*)(stg + (4 * fq + 2 * ip) * STG_RS + (fr + 16 * nt) * 4), *(const LAS float*)(stg + (4 * fq + 2 * ip + 1) * STG_RS + (fr + 16 * nt) * 4)};
                const f32x2 R2 = {R[2 * ip], R[2 * ip + 1]}, I2 = {I[2 * ip], I[2 * ip + 1]};
                const f32x2 t1 = R2 * (-LOG2E) + nbr[nt], t2 = I2 * (-LOG2E) + nbi[nt];
                f32x2 d1 = {__builtin_amdgcn_exp2f(t1.x), __builtin_amdgcn_exp2f(t1.y)}, d2 = {__builtin_amdgcn_exp2f(t2.x), __builtin_amdgcn_exp2f(t2.y)};
                d1 = d1 + 1.0f; d2 = d2 + 1.0f;
                const f32x2 dd = d1 * d2; const f32x2 inv = {__builtin_amdgcn_rcpf(dd.x), __builtin_amdgcn_rcpf(dd.y)};
                const f32x2 rg = d2 * inv, ig = d1 * inv, la = rg * sp[nt];
                const f32x2 a = {__builtin_amdgcn_exp2f(la.x), __builtin_amdgcn_exp2f(la.y)};
                const f32x2 om = 1.0f - a * a; const f32x2 sq = {__builtin_amdgcn_sqrtf(om.x), __builtin_amdgcn_sqrtf(om.y)};
                const f32x2 bb = sq * (ig * uc);
                H = a.x * H + bb.x; A = A * a.x; Al[nt][2 * ip] = A; Hl[nt][2 * ip] = H;
                H = a.y * H + bb.y; A = A * a.y; Al[nt][2 * ip + 1] = A; Hl[nt][2 * ip + 1] = H;
            }
            float pA = __shfl_up(A, 16), pH = __shfl_up(H, 16);
            if (fq >= 1) { H = A * pH + H; A = A * pA; }
            pA = __shfl_up(A, 32); pH = __shfl_up(H, 32);
            if (fq >= 2) { H = A * pH + H; A = A * pA; }
            At_[nt] = A; Ht_[nt] = H;
            if (fq == 3) *(LAS f32x2*)(lds + L_WT + (((kk & 1) * 8 + wid) * 64 + nt * 16 + fr) * 8) = (f32x2){A, H};
        }
        __syncthreads();
        float Ap[4], Hp[4];
        if constexpr (PAIRED) {
            if (wid == 0 && k + 1 < NCH) {
                unsigned long long* slotp = (unsigned long long*)mydata + (kk & 3) * 64 + fr; const unsigned tag = 0x11u + (unsigned)kk;
#pragma unroll
                for (int nt = 0; nt < 4; ++nt) {
                    float Ar = 1.f, Hr = 0.f;
#pragma unroll
                    for (int w = 0; w < 8; ++w) { const f32x2 t = *(const LAS f32x2*)(lds + L_WT + (((kk & 1) * 8 + w) * 64 + nt * 16 + fr) * 8); Hr = t.x * Hr + t.y; Ar = Ar * t.x; }
                    if (fq == 0) __hip_atomic_store(slotp + nt * 16, ((unsigned long long)__float_as_uint(Hr) << 32) | (unsigned long long)((__float_as_uint(Ar) & 0xffffff00u) | tag), __ATOMIC_RELAXED, __HIP_MEMORY_SCOPE_AGENT);
                }
            }
            if (k > 0) {
                const unsigned need = half ? (unsigned)(kk + 1) : (unsigned)kk, tag = 0x10u + need; unsigned spn = 0;
                const unsigned long long* pd = (const unsigned long long*)pdata + ((need - 1u) & 3u) * 64 + fr;
                for (;;) {
                    unsigned long long v[4]; bool ok = true;
#pragma unroll
                    for (int nt = 0; nt < 4; ++nt) { v[nt] = __hip_atomic_load(pd + nt * 16, __ATOMIC_RELAXED, __HIP_MEMORY_SCOPE_AGENT); ok = ok && (((unsigned)v[nt] & 0xffu) == tag); }
#pragma unroll
                    for (int nt = 0; nt < 4; ++nt) { Ap[nt] = __uint_as_float((unsigned)v[nt] & 0xffffff00u); Hp[nt] = __uint_as_float((unsigned)(v[nt] >> 32)); }
                    if (__all(ok) || ++spn > (1u << 20)) break;
                    __builtin_amdgcn_s_sleep(1);
                }
            } else {
#pragma unroll
                for (int nt = 0; nt < 4; ++nt) { Ap[nt] = 0.f; Hp[nt] = 0.f; }
            }
        }
#pragma unroll
        for (int nt = 0; nt < 4; ++nt) {
            float Ar = 1.f, Hr = 0.f, Ain = 1.f, Hin = 0.f;
#pragma unroll
            for (int w = 0; w < 8; ++w) { const f32x2 t = *(const LAS f32x2*)(lds + L_WT + (((kk & 1) * 8 + w) * 64 + nt * 16 + fr) * 8); if (w == wid) { Ain = Ar; Hin = Hr; } Hr = t.x * Hr + t.y; Ar = Ar * t.x; }
            float cc;
            if constexpr (PAIRED) { cc = Ap[nt] * (Aown[nt] * carry[nt] + Hown[nt]) + Hp[nt]; carry[nt] = cc; Aown[nt] = Ar; Hown[nt] = Hr; }
            else { cc = carry[nt]; carry[nt] = Ar * cc + Hr; }
            const float cin = Ain * cc + Hin;
            float eA = __shfl_up(At_[nt], 16), eH = __shfl_up(Ht_[nt], 16);
            if (fq == 0) { eA = 1.f; eH = 0.f; }
            const float hin = eA * cin + eH;
#pragma unroll
            for (int i = 0; i < 4; ++i) *(LAS float*)(stg + (4 * fq + i) * STG_RS + (fr + 16 * nt) * 4) = Hl[nt][i] + Al[nt][i] * hin;
        }
#pragma unroll
        for (int it = 0; it < 2; ++it) { const int row = it * 8 + (lane >> 3), ch = lane & 7;
            const f32x4 a0 = *(const LAS f32x4*)(stg + row * STG_RS + ch * 32), a1 = *(const LAS f32x4*)(stg + row * STG_RS + ch * 32 + 16);
            const size_t grow = rowbase + tw + row;
            const u32x4 g = it ? gc1 : gc0;
            const float y0 = a0[0] * bf_lo(g.x), y1 = a0[1] * bf_hi(g.x), y2 = a0[2] * bf_lo(g.y), y3 = a0[3] * bf_hi(g.y);
            const float y4 = a1[0] * bf_lo(g.z), y5 = a1[1] * bf_hi(g.z), y6 = a1[2] * bf_lo(g.w), y7 = a1[3] * bf_hi(g.w);
            float ss = (y0 * y0 + y1 * y1) + (y2 * y2 + y3 * y3) + (y4 * y4 + y5 * y5) + (y6 * y6 + y7 * y7);
            ss += __shfl_xor(ss, 1); ss += __shfl_xor(ss, 2); ss += __shfl_xor(ss, 4);
            u32x4 w; w.x = cvt_pk_bf16(y0, y1); w.y = cvt_pk_bf16(y2, y3); w.z = cvt_pk_bf16(y4, y5); w.w = cvt_pk_bf16(y6, y7);
            *(u32x4*)(y + grow * KOUT + 1024 + blk * 64 + ch * 8) = w;
            if (ch == 0) ssq[grow * 16 + blk] = ss; }
    }
    __syncthreads();
}
}

#define XB_TMO      128
#define XB_XCNT(j)  (256  + 64 * (j))
#define XB_XSUB(j)  (1280 + 64 * (j))
#define XB_XGEN(j)  (2304 + 64 * (j))
#define XB_TOP      3328
#define XB_TOPGEN   3392
#define XCD_BAR_WORDS 3456
#define XB_SPIN_CAP (1u << 18)
__device__ __forceinline__ unsigned xb_ld(unsigned* p)              { return __hip_atomic_load(p, __ATOMIC_RELAXED, __HIP_MEMORY_SCOPE_AGENT); }
__device__ __forceinline__ unsigned xb_add(unsigned* p, unsigned v) { return __hip_atomic_fetch_add(p, v, __ATOMIC_RELAXED, __HIP_MEMORY_SCOPE_AGENT); }
__device__ __forceinline__ unsigned xb_xcc_id() { return (unsigned)__builtin_amdgcn_s_getreg((3 << 11) | 20) & 0xFu; }
#define XB_SPIN(cond, bar) do { unsigned _sp = 0; while (cond) { __builtin_amdgcn_s_sleep(1); \
    if ((++_sp & 255u) == 0u) { if (xb_ld(&(bar)[XB_TMO])) break; if (_sp > XB_SPIN_CAP) { atomicAdd(&(bar)[XB_TMO], 1u); break; } } } } while (0)
struct XcdBarrier { unsigned* bar; unsigned x; volatile LAS unsigned* st; };
__device__ __forceinline__ XcdBarrier xcd_barrier_post(unsigned* bar, volatile LAS unsigned* st) {
    XcdBarrier b; b.bar = bar; b.x = xb_xcc_id(); b.st = st;
    if (threadIdx.x == 0) (void)xb_add(&bar[XB_XCNT(b.x)], 1u);
    return b;
}
__device__ __forceinline__ void xcd_barrier_complete(unsigned* bar, unsigned x, unsigned& nloc, unsigned& nx) {
    const unsigned G = gridDim.x * gridDim.y * gridDim.z;
    unsigned sum, cnt, mine, sp = 0u;
    for (;;) {
        sum = 0u; cnt = 0u; mine = 0u;
#pragma unroll
        for (unsigned j = 0; j < 16; ++j) { const unsigned c = xb_ld(&bar[XB_XCNT(j)]); sum += c; cnt += (c > 0u) ? 1u : 0u; mine = (j == x) ? c : mine; }
        if (sum == G) break;
        __builtin_amdgcn_s_sleep(1);
        if ((++sp & 255u) == 0u) { if (xb_ld(&bar[XB_TMO])) break; if (sp > XB_SPIN_CAP) { atomicAdd(&bar[XB_TMO], 1u); break; } }
    }
    nloc = mine > 0u ? mine : 1u; nx = cnt > 0u ? cnt : 1u;
}
__device__ __forceinline__ void xcd_barrier(const XcdBarrier& b) {
    asm volatile("s_waitcnt vmcnt(0)" ::: "memory");
    __syncthreads();
    if (threadIdx.x == 0) {
        unsigned* bar = b.bar;
        __builtin_amdgcn_s_waitcnt(0);
        unsigned nloc = b.st[0], nx = b.st[1];
        if (nloc == 0u) { xcd_barrier_complete(bar, b.x, nloc, nx); b.st[0] = nloc; b.st[1] = nx; }
        const unsigned old = xb_add(&bar[XB_XSUB(b.x)], 1u);
        const unsigned gen = old / nloc;
        if (old + 1u == (gen + 1u) * nloc) {
            __builtin_amdgcn_fence(__ATOMIC_RELEASE, "agent");
            asm volatile("s_waitcnt vmcnt(0)" ::: "memory");
            const unsigned og = xb_add(&bar[XB_TOP], 1u);
            const unsigned tg = og / nx;
            if (og + 1u == (tg + 1u) * nx) xb_add(&bar[XB_TOPGEN], 1u);
            else XB_SPIN(xb_ld(&bar[XB_TOPGEN]) == tg, bar);
            __builtin_amdgcn_fence(__ATOMIC_ACQUIRE, "agent");
            xb_add(&bar[XB_XGEN(b.x)], 1u);
            asm volatile("s_waitcnt vmcnt(0)" ::: "memory");
        } else {
            XB_SPIN(xb_ld(&bar[XB_XGEN(b.x)]) == gen, bar);
            __builtin_amdgcn_fence(__ATOMIC_ACQUIRE, "agent");
            asm volatile("s_waitcnt vmcnt(0)" ::: "memory");
        }
    }
    __syncthreads();
}

struct Params {
    const float* x; const float* ln_gain; const float* w_in; const float* sinks; const float* conv_w; const float* conv_b;
    const float* w_r; const float* b_r; const float* w_i; const float* b_i; const float* lam; const float* ga; const float* gl; const float* w_out; const float* fg;
    float* out; unsigned char* ws; int ph_lo, ph_hi;
};

__global__ void __launch_bounds__(512, 2) mega(Params p) {
    extern __shared__ __attribute__((aligned(16))) unsigned char lds_raw[];
    LAS unsigned char* lds = (LAS unsigned char*)lds_raw;
    const int tid = threadIdx.x, lane = tid & 63, wave = __builtin_amdgcn_readfirstlane(tid >> 6);
    const int G = gridDim.x, bx = blockIdx.x;
    unsigned char* ws = p.ws;
    unsigned* ctl = (unsigned*)(ws + WS_CTL);
    bf16_t* WinT = (bf16_t*)(ws + WS_WIN); bf16_t* WoutT = (bf16_t*)(ws + WS_WOUT);
    float* cs = (float*)(ws + WS_CS); float* sn = (float*)(ws + WS_SN);
    float* ssqa = (float*)(ws + WS_SSQA); float* ssql = (float*)(ws + WS_SSQL); float* pss = (float*)(ws + WS_PSS);
    bf16_t* XN = (bf16_t*)(ws + WS_XN); bf16_t* Y = (bf16_t*)(ws + WS_Y); bf16_t* Z = (bf16_t*)(ws + WS_Z);
    const int lo = p.ph_lo, hi = p.ph_hi;
#define IN(k) (lo <= (k) && (k) < hi)
    if (tid < 32) ((LAS unsigned*)(lds + MISC_OFF))[tid] = 0u;
    __syncthreads();
    XcdBarrier bar; bar.bar = ctl + CW_BAR; bar.x = 0; bar.st = nullptr;
    if (hi - lo > 1) bar = xcd_barrier_post(ctl + CW_BAR, (volatile LAS unsigned*)(lds + MISC_OFF) + 8);
    if (hi > 1000) cg::this_grid().sync();
#define SEAM(k) do { if (IN(k) && IN((k) + 1)) { for (int rs_ = 0; rs_ < REP_SYNC; ++rs_) xcd_barrier(bar); } } while (0)

    if (IN(0)) for (int rep = 0; rep < REP_P0; ++rep) {
        LAS float* scr = (LAS float*)(lds + wave * 16384);
        const int gw = bx * 8 + wave, NGW = G * 8;
        constexpr int I_IN = (DM / 64) * (NIN / 32), I_OUT = (KOUT / 64) * (DM / 32);
        for (int it = gw; it < I_IN + I_OUT; it += NGW) {
            if (it < I_IN) p0_transpose_item(p.w_in, DM, NIN, WinT, nullptr, scr, it, lane);
            else { const int r = it - I_IN; const int kb = r / (DM / 32); p0_transpose_item(p.w_out, KOUT, DM, WoutT, (kb < 16) ? p.ga : (p.gl - 1024), scr, r, lane); }
        }
        for (int e = bx * 512 + tid; e < SEQ * 8; e += G * 512) {
            const int pos = e >> 3, i = e & 7;
            const double invf = (i == 0) ? 1.0 : (i == 1) ? 0.19392274474868576 : (i == 2) ? 0.03760603093086393 : (i == 3) ? 0.007292664737217109 : (i == 4) ? 0.001414213562373095
                              : (i == 5) ? 0.0002742481756762073 : (i == 6) ? 5.318295896944988e-05 : 1.031338537721246e-05;
            double s, c; sincos_d((double)pos * invf, s, c); cs[e] = (float)c; sn[e] = (float)s;
        }
        {
            const f32x4* gr = (const f32x4*)p.ln_gain + lane;
            f32x4 gq[4];
#pragma unroll
            for (int j = 0; j < 4; ++j) gq[j] = gr[64 * j];
            for (int m0 = gw * 4; m0 < M_TOK; m0 += NGW * 4) {
                f32x4 v[4][4]; float s2[4];
#pragma unroll
                for (int rr = 0; rr < 4; ++rr) { const f32x4* xr = (const f32x4*)(p.x + (size_t)(m0 + rr) * DM) + lane;
#pragma unroll
                    for (int j = 0; j < 4; ++j) v[rr][j] = __builtin_nontemporal_load(xr + 64 * j); }
#pragma unroll
                for (int rr = 0; rr < 4; ++rr) { float t = 0.f;
#pragma unroll
                    for (int j = 0; j < 4; ++j) t += (v[rr][j].x * v[rr][j].x + v[rr][j].y * v[rr][j].y) + (v[rr][j].z * v[rr][j].z + v[rr][j].w * v[rr][j].w);
                    s2[rr] = t; }
#pragma unroll
                for (int o = 1; o < 64; o <<= 1) {
#pragma unroll
                    for (int rr = 0; rr < 4; ++rr) s2[rr] += __shfl_xor(s2[rr], o); }
#pragma unroll
                for (int rr = 0; rr < 4; ++rr) { const float rstd = 1.0f / sqrtf(s2[rr] * (1.f / DM) + EPS);
                    u32x2* o8 = (u32x2*)(XN + (size_t)(m0 + rr) * DM) + lane;
#pragma unroll
                    for (int j = 0; j < 4; ++j) { const f32x4 g = gq[j]; u32x2 w; w.x = cvt_pk_bf16(v[rr][j].x * rstd * g.x, v[rr][j].y * rstd * g.y); w.y = cvt_pk_bf16(v[rr][j].z * rstd * g.z, v[rr][j].w * rstd * g.w); o8[64 * j] = w; } }
            }
        }
    }
    SEAM(0);

    if (IN(1)) {
        pg8::Gemm g{XN, WinT, M_TOK, NIN, DM}; pg8::StaticOrder S; S.init(M_TOK, NIN, G, bx, REP_P1);
        EpiZ E{Z, cs, sn};
        pg8::gemm_phase<EpiZ, pg8::StaticOrder, true>(lds, g, S, E);
    }
    SEAM(1);

    if (IN(2)) {
        {
            const int uu = bx & 127, half = (bx >> 7) & 1;
            unsigned* sq = ctl + CW_LRU + uu * 128; float* mb = (float*)(ws + WS_MB) + uu * 1024;
            lru::unit<true>(lds, Z, Y, ssql, p.conv_w, p.conv_b, p.w_r, p.b_r, p.w_i, p.b_i, p.lam, uu >> 4, uu & 15, half, sq + 64 * half, sq + 64 * (half ^ 1), mb + 512 * half, mb + 512 * (half ^ 1));
        }
        LAS int* ubox = (LAS int*)(lds + MISC_OFF);
        for (int rep = 0; rep < REP_P2A; ++rep) { att::run(lds, Z, Y, ssqa, p.sinks, ctl + 64 + 64 * rep, ubox); __syncthreads(); }
    }
    SEAM(2);

    if (IN(3)) {
        pg8::Gemm g{Y, WoutT, M_TOK, DM, KOUT}; pg8::StaticOrder S; S.init(M_TOK, DM, G, bx, REP_P3);
        LAS f32x2* RS = (LAS f32x2*)(lds + RS_OFF);
        pg8::Unit u;
        for (int i = 0; i < 4 && S.next(i, u); ++i) {
            if (tid < 256) { const size_t row = (size_t)u.pm * 256 + tid; const f32x4* pa = (const f32x4*)(ssqa + row * 16); const f32x4* pl = (const f32x4*)(ssql + row * 16);
                float sa = 0.f, sl = 0.f;
#pragma unroll
                for (int j = 0; j < 4; ++j) { const f32x4 a = pa[j], l = pl[j]; sa += (a.x + a.y) + (a.z + a.w); sl += (l.x + l.y) + (l.z + l.w); }
                const float rA = 1.0f / sqrtf(sa * (1.f / 1024.f) + EPS), rB = 1.0f / sqrtf(sl * (1.f / 1024.f) + EPS);
                RS[i * 256 + tid] = (f32x2){rA / rB, rB}; }
        }
        __syncthreads();
        EpiOutF E{p.x, p.out, p.fg, pss, ctl + CW_PANEL, RS, (LAS float*)(lds + RS_OFF + 8192), (LAS float*)(lds + RS_OFF + 8192 + 4096)};
        pg8::gemm_phase<EpiOutF, pg8::StaticOrder, true>(lds, g, S, E);
    }
    SEAM(3);

    if (IN(4)) {
        const int gw = bx * 8 + wave, NGW = G * 8;
        const f32x4* fgr = (const f32x4*)p.fg + lane;
        for (int rep = 0; rep < REP_P4; ++rep)
        for (int m = gw; m < M_TOK; m += NGW) {
            float s2 = (lane < 16) ? pss[(size_t)m * 16 + lane] : 0.f;
            s2 += __shfl_xor(s2, 1); s2 += __shfl_xor(s2, 2); s2 += __shfl_xor(s2, 4); s2 += __shfl_xor(s2, 8);
            s2 = __shfl(s2, 0);
            float rstd = 1.0f / sqrtf(s2 * (1.f / DM) + EPS);
            if (rep > 0) rstd = 1.0f;
            f32x4* orow = (f32x4*)(p.out + (size_t)m * DM) + lane;
#pragma unroll
            for (int j = 0; j < 4; ++j) { const f32x4 t = orow[64 * j]; f32x4 g = fgr[64 * j]; if (rep > 0) g = (f32x4){1.f, 1.f, 1.f, 1.f}; orow[64 * j] = t * rstd * g; }
        }
    }
#undef IN
#undef SEAM
}

extern "C" void kernel_launch(void* const* d_in, const int* in_sizes, int n_in, void* d_out, int out_size, void* d_ws, size_t ws_size, hipStream_t stream) {
    static int grid = 0;
    if (grid == 0) {
        if (n_in != 15 || in_sizes[0] != M_TOK * DM || out_size != M_TOK * DM || ws_size < WS_END) { fprintf(stderr, "kernel_launch: unexpected shapes (n_in %d, ws %zu)\n", n_in, ws_size); grid = -1; return; }
        int dev = 0, cus = 0, per_cu = 0;
        (void)hipGetDevice(&dev); (void)hipDeviceGetAttribute(&cus, hipDeviceAttributeMultiprocessorCount, dev);
        if (hipFuncSetAttribute((const void*)mega, hipFuncAttributeMaxDynamicSharedMemorySize, LDS_BYTES) != hipSuccess) { fprintf(stderr, "kernel_launch: hipFuncSetAttribute failed\n"); grid = -1; return; }
        if (hipOccupancyMaxActiveBlocksPerMultiprocessor(&per_cu, (const void*)mega, 512, LDS_BYTES) != hipSuccess || per_cu < 1) { fprintf(stderr, "kernel_launch: occupancy query says %d\n", per_cu); per_cu = 1; }
        (void)hipGetLastError();
        grid = 256;
        if (cus * per_cu < 256) fprintf(stderr, "kernel_launch: device capacity %d x %d < 256 workgroups\n", cus, per_cu);
    }
    if (grid < 0) return;
    (void)hipMemsetAsync((char*)d_ws + WS_CTL, 0, 131072 + 524288, stream);
    Params p{};
    p.x = (const float*)d_in[0]; p.ln_gain = (const float*)d_in[1]; p.w_in = (const float*)d_in[2]; p.sinks = (const float*)d_in[3]; p.conv_w = (const float*)d_in[4]; p.conv_b = (const float*)d_in[5];
    p.w_r = (const float*)d_in[6]; p.b_r = (const float*)d_in[7]; p.w_i = (const float*)d_in[8]; p.b_i = (const float*)d_in[9]; p.lam = (const float*)d_in[10]; p.ga = (const float*)d_in[11]; p.gl = (const float*)d_in[12];
    p.w_out = (const float*)d_in[13]; p.fg = (const float*)d_in[14]; p.out = (float*)d_out; p.ws = (unsigned char*)d_ws;
    if (MK_N_LAUNCHES == 1) {
        p.ph_lo = 0; p.ph_hi = 4; void* args[] = {&p};
        hipError_t e = hipLaunchCooperativeKernel((const void*)mega, dim3(grid), dim3(512), args, LDS_BYTES, stream);
        if (e != hipSuccess) fprintf(stderr, "kernel_launch: cooperative launch failed: %s (grid %d)\n", hipGetErrorString(e), grid);
    } else {
        for (int ph = 0; ph < 4; ++ph) { p.ph_lo = ph; p.ph_hi = ph + 1; hipLaunchKernelGGL(mega, dim3(grid), dim3(512), LDS_BYTES, stream, p); }
    }
}
```

```cpp
#include <hip/hip_runtime.h>
#include <hip/hip_cooperative_groups.h>
#include <cstdio>
#include <cstdint>
namespace cg = cooperative_groups;

#ifndef MK_N_LAUNCHES
#define MK_N_LAUNCHES 1
#endif

#ifndef REP_P0
#define REP_P0 1
#endif
#ifndef REP_P1
#define REP_P1 1
#endif
#ifndef REP_P2L
#define REP_P2L 1
#endif
#ifndef REP_P2A
#define REP_P2A 1
#endif
#ifndef REP_P3
#define REP_P3 1
#endif
#ifndef REP_P4
#define REP_P4 1
#endif
#ifndef REP_SYNC
#define REP_SYNC 1
#endif
#ifndef P1_WGM
#define P1_WGM 2
#endif
#ifndef PROBE_SEAM
#define PROBE_SEAM -1
#endif
#ifndef PROBE_X_US
#define PROBE_X_US 0
#endif

#define LAS __attribute__((address_space(3)))
typedef unsigned short bf16_t;
typedef short bf16x8 __attribute__((ext_vector_type(8)));
typedef short s16x4 __attribute__((ext_vector_type(4)));
typedef float f32x4 __attribute__((ext_vector_type(4)));
typedef float f32x2 __attribute__((ext_vector_type(2)));
typedef float f32x16 __attribute__((ext_vector_type(16)));
typedef unsigned u32x4 __attribute__((ext_vector_type(4)));
typedef unsigned u32x2 __attribute__((ext_vector_type(2)));

constexpr int SEQ = 4096, NB = 8, M_TOK = NB * SEQ, DM = 1024, NIN = 4608, KOUT = 2048;
constexpr int COL_Q = 0, COL_K = 1024, COL_V = 1280, COL_GA = 1536, COL_XL = 2560, COL_GL = 3584;
constexpr float EPS = 1e-6f;
constexpr float LOG2E = 1.4426950408889634f;
constexpr float C2 = 0.125f * LOG2E;

constexpr size_t MiB = 1u << 20;
constexpr size_t WS_CTL = 0;
constexpr int CW_BAR = 1024;
constexpr int CW_PANEL = 8192;
constexpr int CW_LRU = 16384;
constexpr size_t WS_WIN = 2 * MiB;
constexpr size_t WS_WOUT = 12 * MiB;
constexpr size_t WS_CS = 16 * MiB;
constexpr size_t WS_SN = 16 * MiB + 128 * 1024;
constexpr size_t WS_MB = 128 * 1024;
constexpr size_t WS_SSQA = 17 * MiB;
constexpr size_t WS_SSQL = 19 * MiB;
constexpr size_t WS_PSS = 21 * MiB;
constexpr size_t WS_XN = 32 * MiB;
constexpr size_t WS_Y = 32 * MiB;
constexpr size_t WS_Z = 160 * MiB;
constexpr size_t WS_END = 448 * MiB;

constexpr int RING_BYTES = 131072;
constexpr int MISC_OFF = RING_BYTES;
constexpr int RS_OFF = RING_BYTES + 512;
constexpr int LDS_BYTES = 147456;

#define LDS_BARRIER() asm volatile("s_waitcnt lgkmcnt(0)\n\ts_barrier" ::: "memory")
__device__ __forceinline__ unsigned cvt_pk_bf16(float lo, float hi) { unsigned r; asm volatile("v_cvt_pk_bf16_f32 %0, %1, %2" : "=v"(r) : "v"(lo), "v"(hi)); return r; }
__device__ __forceinline__ float bf_lo(unsigned w) { return __uint_as_float(w << 16); }
__device__ __forceinline__ float bf_hi(unsigned w) { return __uint_as_float(w & 0xffff0000u); }
__device__ __forceinline__ unsigned f2bf(float f) { unsigned u = __float_as_uint(f); return (u + 0x7fffu + ((u >> 16) & 1u)) >> 16; }
__device__ __forceinline__ unsigned pk2(float lo, float hi) { return f2bf(lo) | (f2bf(hi) << 16); }
__device__ __forceinline__ float fast_sigmoid(float v) { return __builtin_amdgcn_rcpf(1.0f + __builtin_amdgcn_exp2f(-v * LOG2E)); }

namespace pg8 {
constexpr int BM = 256, BK = 64, HALF = 128, HTB = HALF * BK * 2, STAGE_BYTES = 8 * HTB, NXCD = 8, WGM = 8;
__host__ __device__ __forceinline__ int lds_byte(int r, int c) { const int st = (r >> 4) * 2 + (c >> 5), rr = r & 15, cc = c & 31, ob = rr * 64 + cc * 2; return st * 1024 + (ob ^ (((ob >> 9) & 1) << 5)); }
__host__ __device__ __forceinline__ void stage_rc(int b, int& R, int& C) { const int st = b / 1024, sb = b % 1024, swz = sb ^ (((sb >> 9) & 1) << 5); R = (st >> 1) * 16 + swz / 64; C = (st & 1) * 32 + (swz % 64) / 2; }
__host__ __device__ __forceinline__ int perm32(int rho) { const int n = rho >> 4, i = rho & 15; return 8 * (i >> 2) + 4 * n + (i & 3); }

struct Unit { int pm, pn; };
struct Gemm { const bf16_t* A; const bf16_t* Bt; int M, N, K; };

struct StaticOrder {
    int nM, nN, nwg, G, c, rep, wgm;
    __host__ __device__ void init(int M, int N, int G_, int c_, int rep_ = 1, int wgm_ = WGM) { nM = M / BM; nN = N / BM; nwg = nM * nN; G = G_; c = c_; rep = rep_; wgm = wgm_; }
    __host__ __device__ bool next(int i, Unit& u) const {
        const long L = (long)i * G + c; if (L >= (long)nwg * rep) return false;
        int wgid = (int)(L % nwg); { const int q = nwg / NXCD, r = nwg % NXCD, xcd = wgid % NXCD, off = wgid / NXCD; wgid = (xcd < r ? xcd * (q + 1) : r * (q + 1) + (xcd - r) * q) + off; }
        const int nig = wgm * nN, gid = wgid / nig, fm = gid * wgm, gsz = (nM - fm) < wgm ? (nM - fm) : wgm;
        u.pm = fm + ((wgid % nig) % gsz); u.pn = (wgid % nig) / gsz; return true;
    }
};

template <class Epi, class Sched, bool ALIGN_EPI>
__device__ __forceinline__ void gemm_phase(LAS unsigned char* lds, const Gemm g, const Sched& S, const Epi& E) {
    const int tid = threadIdx.x, wid = __builtin_amdgcn_readfirstlane(tid >> 6), lane = tid & 63, wr = wid >> 2, wc = wid & 3, fr = lane & 15, fq = lane >> 4;
    const int K = g.K, nt = K / BK;
    unsigned voffA[2], voffB[2];
#pragma unroll
    for (int i = 0; i < 2; ++i) { int R, C; stage_rc(tid * 16 + i * 8192, R, C); const int Rb = Epi::PERM ? ((R & ~31) + perm32(R & 31)) : R;
        voffA[i] = (unsigned)(R * K + C) * 2u; voffB[i] = (unsigned)(Rb * K + C) * 2u; }
    const size_t kstep = (size_t)(BK * 2);
    const size_t hstep = (size_t)HALF * K * 2;
    const size_t tstep = 2 * hstep;
    const unsigned ldsw = (unsigned)wid * 1024u;
    const int aoff = lds_byte(wr * 64 + fr, fq * 8), boff = lds_byte(wc * 32 + fr, fq * 8);
#define PG8_SA(b, h) (((b) * 2 + (h)) * HTB)
#define PG8_SB(b, h) ((4 + (b) * 2 + (h)) * HTB)
#define PG8_STAGE(bufoff, gbase, voff) do { _Pragma("unroll") for (int _i = 0; _i < 2; ++_i) \
        __builtin_amdgcn_global_load_lds((const unsigned*)((const char*)(gbase) + (voff)[_i]), (LAS unsigned*)(lds + (bufoff) + ldsw + _i * 8192), 16, 0, 0); } while (0)
#define PG8_LDA(dst, b, h) do { _Pragma("unroll") for (int m = 0; m < 4; ++m) _Pragma("unroll") for (int k = 0; k < 2; ++k) dst[m][k] = *(const LAS bf16x8*)(lds + PG8_SA(b, h) + aoff + m * 2048 + k * 1024); } while (0)
#define PG8_LDB(dst, b, h) do { _Pragma("unroll") for (int n = 0; n < 2; ++n) _Pragma("unroll") for (int k = 0; k < 2; ++k) dst[n][k] = *(const LAS bf16x8*)(lds + PG8_SB(b, h) + boff + n * 2048 + k * 1024); } while (0)
#define PG8_MMA(ai, bj, At, Bt) do { __builtin_amdgcn_s_setprio(1); _Pragma("unroll") for (int m = 0; m < 4; ++m) _Pragma("unroll") for (int n = 0; n < 2; ++n) _Pragma("unroll") for (int k = 0; k < 2; ++k) \
        acc[ai][bj][m][n] = __builtin_amdgcn_mfma_f32_16x16x32_bf16(Bt[n][k], At[m][k], acc[ai][bj][m][n], 0, 0, 0); __builtin_amdgcn_s_setprio(0); } while (0)
#define PG8_WAIT_V(n) asm volatile("s_waitcnt vmcnt(" #n ")" ::: "memory")
#define PG8_WAIT_L(n) asm volatile("s_waitcnt lgkmcnt(" #n ")" ::: "memory")
#define PG8_BAR __builtin_amdgcn_s_barrier()
#define PG8_SCHED __builtin_amdgcn_sched_barrier(0)
    Unit cur, nxt; int ui = 0;
    if (!S.next(0, cur)) return;
    f32x4 acc[2][2][4][2];
#pragma unroll
    for (int a = 0; a < 2; ++a)
#pragma unroll
        for (int b = 0; b < 2; ++b)
#pragma unroll
            for (int m = 0; m < 4; ++m)
#pragma unroll
                for (int n = 0; n < 2; ++n) acc[a][b][m][n] = (f32x4){0.f, 0.f, 0.f, 0.f};
    bf16x8 At[4][2], B0[2][2], B1[2][2];
    const char* cA = (const char*)g.A + (size_t)cur.pm * tstep; const char* cB = (const char*)g.Bt + (size_t)cur.pn * tstep;
    PG8_STAGE(PG8_SB(0, 0), cB, voffB); PG8_STAGE(PG8_SB(0, 1), cB + hstep, voffB); PG8_STAGE(PG8_SA(0, 0), cA, voffA); PG8_STAGE(PG8_SA(0, 1), cA + hstep, voffA);
    if (wr == 1) PG8_BAR;
    PG8_WAIT_V(2); PG8_BAR;
    PG8_STAGE(PG8_SB(1, 0), cB + kstep, voffB); PG8_STAGE(PG8_SA(1, 0), cA + kstep, voffA); PG8_STAGE(PG8_SB(1, 1), cB + hstep + kstep, voffB);
    PG8_WAIT_V(6); PG8_BAR;
    for (;;) {
        const bool has_next = S.next(ui + 1, nxt);
        const char* nA = has_next ? (const char*)g.A + (size_t)nxt.pm * tstep : cA; const char* nB = has_next ? (const char*)g.Bt + (size_t)nxt.pn * tstep : cB;
        for (int t = 0; t < nt; t += 2) {
            const bool last = (t == nt - 2);
            const char* a1 = cA + (size_t)(t + 1) * kstep;
            const char* a2 = last ? nA : cA + (size_t)(t + 2) * kstep; const char* b2 = last ? nB : cB + (size_t)(t + 2) * kstep;
            const char* a3 = a2 + kstep; const char* b3 = b2 + kstep;
            if constexpr (Epi::MIDK > 0) { if (t == Epi::MIDK) E.mid(acc, ui, wr, fr); }
            PG8_LDB(B0, 0, 0); PG8_LDB(B1, 0, 1); PG8_SCHED; PG8_LDA(At, 0, 0); PG8_STAGE(PG8_SA(1, 1), a1 + hstep, voffA);
            PG8_WAIT_V(8); PG8_WAIT_L(0); PG8_BAR; PG8_MMA(0, 0, At, B0); PG8_MMA(0, 1, At, B1); PG8_BAR; PG8_SCHED;
            PG8_LDA(At, 0, 1); PG8_STAGE(PG8_SB(0, 0), b2, voffB); PG8_STAGE(PG8_SB(0, 1), b2 + hstep, voffB); PG8_STAGE(PG8_SA(0, 0), a2, voffA);
            PG8_WAIT_V(8); PG8_WAIT_L(0); PG8_BAR; PG8_MMA(1, 0, At, B0); PG8_MMA(1, 1, At, B1); PG8_BAR; PG8_SCHED;
            PG8_LDB(B0, 1, 0); PG8_LDB(B1, 1, 1); PG8_SCHED; PG8_LDA(At, 1, 0); PG8_STAGE(PG8_SA(0, 1), a2 + hstep, voffA);
            PG8_WAIT_V(8); PG8_WAIT_L(0); PG8_BAR; PG8_MMA(0, 0, At, B0); PG8_MMA(0, 1, At, B1); PG8_BAR; PG8_SCHED;
            PG8_LDA(At, 1, 1); PG8_STAGE(PG8_SB(1, 0), b3, voffB); PG8_STAGE(PG8_SB(1, 1), b3 + hstep, voffB); PG8_STAGE(PG8_SA(1, 0), a3, voffA);
            PG8_WAIT_V(8); PG8_WAIT_L(0); PG8_BAR; PG8_MMA(1, 0, At, B0); PG8_MMA(1, 1, At, B1); PG8_BAR; PG8_SCHED;
        }
        if constexpr (ALIGN_EPI) { if (wr == 0) PG8_BAR; }
        E(acc, cur, ui, wr, wc, fr, fq);
        if (!has_next) break;
#pragma unroll
        for (int a = 0; a < 2; ++a)
#pragma unroll
            for (int b = 0; b < 2; ++b)
#pragma unroll
                for (int m = 0; m < 4; ++m)
#pragma unroll
                    for (int n = 0; n < 2; ++n) acc[a][b][m][n] = (f32x4){0.f, 0.f, 0.f, 0.f};
        cur = nxt; cA = nA; cB = nB; ++ui;
        if constexpr (ALIGN_EPI) { if (wr == 1) PG8_BAR; }
    }
    PG8_WAIT_V(0);
    if constexpr (!ALIGN_EPI) { if (wr == 0) PG8_BAR; }
    PG8_BAR;
#undef PG8_SA
#undef PG8_SB
#undef PG8_STAGE
#undef PG8_LDA
#undef PG8_LDB
#undef PG8_MMA
#undef PG8_WAIT_V
#undef PG8_WAIT_L
#undef PG8_BAR
#undef PG8_SCHED
}
}

struct EpiZ {
    static constexpr bool PERM = true; static constexpr int MIDK = 0;
    bf16_t* Z; const float* cs; const float* sn;
    __device__ __forceinline__ void mid(f32x4 (&acc)[2][2][4][2], int ui, int wr, int fr) const {}
    __device__ __forceinline__ void operator()(const f32x4 (&acc)[2][2][4][2], const pg8::Unit& u, int ui, int wr, int wc, int fr, int fq) const {
        const int row0 = u.pm * 256 + wr * 64 + fr, col0 = u.pn * 256 + wc * 32 + 8 * fq, pn = u.pn;
        const int mode = (pn <= 4) ? 2 : (pn == 5 ? 0 : (pn <= 9 ? 1 : (pn <= 13 ? 0 : 1)));
        const bool rope = (mode == 2) && ((wc & 1) == 0);
        const float sc = (pn <= 3) ? C2 : 1.f;
        const float sgn = (fq == 0) ? -1.f : 1.f;
        if (rope) {
            const bool lo = (fq & 1) == 0;
#pragma unroll
            for (int ai = 0; ai < 2; ++ai) {
                f32x4 cc[4][2], ss_[4][2];
#pragma unroll
                for (int m = 0; m < 4; ++m) { const int pos = (row0 + ai * 128 + m * 16) & (SEQ - 1);
                    if (fq < 2) { cc[m][0] = *(const f32x4*)(cs + pos * 8); cc[m][1] = *(const f32x4*)(cs + pos * 8 + 4); ss_[m][0] = *(const f32x4*)(sn + pos * 8) * sgn; ss_[m][1] = *(const f32x4*)(sn + pos * 8 + 4) * sgn; }
                    else { cc[m][0] = (f32x4){1.f, 1.f, 1.f, 1.f}; cc[m][1] = cc[m][0]; ss_[m][0] = (f32x4){0.f, 0.f, 0.f, 0.f}; ss_[m][1] = ss_[m][0]; } }
#pragma unroll
                for (int m = 0; m < 4; ++m) {
                    bf16_t* rowp = Z + (size_t)(row0 + ai * 128 + m * 16) * NIN + col0;
#pragma unroll
                    for (int bj = 0; bj < 2; ++bj) {
                        f32x4 v0 = acc[ai][bj][m][0], v1 = acc[ai][bj][m][1], p0, p1;
#pragma unroll
                        for (int k = 0; k < 4; ++k) {
                            const auto r0 = __builtin_amdgcn_permlane16_swap(__float_as_uint(v0[k]), __float_as_uint(v0[k]), false, false);
                            const auto r1 = __builtin_amdgcn_permlane16_swap(__float_as_uint(v1[k]), __float_as_uint(v1[k]), false, false);
                            p0[k] = __uint_as_float(lo ? r0[1] : r0[0]); p1[k] = __uint_as_float(lo ? r1[1] : r1[0]); }
                        v0 = (v0 * cc[m][0] + p0 * ss_[m][0]) * sc; v1 = (v1 * cc[m][1] + p1 * ss_[m][1]) * sc;
                        u32x4 w; w.x = cvt_pk_bf16(v0[0], v0[1]); w.y = cvt_pk_bf16(v0[2], v0[3]); w.z = cvt_pk_bf16(v1[0], v1[1]); w.w = cvt_pk_bf16(v1[2], v1[3]);
                        __builtin_nontemporal_store(w, (u32x4*)(rowp + bj * 128));
                    }
                }
            }
            return;
        }
#pragma unroll
        for (int ai = 0; ai < 2; ++ai)
#pragma unroll
            for (int m = 0; m < 4; ++m) {
                bf16_t* rowp = Z + (size_t)(row0 + ai * 128 + m * 16) * NIN + col0;
#pragma unroll
                for (int bj = 0; bj < 2; ++bj) {
                    f32x4 v0 = acc[ai][bj][m][0], v1 = acc[ai][bj][m][1];
                    if (mode == 1) {
#pragma unroll
                        for (int k = 0; k < 4; ++k) {
                            const float da = 1.0f + __builtin_amdgcn_exp2f(fminf(-v0[k] * LOG2E, 60.f)), db = 1.0f + __builtin_amdgcn_exp2f(fminf(-v1[k] * LOG2E, 60.f));
                            const float inv = __builtin_amdgcn_rcpf(da * db); v0[k] = v0[k] * (db * inv); v1[k] = v1[k] * (da * inv); }
                    }
                    v0 = v0 * sc; v1 = v1 * sc;
                    u32x4 w; w.x = cvt_pk_bf16(v0[0], v0[1]); w.y = cvt_pk_bf16(v0[2], v0[3]); w.z = cvt_pk_bf16(v1[0], v1[1]); w.w = cvt_pk_bf16(v1[2], v1[3]);
                    __builtin_nontemporal_store(w, (u32x4*)(rowp + bj * 128));
                }
            }
    }
};

struct EpiOut {
    static constexpr bool PERM = false; static constexpr int MIDK = 16;
    const float* x; float* out; float* pss; LAS const f32x2* RS;
    __device__ __forceinline__ void mid(f32x4 (&acc)[2][2][4][2], int ui, int wr, int fr) const {
#pragma unroll
        for (int ai = 0; ai < 2; ++ai)
#pragma unroll
            for (int m = 0; m < 4; ++m) { const float ratio = RS[(ui & 3) * 256 + ai * 128 + wr * 64 + m * 16 + fr].x;
#pragma unroll
                for (int bj = 0; bj < 2; ++bj)
#pragma unroll
                    for (int n = 0; n < 2; ++n) acc[ai][bj][m][n] = acc[ai][bj][m][n] * ratio; }
    }
    __device__ __forceinline__ void operator()(const f32x4 (&acc)[2][2][4][2], const pg8::Unit& u, int ui, int wr, int wc, int fr, int fq) const {
        const int col0 = u.pn * 256 + wc * 32 + 4 * fq;
#pragma unroll
        for (int ai = 0; ai < 2; ++ai)
#pragma unroll
            for (int m = 0; m < 4; ++m) {
                const int lr = ai * 128 + wr * 64 + m * 16 + fr; const float rB = RS[(ui & 3) * 256 + lr].y;
                const size_t off = (size_t)(u.pm * 256 + lr) * DM + col0; float ss = 0.f;
#pragma unroll
                for (int bj = 0; bj < 2; ++bj)
#pragma unroll
                    for (int n = 0; n < 2; ++n) { const f32x4 xb = *(const f32x4*)(x + off + bj * 128 + n * 16); const f32x4 o = xb + acc[ai][bj][m][n] * rB;
                        ss += (o[0] * o[0] + o[1] * o[1]) + (o[2] * o[2] + o[3] * o[3]); *(f32x4*)(out + off + bj * 128 + n * 16) = o; }
                ss += __shfl_xor(ss, 16); ss += __shfl_xor(ss, 32);
                if (fq == 0) pss[(size_t)(u.pm * 256 + lr) * 16 + u.pn * 4 + wc] = ss;
            }
    }
};

struct EpiOutF {
    static constexpr bool PERM = false; static constexpr int MIDK = 16;
    const float* x; float* out; const float* fg; float* xbuf; unsigned* cnt; LAS const f32x2* RS; LAS float* PP; LAS float* SS;
    __device__ __forceinline__ void mid(f32x4 (&acc)[2][2][4][2], int ui, int wr, int fr) const {
#pragma unroll
        for (int ai = 0; ai < 2; ++ai)
#pragma unroll
            for (int m = 0; m < 4; ++m) { const float ratio = RS[(ui & 3) * 256 + ai * 128 + wr * 64 + m * 16 + fr].x;
#pragma unroll
                for (int bj = 0; bj < 2; ++bj)
#pragma unroll
                    for (int n = 0; n < 2; ++n) acc[ai][bj][m][n] = acc[ai][bj][m][n] * ratio; }
    }
    __device__ __forceinline__ void operator()(f32x4 (&acc)[2][2][4][2], const pg8::Unit& u, int ui, int wr, int wc, int fr, int fq) const {
        const int tid = threadIdx.x, lane = tid & 63, wid = __builtin_amdgcn_readfirstlane(tid >> 6);
        const int col0 = u.pn * 256 + wc * 32 + 4 * fq;
#pragma unroll
        for (int ai = 0; ai < 2; ++ai) {
            f32x4 xb[4][2][2];
#pragma unroll
            for (int m = 0; m < 4; ++m) { const size_t off = (size_t)(u.pm * 256 + ai * 128 + wr * 64 + m * 16 + fr) * DM + col0;
#pragma unroll
                for (int bj = 0; bj < 2; ++bj)
#pragma unroll
                    for (int n = 0; n < 2; ++n) xb[m][bj][n] = *(const f32x4*)(x + off + bj * 128 + n * 16); }
            asm volatile("" ::: "memory");
            float ssv[4];
#pragma unroll
            for (int m = 0; m < 4; ++m) { const int lr = ai * 128 + wr * 64 + m * 16 + fr; const float rB = RS[(ui & 3) * 256 + lr].y; float ss = 0.f;
#pragma unroll
                for (int bj = 0; bj < 2; ++bj)
#pragma unroll
                    for (int n = 0; n < 2; ++n) { const f32x4 o = xb[m][bj][n] + acc[ai][bj][m][n] * rB; ss += (o[0] * o[0] + o[1] * o[1]) + (o[2] * o[2] + o[3] * o[3]); acc[ai][bj][m][n] = o; }
                ssv[m] = ss; }
#pragma unroll
            for (int m = 0; m < 4; ++m) ssv[m] += __shfl_xor(ssv[m], 16);
#pragma unroll
            for (int m = 0; m < 4; ++m) ssv[m] += __shfl_xor(ssv[m], 32);
            if (fq == 0) {
#pragma unroll
                for (int m = 0; m < 4; ++m) PP[(ai * 128 + wr * 64 + m * 16 + fr) * 4 + wc] = ssv[m]; }
        }
        asm volatile("s_waitcnt lgkmcnt(0)" ::: "memory"); __builtin_amdgcn_s_barrier(); asm volatile("" ::: "memory");
        unsigned* pc = cnt + 64 * u.pm;
        if (tid < 256) { const f32x4 pp = *(const LAS f32x4*)(PP + tid * 4); const float tp = (pp[0] + pp[1]) + (pp[2] + pp[3]);
            __hip_atomic_store(xbuf + (size_t)(u.pm * 256 + tid) * 4 + u.pn, tp, __ATOMIC_RELAXED, __HIP_MEMORY_SCOPE_AGENT); }
        asm volatile("s_waitcnt vmcnt(0)" ::: "memory");
        if (tid < 256 && lane == 0) __hip_atomic_fetch_add(pc, 1u, __ATOMIC_RELAXED, __HIP_MEMORY_SCOPE_AGENT);
        if (wid == 0) {
            unsigned sp = 0;
            while ((unsigned)__builtin_amdgcn_readfirstlane(__hip_atomic_load(pc, __ATOMIC_RELAXED, __HIP_MEMORY_SCOPE_AGENT)) < 16u) { if (++sp > (1u << 22)) break; }
            __builtin_amdgcn_fence(__ATOMIC_ACQUIRE, "agent");
        }
        asm volatile("s_waitcnt vmcnt(0) lgkmcnt(0)" ::: "memory"); __builtin_amdgcn_s_barrier(); asm volatile("" ::: "memory");
        if (tid < 256) { const float* slot = xbuf + (size_t)(u.pm * 256 + tid) * 4; float q = 0.f;
#pragma unroll
            for (int t = 0; t < 4; ++t) q += __hip_atomic_load(slot + t, __ATOMIC_RELAXED, __HIP_MEMORY_SCOPE_AGENT);
            SS[tid] = 1.0f / sqrtf(q * (1.f / DM) + EPS); }
        asm volatile("s_waitcnt lgkmcnt(0)" ::: "memory"); __builtin_amdgcn_s_barrier(); asm volatile("" ::: "memory");
        f32x4 gv[2][2];
#pragma unroll
        for (int bj = 0; bj < 2; ++bj)
#pragma unroll
            for (int n = 0; n < 2; ++n) gv[bj][n] = *(const f32x4*)(fg + col0 + bj * 128 + n * 16);
#pragma unroll
        for (int ai = 0; ai < 2; ++ai)
#pragma unroll
            for (int m = 0; m < 4; ++m) {
                const int lr = ai * 128 + wr * 64 + m * 16 + fr; const float rs = SS[lr];
                const size_t off = (size_t)(u.pm * 256 + lr) * DM + col0;
#pragma unroll
                for (int bj = 0; bj < 2; ++bj)
#pragma unroll
                    for (int n = 0; n < 2; ++n) *(f32x4*)(out + off + bj * 128 + n * 16) = acc[ai][bj][m][n] * rs * gv[bj][n];
            }
        asm volatile("s_waitcnt lgkmcnt(0)" ::: "memory"); __builtin_amdgcn_s_barrier(); asm volatile("" ::: "memory");
    }
};

__device__ __forceinline__ float wave_sum(float v) {
#pragma unroll
    for (int o = 1; o < 64; o <<= 1) v += __shfl_xor(v, o);
    return v;
}
__device__ __forceinline__ void p0_transpose_item(const float* W, int K, int N, bf16_t* WT, const float* kscale, LAS float* scr, int item, int lane) {
    const int nblk = N / 32, kb = item / nblk, nb = item % nblk, k0 = 64 * kb, n0 = 32 * nb;
#pragma unroll
    for (int i = 0; i < 32; ++i) { const int kk = 2 * i + (lane >> 5); float v = __builtin_nontemporal_load(W + (size_t)(k0 + kk) * N + n0 + (lane & 31)); if (kscale) v *= kscale[k0 + kk]; scr[kk * 33 + (lane & 31)] = v; }
    asm volatile("s_waitcnt lgkmcnt(0)" ::: "memory");
    const int c = lane & 7;
#pragma unroll
    for (int j = 0; j < 4; ++j) { const int n = (lane >> 3) + 8 * j; const LAS float* s = scr + (8 * c) * 33 + n;
        u32x4 o; o.x = pk2(s[0 * 33], s[1 * 33]); o.y = pk2(s[2 * 33], s[3 * 33]); o.z = pk2(s[4 * 33], s[5 * 33]); o.w = pk2(s[6 * 33], s[7 * 33]);
        *(u32x4*)(WT + (size_t)(n0 + n) * K + k0 + 8 * c) = o; }
    asm volatile("s_waitcnt lgkmcnt(0)" ::: "memory");
}
__device__ __forceinline__ void sincos_d(double xx, double& s, double& c) {
    const double kq = rint(xx * 0.63661977236758134308);
    double r = fma(-kq, 1.57079632679489655800e+00, xx); r = fma(-kq, 6.12323399573676603587e-17, r);
    const int q = ((int)kq) & 3; const double r2 = r * r;
    const double sp = r * (1.0 + r2 * (-1.0 / 6.0 + r2 * (1.0 / 120.0 + r2 * (-1.0 / 5040.0 + r2 * (1.0 / 362880.0 + r2 * (-1.0 / 39916800.0 + r2 * (1.0 / 6227020800.0 + r2 * (-1.0 / 1307674368000.0))))))));
    const double cp = 1.0 + r2 * (-0.5 + r2 * (1.0 / 24.0 + r2 * (-1.0 / 720.0 + r2 * (1.0 / 40320.0 + r2 * (-1.0 / 3628800.0 + r2 * (1.0 / 479001600.0 + r2 * (-1.0 / 87178291200.0 + r2 * (1.0 / 20922789888000.0))))))));
    s = (q == 0) ? sp : (q == 1) ? cp : (q == 2) ? -sp : -cp;
    c = (q == 0) ? cp : (q == 1) ? -sp : (q == 2) ? -cp : sp;
}

namespace att {
constexpr int KV_ROWS = 192, RS = 144;
constexpr int L_K = 0, L_V = KV_ROWS * RS, L_STG = 2 * KV_ROWS * RS, STG_RS = 272, STG_W = 32 * STG_RS, L_LW = L_STG + 8 * STG_W, L_END = L_LW + 8 * 128;
static_assert(L_END <= RING_BYTES, "attention LDS");
__device__ __forceinline__ int crow(int i, int h) { return (i & 3) + 8 * (i >> 2) + 4 * h; }
__device__ __forceinline__ s16x4 vtr(LAS const unsigned char* p) { return __builtin_bit_cast(s16x4, __builtin_amdgcn_ds_read_tr16_b64_v4i16((LAS s16x4*)p)); }

constexpr int NUNITS = NB * 4 * 64;
__device__ __forceinline__ void load_kvq(u32x4 (&kreg)[3], u32x4 (&vreg)[3], bf16x8 (&qr)[4], const bf16_t* __restrict__ z, int u, int tid, int wid, int r, int h) {
    const int b = u >> 8, kvh = (u >> 6) & 3, q0 = (u & 63) * 64; const size_t rowbase = (size_t)b * SEQ;
    const int head = kvh * 4 + (wid >> 1), qs = q0 + 32 * (wid & 1);
#pragma unroll
    for (int i = 0; i < 3; ++i) { const int pidx = tid + 512 * i, row = pidx >> 3, ch = pidx & 7, pos = q0 - 128 + row;
        if (pos >= 0) { const bf16_t* src = z + (rowbase + pos) * NIN + COL_K + kvh * 64 + ch * 8; kreg[i] = *(const u32x4*)src; vreg[i] = *(const u32x4*)(src + 256); }
        else { kreg[i] = (u32x4){0u, 0u, 0u, 0u}; vreg[i] = (u32x4){0u, 0u, 0u, 0u}; } }
#pragma unroll
    for (int d0 = 0; d0 < 4; ++d0) qr[d0] = *(const bf16x8*)(z + (rowbase + qs + r) * NIN + COL_Q + head * 64 + d0 * 16 + h * 8);
}

__device__ __forceinline__ void run(LAS unsigned char* lds, const bf16_t* __restrict__ z, bf16_t* __restrict__ y, float* __restrict__ ssq, const float* __restrict__ sinks, unsigned* ctr, LAS int* ubox) {
    const int tid = threadIdx.x, lane = tid & 63, r = lane & 31, h = lane >> 5, wid = __builtin_amdgcn_readfirstlane(tid >> 6);
    const int G = gridDim.x, nper = (NUNITS + G - 1) / G;
    int u = (int)blockIdx.x * nper; const int uend = (u + nper < NUNITS) ? u + nper : NUNITS;
    if (u >= uend) return;
    float sinkv[4];
#pragma unroll
    for (int kq = 0; kq < 4; ++kq) sinkv[kq] = sinks[kq * 4 + (wid >> 1)] * LOG2E;
    u32x4 kreg[3], vreg[3]; bf16x8 qn[4];
    load_kvq(kreg, vreg, qn, z, u, tid, wid, r, h);
    for (int n = 0;; ++n) {
        const int b = u >> 8, kvh = (u >> 6) & 3, q0 = (u & 63) * 64; const size_t rowbase = (size_t)b * SEQ;
        const int head = kvh * 4 + (wid >> 1), qs = q0 + 32 * (wid & 1);
        bf16x8 qr[4];
#pragma unroll
        for (int d0 = 0; d0 < 4; ++d0) qr[d0] = qn[d0];
#pragma unroll
        for (int i = 0; i < 3; ++i) { const int pidx = tid + 512 * i, row = pidx >> 3, ch = pidx & 7;
            *(LAS u32x4*)(lds + L_K + row * RS + ch * 16) = kreg[i]; *(LAS u32x4*)(lds + L_V + row * RS + ch * 16) = vreg[i]; }
        LDS_BARRIER();
        const int un = u + 1;
        if (un < uend) load_kvq(kreg, vreg, qn, z, un, tid, wid, r, h);
        u32x4 gv[4];
#pragma unroll
        for (int it = 0; it < 4; ++it) gv[it] = *(const u32x4*)(z + (rowbase + qs + it * 8 + (lane >> 3)) * NIN + COL_GA + head * 64 + (lane & 7) * 8);
        f32x16 s[5];
        const LAS unsigned char* kb = lds + L_K + (32 * (wid & 1) + r) * RS + h * 16;
#pragma unroll
        for (int c = 0; c < 5; ++c) { f32x16 a = {0.f, 0.f, 0.f, 0.f, 0.f, 0.f, 0.f, 0.f, 0.f, 0.f, 0.f, 0.f, 0.f, 0.f, 0.f, 0.f};
#pragma unroll
            for (int d0 = 0; d0 < 4; ++d0) { const bf16x8 kf = *(const LAS bf16x8*)(kb + c * 32 * RS + d0 * 32); a = __builtin_amdgcn_mfma_f32_32x32x16_bf16(kf, qr[d0], a, 0, 0, 0); }
            s[c] = a; }
        const float sink2 = (kvh == 0) ? sinkv[0] : (kvh == 1) ? sinkv[1] : (kvh == 2) ? sinkv[2] : sinkv[3];
        float mx = -1e30f;
        if (q0 < 128) {
#pragma unroll
            for (int c = 0; c < 5; ++c)
#pragma unroll
                for (int i = 0; i < 16; ++i) { const int cr = crow(i, h), diff = 128 - 32 * c + r - cr, kp = qs - 128 + 32 * c + cr;
                    const bool valid = (diff >= 0) && (diff < 128) && (kp >= 0); const float v = valid ? s[c][i] : -1e30f; s[c][i] = v; mx = fmaxf(mx, v); }
        } else {
#pragma unroll
            for (int i = 0; i < 16; ++i) { const int cr = crow(i, h); const float v0 = (cr > r) ? s[0][i] : -1e30f, v4 = (cr <= r) ? s[4][i] : -1e30f; s[0][i] = v0; s[4][i] = v4; mx = fmaxf(mx, fmaxf(v0, v4)); }
#pragma unroll
            for (int c = 1; c < 4; ++c)
#pragma unroll
                for (int i = 0; i < 16; ++i) mx = fmaxf(mx, s[c][i]);
        }
        mx = fmaxf(mx, __shfl_xor(mx, 32));
        const float mref = fmaxf(mx, sink2);
        float lsum = 0.f;
#pragma unroll
        for (int c = 0; c < 5; ++c)
#pragma unroll
            for (int i = 0; i < 16; ++i) { const float pv = __builtin_amdgcn_exp2f(s[c][i] - mref); s[c][i] = pv; lsum += pv; }
        lsum += __shfl_xor(lsum, 32);
        const float l = lsum + __builtin_amdgcn_exp2f(sink2 - mref);
        f32x16 o[2];
        o[0] = (f32x16){0.f, 0.f, 0.f, 0.f, 0.f, 0.f, 0.f, 0.f, 0.f, 0.f, 0.f, 0.f, 0.f, 0.f, 0.f, 0.f}; o[1] = o[0];
        const LAS unsigned char* vb = lds + L_V + (32 * (wid & 1) + 4 * h + ((lane & 15) >> 2)) * RS + ((lane >> 4) & 1) * 32 + (lane & 3) * 8;
#pragma unroll
        for (int c = 0; c < 5; ++c)
#pragma unroll
            for (int s2 = 0; s2 < 2; ++s2) {
                u32x4 pw; pw.x = cvt_pk_bf16(s[c][8 * s2 + 0], s[c][8 * s2 + 1]); pw.y = cvt_pk_bf16(s[c][8 * s2 + 2], s[c][8 * s2 + 3]); pw.z = cvt_pk_bf16(s[c][8 * s2 + 4], s[c][8 * s2 + 5]); pw.w = cvt_pk_bf16(s[c][8 * s2 + 6], s[c][8 * s2 + 7]);
                const bf16x8 pa = __builtin_bit_cast(bf16x8, pw);
#pragma unroll
                for (int dh = 0; dh < 2; ++dh) { const LAS unsigned char* ap = vb + (32 * c + 16 * s2) * RS + dh * 64;
                    const s16x4 lo = vtr(ap), hi = vtr(ap + 8 * RS);
                    const bf16x8 vf = __builtin_shufflevector(lo, hi, 0, 1, 2, 3, 4, 5, 6, 7);
                    o[dh] = __builtin_amdgcn_mfma_f32_32x32x16_bf16(pa, vf, o[dh], 0, 0, 0); }
            }
        LAS float* lw = (LAS float*)(lds + L_LW + wid * 128);
        if (h == 0) lw[r] = __builtin_amdgcn_rcpf(l);
        LAS unsigned char* stg = lds + L_STG + wid * STG_W;
#pragma unroll
        for (int i = 0; i < 16; ++i) { const int cr = crow(i, h); const float rl = lw[cr];
            *(LAS float*)(stg + cr * STG_RS + r * 4) = o[0][i] * rl; *(LAS float*)(stg + cr * STG_RS + (32 + r) * 4) = o[1][i] * rl; }
#pragma unroll
        for (int it = 0; it < 4; ++it) { const int row = it * 8 + (lane >> 3), ch = lane & 7;
            const f32x4 a0 = *(const LAS f32x4*)(stg + row * STG_RS + ch * 32), a1 = *(const LAS f32x4*)(stg + row * STG_RS + ch * 32 + 16);
            const size_t grow = rowbase + qs + row;
            const u32x4 g = gv[it];
            const float g0 = bf_lo(g.x), g1 = bf_hi(g.x), g2 = bf_lo(g.y), g3 = bf_hi(g.y), g4 = bf_lo(g.z), g5 = bf_hi(g.z), g6 = bf_lo(g.w), g7 = bf_hi(g.w);
            const float y0 = a0[0] * g0, y1 = a0[1] * g1, y2 = a0[2] * g2, y3 = a0[3] * g3;
            const float y4 = a1[0] * g4, y5 = a1[1] * g5, y6 = a1[2] * g6, y7 = a1[3] * g7;
            float ss = (y0 * y0 + y1 * y1) + (y2 * y2 + y3 * y3) + (y4 * y4 + y5 * y5) + (y6 * y6 + y7 * y7);
            ss += __shfl_xor(ss, 1); ss += __shfl_xor(ss, 2); ss += __shfl_xor(ss, 4);
            u32x4 w; w.x = cvt_pk_bf16(y0, y1); w.y = cvt_pk_bf16(y2, y3); w.z = cvt_pk_bf16(y4, y5); w.w = cvt_pk_bf16(y6, y7);
            *(u32x4*)(y + grow * KOUT + head * 64 + ch * 8) = w;
            if (ch == 0) ssq[grow * 16 + head] = ss; }
        LDS_BARRIER();
        u = un;
        if (u >= uend) break;
    }
}
}

namespace lru {
constexpr int L_CW = 0, L_WT = 2048, L_STG = L_WT + 8192, STG_RS = 272, STG_W = 16 * STG_RS, L_END = L_STG + 8 * STG_W;
static_assert(L_END <= RING_BYTES, "lru LDS");
constexpr int NCH = SEQ / 128;

template <bool FIRST> __device__ __forceinline__ void load_x(u32x4 (&xv)[4][2], const bf16_t* __restrict__ z, size_t rowbase, int tok, int cbase) {
#pragma unroll
    for (int tap = 0; tap < 4; ++tap) { const int pos = tok - 3 + tap, posc = (FIRST && pos < 0) ? 0 : pos;
#pragma unroll
        for (int ks = 0; ks < 2; ++ks) xv[tap][ks] = *(const u32x4*)(z + (rowbase + posc) * NIN + cbase + 32 * ks); }
    if (FIRST) {
#pragma unroll
        for (int tap = 0; tap < 3; ++tap) if (tok - 3 + tap < 0) { xv[tap][0] = (u32x4){0u, 0u, 0u, 0u}; xv[tap][1] = (u32x4){0u, 0u, 0u, 0u}; }
    }
}

template <bool PAIRED>
__device__ __forceinline__ void unit(LAS unsigned char* lds, const bf16_t* __restrict__ z, bf16_t* __restrict__ y, float* __restrict__ ssq,
                                     const float* __restrict__ conv_w, const float* __restrict__ conv_b, const float* __restrict__ w_r, const float* __restrict__ b_r,
                                     const float* __restrict__ w_i, const float* __restrict__ b_i, const float* __restrict__ lam, int b, int blk,
                                     int half, unsigned* myseq, unsigned* pseq, float* mydata, float* pdata) {
    constexpr int STEP = PAIRED ? 2 : 1, NIT = NCH / STEP;
    const int tid = threadIdx.x, lane = tid & 63, fr = lane & 15, fq = lane >> 4, wid = __builtin_amdgcn_readfirstlane(tid >> 6);
    const size_t rowbase = (size_t)b * SEQ;
    LAS float* cw = (LAS float*)(lds + L_CW);
    if (tid < 320) { const int tap = tid >> 6, c = tid & 63; cw[tid] = (tap < 4) ? conv_w[tap * 1024 + blk * 64 + c] : conv_b[blk * 64 + c]; }
    bf16x8 bfr[2][4], bfi[2][4];
#pragma unroll
    for (int ks = 0; ks < 2; ++ks)
#pragma unroll
        for (int nt = 0; nt < 4; ++nt) {
            u32x4 wr_, wi_; unsigned* pr = (unsigned*)&wr_; unsigned* pi = (unsigned*)&wi_;
#pragma unroll
            for (int j = 0; j < 8; j += 2) { const size_t o0 = ((size_t)blk * 64 + 8 * fq + j + 32 * ks) * 64 + fr + 16 * nt;
                pr[j >> 1] = pk2(w_r[o0], w_r[o0 + 64]); pi[j >> 1] = pk2(w_i[o0], w_i[o0 + 64]); }
            bfr[ks][nt] = __builtin_bit_cast(bf16x8, wr_); bfi[ks][nt] = __builtin_bit_cast(bf16x8, wi_);
        }
    float nbr[4], nbi[4], sp[4], carry[4], Aown[4], Hown[4];
#pragma unroll
    for (int nt = 0; nt < 4; ++nt) { const int c = blk * 64 + fr + 16 * nt; nbr[nt] = -b_r[c] * LOG2E; nbi[nt] = -b_i[c] * LOG2E; sp[nt] = -8.0f * log1pf(expf(-lam[c])) * LOG2E; carry[nt] = 0.f; Aown[nt] = 1.f; Hown[nt] = 0.f; }
    __syncthreads();
    const int cbaseA = COL_XL + blk * 64 + 8 * fq;
    LAS unsigned char* stg = lds + L_STG + wid * STG_W;
    u32x4 xn[4][2], gn[2];
    if (wid == 0 && half == 0) load_x<true>(xn, z, rowbase, fr, cbaseA); else load_x<false>(xn, z, rowbase, 128 * half + 16 * wid + fr, cbaseA);
    const bf16_t* gbase = z + (rowbase + 128 * half + 16 * wid + (lane >> 3)) * NIN + COL_GL + blk * 64 + (lane & 7) * 8;
    gn[0] = *(const u32x4*)gbase; gn[1] = *(const u32x4*)(gbase + (size_t)8 * NIN);
    for (int kk = 0; kk < NIT; ++kk) {
        asm volatile("" ::: "memory");
        const int k = half + STEP * kk;
        const int tw = 128 * k + 16 * wid;
        bf16x8 uA[2];
#pragma unroll
        for (int ks = 0; ks < 2; ++ks) {
            float u[8];
            { const f32x4 b0 = *(const LAS f32x4*)(cw + 4 * 64 + 32 * ks + 8 * fq), b1 = *(const LAS f32x4*)(cw + 4 * 64 + 32 * ks + 8 * fq + 4);
              u[0] = b0[0]; u[1] = b0[1]; u[2] = b0[2]; u[3] = b0[3]; u[4] = b1[0]; u[5] = b1[1]; u[6] = b1[2]; u[7] = b1[3]; }
#pragma unroll
            for (int tap = 0; tap < 4; ++tap) { const f32x4 w0 = *(const LAS f32x4*)(cw + tap * 64 + 32 * ks + 8 * fq), w1 = *(const LAS f32x4*)(cw + tap * 64 + 32 * ks + 8 * fq + 4); const u32x4 xx = xn[tap][ks];
                u[0] += w0[0] * bf_lo(xx.x); u[1] += w0[1] * bf_hi(xx.x); u[2] += w0[2] * bf_lo(xx.y); u[3] += w0[3] * bf_hi(xx.y);
                u[4] += w1[0] * bf_lo(xx.z); u[5] += w1[1] * bf_hi(xx.z); u[6] += w1[2] * bf_lo(xx.w); u[7] += w1[3] * bf_hi(xx.w); }
            u32x4 pw; pw.x = cvt_pk_bf16(u[0], u[1]); pw.y = cvt_pk_bf16(u[2], u[3]); pw.z = cvt_pk_bf16(u[4], u[5]); pw.w = cvt_pk_bf16(u[6], u[7]);
            uA[ks] = __builtin_bit_cast(bf16x8, pw);
            *(LAS f32x4*)(stg + fr * STG_RS + (32 * ks + 8 * fq) * 4) = (f32x4){u[0], u[1], u[2], u[3]};
            *(LAS f32x4*)(stg + fr * STG_RS + (32 * ks + 8 * fq) * 4 + 16) = (f32x4){u[4], u[5], u[6], u[7]};
        }
        const u32x4 gc0 = gn[0], gc1 = gn[1];
        if (kk + 1 < NIT) { load_x<false>(xn, z, rowbase, tw + 128 * STEP + fr, cbaseA); const bf16_t* gp = gbase + (size_t)(128 * STEP * (kk + 1)) * NIN; gn[0] = *(const u32x4*)gp; gn[1] = *(const u32x4*)(gp + (size_t)8 * NIN); }
        float Al[4][4], Hl[4][4], At_[4], Ht_[4];
#pragma unroll
        for (int nt = 0; nt < 4; ++nt) {
            f32x4 R = {0.f, 0.f, 0.f, 0.f}, I = R;
            R = __builtin_amdgcn_mfma_f32_16x16x32_bf16(uA[0], bfr[0][nt], R, 0, 0, 0); R = __builtin_amdgcn_mfma_f32_16x16x32_bf16(uA[1], bfr[1][nt], R, 0, 0, 0);
            I = __builtin_amdgcn_mfma_f32_16x16x32_bf16(uA[0], bfi[0][nt], I, 0, 0, 0); I = __builtin_amdgcn_mfma_f32_16x16x32_bf16(uA[1], bfi[1][nt], I, 0, 0, 0);
            float A = 1.f, H = 0.f;
#pragma unroll
            for (int ip = 0; ip < 2; ++ip) {
                const f32x2 uc = {*(const LAS float*)(stg + (4 * fq + 2 * ip) * STG_RS + (fr + 16 * nt) * 4), *(const LAS float*)(stg + (4 * fq + 2 * ip + 1) * STG_RS + (fr + 16 * nt) * 4)};
                const f32x2 R2 = {R[2 * ip], R[2 * ip + 1]}, I2 = {I[2 * ip], I[2 * ip + 1]};
                const f32x2 t1 = R2 * (-LOG2E) + nbr[nt], t2 = I2 * (-LOG2E) + nbi[nt];
                f32x2 d1 = {__builtin_amdgcn_exp2f(t1.x), __builtin_amdgcn_exp2f(t1.y)}, d2 = {__builtin_amdgcn_exp2f(t2.x), __builtin_amdgcn_exp2f(t2.y)};
                d1 = d1 + 1.0f; d2 = d2 + 1.0f;
                const f32x2 dd = d1 * d2; const f32x2 inv = {__builtin_amdgcn_rcpf(dd.x), __builtin_amdgcn_rcpf(dd.y)};
                const f32x2 rg = d2 * inv, ig = d1 * inv, la = rg * sp[nt];
                const f32x2 a = {__builtin_amdgcn_exp2f(la.x), __builtin_amdgcn_exp2f(la.y)};
                const f32x2 om = 1.0f - a * a; const f32x2 sq = {__builtin_amdgcn_sqrtf(om.x), __builtin_amdgcn_sqrtf(om.y)};
                const f32x2 bb = sq * (ig * uc);
                H = a.x * H + bb.x; A = A * a.x; Al[nt][2 * ip] = A; Hl[nt][2 * ip] = H;
                H = a.y * H + bb.y; A = A * a.y; Al[nt][2 * ip + 1] = A; Hl[nt][2 * ip + 1] = H;
            }
            float pA = __shfl_up(A, 16), pH = __shfl_up(H, 16);
            if (fq >= 1) { H = A * pH + H; A = A * pA; }
            pA = __shfl_up(A, 32); pH = __shfl_up(H, 32);
            if (fq >= 2) { H = A * pH + H; A = A * pA; }
            At_[nt] = A; Ht_[nt] = H;
            if (fq == 3) *(LAS f32x2*)(lds + L_WT + (((kk & 1) * 8 + wid) * 64 + nt * 16 + fr) * 8) = (f32x2){A, H};
        }
        LDS_BARRIER();
        float Ap[4], Hp[4];
        if constexpr (PAIRED) {
            if (wid == 0 && k + 1 < NCH) {
                unsigned long long* slotp = (unsigned long long*)mydata + (kk & 3) * 64 + fr; const unsigned tag = 0x11u + (unsigned)kk;
#pragma unroll
                for (int nt = 0; nt < 4; ++nt) {
                    float Ar = 1.f, Hr = 0.f;
#pragma unroll
                    for (int w = 0; w < 8; ++w) { const f32x2 t = *(const LAS f32x2*)(lds + L_WT + (((kk & 1) * 8 + w) * 64 + nt * 16 + fr) * 8); Hr = t.x * Hr + t.y; Ar = Ar * t.x; }
                    if (fq == 0) __hip_atomic_store(slotp + nt * 16, ((unsigned long long)__float_as_uint(Hr) << 32) | (unsigned long long)((__float_as_uint(Ar) & 0xffffff00u) | tag), __ATOMIC_RELAXED, __HIP_MEMORY_SCOPE_AGENT);
                }
            }
            if (k > 0) {
                const unsigned need = half ? (unsigned)(kk + 1) : (unsigned)kk, tag = 0x10u + need; unsigned spn = 0;
                const unsigned long long* pd = (const unsigned long long*)pdata + ((need - 1u) & 3u) * 64 + fr;
                for (;;) {
                    unsigned long long v[4]; bool ok = true;
#pragma unroll
                    for (int nt = 0; nt < 4; ++nt) { v[nt] = __hip_atomic_load(pd + nt * 16, __ATOMIC_RELAXED, __HIP_MEMORY_SCOPE_AGENT); ok = ok && (((unsigned)v[nt] & 0xffu) == tag); }
#pragma unroll
                    for (int nt = 0; nt < 4; ++nt) { Ap[nt] = __uint_as_float((unsigned)v[nt] & 0xffffff00u); Hp[nt] = __uint_as_float((unsigned)(v[nt] >> 32)); }
                    if (__all(ok) || ++spn > (1u << 20)) break;
                }
            } else {
#pragma unroll
                for (int nt = 0; nt < 4; ++nt) { Ap[nt] = 0.f; Hp[nt] = 0.f; }
            }
        }
#pragma unroll
        for (int nt = 0; nt < 4; ++nt) {
            float Ar = 1.f, Hr = 0.f, Ain = 1.f, Hin = 0.f;
#pragma unroll
            for (int w = 0; w < 8; ++w) { const f32x2 t = *(const LAS f32x2*)(lds + L_WT + (((kk & 1) * 8 + w) * 64 + nt * 16 + fr) * 8); if (w == wid) { Ain = Ar; Hin = Hr; } Hr = t.x * Hr + t.y; Ar = Ar * t.x; }
            float cc;
            if constexpr (PAIRED) { cc = Ap[nt] * (Aown[nt] * carry[nt] + Hown[nt]) + Hp[nt]; carry[nt] = cc; Aown[nt] = Ar; Hown[nt] = Hr; }
            else { cc = carry[nt]; carry[nt] = Ar * cc + Hr; }
            const float cin = Ain * cc + Hin;
            float eA = __shfl_up(At_[nt], 16), eH = __shfl_up(Ht_[nt], 16);
            if (fq == 0) { eA = 1.f; eH = 0.f; }
            const float hin = eA * cin + eH;
#pragma unroll
            for (int i = 0; i < 4; ++i) *(LAS float*)(stg + (4 * fq + i) * STG_RS + (fr + 16 * nt) * 4) = Hl[nt][i] + Al[nt][i] * hin;
        }
#pragma unroll
        for (int it = 0; it < 2; ++it) { const int row = it * 8 + (lane >> 3), ch = lane & 7;
            const f32x4 a0 = *(const LAS f32x4*)(stg + row * STG_RS + ch * 32), a1 = *(const LAS f32x4*)(stg + row * STG_RS + ch * 32 + 16);
            const size_t grow = rowbase + tw + row;
            const u32x4 g = it ? gc1 : gc0;
            const float y0 = a0[0] * bf_lo(g.x), y1 = a0[1] * bf_hi(g.x), y2 = a0[2] * bf_lo(g.y), y3 = a0[3] * bf_hi(g.y);
            const float y4 = a1[0] * bf_lo(g.z), y5 = a1[1] * bf_hi(g.z), y6 = a1[2] * bf_lo(g.w), y7 = a1[3] * bf_hi(g.w);
            float ss = (y0 * y0 + y1 * y1) + (y2 * y2 + y3 * y3) + (y4 * y4 + y5 * y5) + (y6 * y6 + y7 * y7);
            ss += __shfl_xor(ss, 1); ss += __shfl_xor(ss, 2); ss += __shfl_xor(ss, 4);
            u32x4 w; w.x = cvt_pk_bf16(y0, y1); w.y = cvt_pk_bf16(y2, y3); w.z = cvt_pk_bf16(y4, y5); w.w = cvt_pk_bf16(y6, y7);
            *(u32x4*)(y + grow * KOUT + 1024 + blk * 64 + ch * 8) = w;
            if (ch == 0) ssq[grow * 16 + blk] = ss; }
    }
    __syncthreads();
}
}

#define XB_TMO      128
#define XB_XCNT(j)  (256  + 64 * (j))
#define XB_XSUB(j)  (1280 + 64 * (j))
#define XB_XGEN(j)  (2304 + 64 * (j))
#define XB_TOP      3328
#define XB_TOPGEN   3392
#define XCD_BAR_WORDS 3456
#define XB_SPIN_CAP (1u << 18)
__device__ __forceinline__ unsigned xb_ld(unsigned* p)              { return __hip_atomic_load(p, __ATOMIC_RELAXED, __HIP_MEMORY_SCOPE_AGENT); }
__device__ __forceinline__ unsigned xb_add(unsigned* p, unsigned v) { return __hip_atomic_fetch_add(p, v, __ATOMIC_RELAXED, __HIP_MEMORY_SCOPE_AGENT); }
__device__ __forceinline__ unsigned xb_xcc_id() { return (unsigned)__builtin_amdgcn_s_getreg((3 << 11) | 20) & 0xFu; }
#define XB_SPIN(cond, bar) do { unsigned _sp = 0; while (cond) { __builtin_amdgcn_s_sleep(1); \
    if ((++_sp & 255u) == 0u) { if (xb_ld(&(bar)[XB_TMO])) break; if (_sp > XB_SPIN_CAP) { atomicAdd(&(bar)[XB_TMO], 1u); break; } } } } while (0)
struct XcdBarrier { unsigned* bar; unsigned x; volatile LAS unsigned* st; };
__device__ __forceinline__ XcdBarrier xcd_barrier_post(unsigned* bar, volatile LAS unsigned* st) {
    XcdBarrier b; b.bar = bar; b.x = xb_xcc_id(); b.st = st;
    if (threadIdx.x == 0) (void)xb_add(&bar[XB_XCNT(b.x)], 1u);
    return b;
}
__device__ __forceinline__ void xcd_barrier_complete(unsigned* bar, unsigned x, unsigned& nloc, unsigned& nx) {
    const unsigned G = gridDim.x * gridDim.y * gridDim.z;
    unsigned sum, cnt, mine, sp = 0u;
    for (;;) {
        sum = 0u; cnt = 0u; mine = 0u;
#pragma unroll
        for (unsigned j = 0; j < 16; ++j) { const unsigned c = xb_ld(&bar[XB_XCNT(j)]); sum += c; cnt += (c > 0u) ? 1u : 0u; mine = (j == x) ? c : mine; }
        if (sum == G) break;
        __builtin_amdgcn_s_sleep(1);
        if ((++sp & 255u) == 0u) { if (xb_ld(&bar[XB_TMO])) break; if (sp > XB_SPIN_CAP) { atomicAdd(&bar[XB_TMO], 1u); break; } }
    }
    nloc = mine > 0u ? mine : 1u; nx = cnt > 0u ? cnt : 1u;
}
__device__ __forceinline__ void xcd_barrier(const XcdBarrier& b) {
    asm volatile("s_waitcnt vmcnt(0)" ::: "memory");
    __syncthreads();
    if (threadIdx.x == 0) {
        unsigned* bar = b.bar;
        __builtin_amdgcn_s_waitcnt(0);
        unsigned nloc = b.st[0], nx = b.st[1];
        if (nloc == 0u) { xcd_barrier_complete(bar, b.x, nloc, nx); b.st[0] = nloc; b.st[1] = nx; }
        const unsigned old = xb_add(&bar[XB_XSUB(b.x)], 1u);
        const unsigned gen = old / nloc;
        if (old + 1u == (gen + 1u) * nloc) {
            __builtin_amdgcn_fence(__ATOMIC_RELEASE, "agent");
            asm volatile("s_waitcnt vmcnt(0)" ::: "memory");
            const unsigned og = xb_add(&bar[XB_TOP], 1u);
            const unsigned tg = og / nx;
            if (og + 1u == (tg + 1u) * nx) xb_add(&bar[XB_TOPGEN], 1u);
            else XB_SPIN(xb_ld(&bar[XB_TOPGEN]) == tg, bar);
            __builtin_amdgcn_fence(__ATOMIC_ACQUIRE, "agent");
            xb_add(&bar[XB_XGEN(b.x)], 1u);
            asm volatile("s_waitcnt vmcnt(0)" ::: "memory");
        } else {
            XB_SPIN(xb_ld(&bar[XB_XGEN(b.x)]) == gen, bar);
            __builtin_amdgcn_fence(__ATOMIC_ACQUIRE, "agent");
            asm volatile("s_waitcnt vmcnt(0)" ::: "memory");
        }
    }
    __syncthreads();
}

struct Params {
    const float* x; const float* ln_gain; const float* w_in; const float* sinks; const float* conv_w; const float* conv_b;
    const float* w_r; const float* b_r; const float* w_i; const float* b_i; const float* lam; const float* ga; const float* gl; const float* w_out; const float* fg;
    float* out; unsigned char* ws; int ph_lo, ph_hi;
};

__global__ void __launch_bounds__(512, 2) mega(Params p) {
    extern __shared__ __attribute__((aligned(16))) unsigned char lds_raw[];
    LAS unsigned char* lds = (LAS unsigned char*)lds_raw;
    const int tid = threadIdx.x, lane = tid & 63, wave = __builtin_amdgcn_readfirstlane(tid >> 6);
    const int G = gridDim.x, bx = blockIdx.x;
    unsigned char* ws = p.ws;
    unsigned* ctl = (unsigned*)(ws + WS_CTL);
    bf16_t* WinT = (bf16_t*)(ws + WS_WIN); bf16_t* WoutT = (bf16_t*)(ws + WS_WOUT);
    float* cs = (float*)(ws + WS_CS); float* sn = (float*)(ws + WS_SN);
    float* ssqa = (float*)(ws + WS_SSQA); float* ssql = (float*)(ws + WS_SSQL); float* pss = (float*)(ws + WS_PSS);
    bf16_t* XN = (bf16_t*)(ws + WS_XN); bf16_t* Y = (bf16_t*)(ws + WS_Y); bf16_t* Z = (bf16_t*)(ws + WS_Z);
    const int lo = p.ph_lo, hi = p.ph_hi;
#define IN(k) (lo <= (k) && (k) < hi)
    if (tid < 32) ((LAS unsigned*)(lds + MISC_OFF))[tid] = 0u;
    __syncthreads();
    XcdBarrier bar; bar.bar = ctl + CW_BAR; bar.x = 0; bar.st = nullptr;
    if (hi - lo > 1) bar = xcd_barrier_post(ctl + CW_BAR, (volatile LAS unsigned*)(lds + MISC_OFF) + 8);
    if (hi > 1000) cg::this_grid().sync();
    const unsigned long long t_start = (PROBE_SEAM >= 0) ? __builtin_amdgcn_s_memrealtime() : 0ull;
#define SEAM(k) do { if (IN(k) && IN((k) + 1)) { if (PROBE_SEAM == (k)) { while (__builtin_amdgcn_s_memrealtime() - t_start < (unsigned long long)(PROBE_X_US) * 100ull) __builtin_amdgcn_s_sleep(8); } \
    for (int rs_ = 0; rs_ < REP_SYNC; ++rs_) xcd_barrier(bar); } } while (0)

    if (IN(0)) for (int rep = 0; rep < REP_P0; ++rep) {
        LAS float* scr = (LAS float*)(lds + wave * 16384);
        const int gw = bx * 8 + wave, NGW = G * 8;
        constexpr int I_IN = (DM / 64) * (NIN / 32), I_OUT = (KOUT / 64) * (DM / 32);
        if (wave < 2) for (int it = bx * 2 + wave; it < I_IN + I_OUT; it += G * 2) {
            if (it < I_IN) p0_transpose_item(p.w_in, DM, NIN, WinT, nullptr, scr, it, lane);
            else { const int r = it - I_IN; const int kb = r / (DM / 32); p0_transpose_item(p.w_out, KOUT, DM, WoutT, (kb < 16) ? p.ga : (p.gl - 1024), scr, r, lane); }
        }
        for (int e = bx * 512 + tid; e < SEQ * 8; e += G * 512) {
            const int pos = e >> 3, i = e & 7;
            const double invf = (i == 0) ? 1.0 : (i == 1) ? 0.19392274474868576 : (i == 2) ? 0.03760603093086393 : (i == 3) ? 0.007292664737217109 : (i == 4) ? 0.001414213562373095
                              : (i == 5) ? 0.0002742481756762073 : (i == 6) ? 5.318295896944988e-05 : 1.031338537721246e-05;
            double s, c; sincos_d((double)pos * invf, s, c); cs[e] = (float)c; sn[e] = (float)s;
        }
        if (wave >= 2) {
            const f32x4* gr = (const f32x4*)p.ln_gain + lane;
            f32x4 gq[4];
#pragma unroll
            for (int j = 0; j < 4; ++j) gq[j] = gr[64 * j];
            for (int m0 = (bx * 6 + wave - 2) * 4; m0 < M_TOK; m0 += G * 6 * 4) {
                f32x4 v[4][4]; float s2[4];
#pragma unroll
                for (int rr = 0; rr < 4; ++rr) { const f32x4* xr = (const f32x4*)(p.x + (size_t)(m0 + rr) * DM) + lane;
#pragma unroll
                    for (int j = 0; j < 4; ++j) v[rr][j] = __builtin_nontemporal_load(xr + 64 * j); }
#pragma unroll
                for (int rr = 0; rr < 4; ++rr) { float t = 0.f;
#pragma unroll
                    for (int j = 0; j < 4; ++j) t += (v[rr][j].x * v[rr][j].x + v[rr][j].y * v[rr][j].y) + (v[rr][j].z * v[rr][j].z + v[rr][j].w * v[rr][j].w);
                    s2[rr] = t; }
#pragma unroll
                for (int o = 1; o < 64; o <<= 1) {
#pragma unroll
                    for (int rr = 0; rr < 4; ++rr) s2[rr] += __shfl_xor(s2[rr], o); }
#pragma unroll
                for (int rr = 0; rr < 4; ++rr) { const float rstd = 1.0f / sqrtf(s2[rr] * (1.f / DM) + EPS);
                    u32x2* o8 = (u32x2*)(XN + (size_t)(m0 + rr) * DM) + lane;
#pragma unroll
                    for (int j = 0; j < 4; ++j) { const f32x4 g = gq[j]; u32x2 w; w.x = cvt_pk_bf16(v[rr][j].x * rstd * g.x, v[rr][j].y * rstd * g.y); w.y = cvt_pk_bf16(v[rr][j].z * rstd * g.z, v[rr][j].w * rstd * g.w); o8[64 * j] = w; } }
            }
        }
    }
    SEAM(0);

    if (IN(1)) {
        pg8::Gemm g{XN, WinT, M_TOK, NIN, DM}; pg8::StaticOrder S; S.init(M_TOK, NIN, G, bx, REP_P1, P1_WGM);
        EpiZ E{Z, cs, sn};
        pg8::gemm_phase<EpiZ, pg8::StaticOrder, true>(lds, g, S, E);
    }
    SEAM(1);

    if (IN(2)) {
        {
            const int uu = bx & 127, half = (bx >> 7) & 1;
            unsigned* sq = ctl + CW_LRU + uu * 128; float* mb = (float*)(ws + WS_MB) + uu * 1024;
            lru::unit<true>(lds, Z, Y, ssql, p.conv_w, p.conv_b, p.w_r, p.b_r, p.w_i, p.b_i, p.lam, uu >> 4, uu & 15, half, sq + 64 * half, sq + 64 * (half ^ 1), mb + 512 * half, mb + 512 * (half ^ 1));
        }
        LAS int* ubox = (LAS int*)(lds + MISC_OFF);
        for (int rep = 0; rep < REP_P2A; ++rep) { att::run(lds, Z, Y, ssqa, p.sinks, ctl + 64 + 64 * rep, ubox); __syncthreads(); }
    }
    SEAM(2);

    if (IN(3)) {
        pg8::Gemm g{Y, WoutT, M_TOK, DM, KOUT}; pg8::StaticOrder S; S.init(M_TOK, DM, G, bx, REP_P3);
        LAS f32x2* RS = (LAS f32x2*)(lds + RS_OFF);
        pg8::Unit u;
        for (int i = 0; i < 4 && S.next(i, u); ++i) {
            if (tid < 256) { const size_t row = (size_t)u.pm * 256 + tid; const f32x4* pa = (const f32x4*)(ssqa + row * 16); const f32x4* pl = (const f32x4*)(ssql + row * 16);
                float sa = 0.f, sl = 0.f;
#pragma unroll
                for (int j = 0; j < 4; ++j) { const f32x4 a = pa[j], l = pl[j]; sa += (a.x + a.y) + (a.z + a.w); sl += (l.x + l.y) + (l.z + l.w); }
                const float rA = 1.0f / sqrtf(sa * (1.f / 1024.f) + EPS), rB = 1.0f / sqrtf(sl * (1.f / 1024.f) + EPS);
                RS[i * 256 + tid] = (f32x2){rA / rB, rB}; }
        }
        __syncthreads();
        EpiOutF E{p.x, p.out, p.fg, pss, ctl + CW_PANEL, RS, (LAS float*)(lds + RS_OFF + 8192), (LAS float*)(lds + RS_OFF + 8192 + 4096)};
        pg8::gemm_phase<EpiOutF, pg8::StaticOrder, true>(lds, g, S, E);
    }
    SEAM(3);

    if (IN(4)) {
        const int gw = bx * 8 + wave, NGW = G * 8;
        const f32x4* fgr = (const f32x4*)p.fg + lane;
        for (int rep = 0; rep < REP_P4; ++rep)
        for (int m = gw; m < M_TOK; m += NGW) {
            float s2 = (lane < 16) ? pss[(size_t)m * 16 + lane] : 0.f;
            s2 += __shfl_xor(s2, 1); s2 += __shfl_xor(s2, 2); s2 += __shfl_xor(s2, 4); s2 += __shfl_xor(s2, 8);
            s2 = __shfl(s2, 0);
            float rstd = 1.0f / sqrtf(s2 * (1.f / DM) + EPS);
            if (rep > 0) rstd = 1.0f;
            f32x4* orow = (f32x4*)(p.out + (size_t)m * DM) + lane;
#pragma unroll
            for (int j = 0; j < 4; ++j) { const f32x4 t = orow[64 * j]; f32x4 g = fgr[64 * j]; if (rep > 0) g = (f32x4){1.f, 1.f, 1.f, 1.f}; orow[64 * j] = t * rstd * g; }
        }
    }
#undef IN
#undef SEAM
}

extern "C" void kernel_launch(void* const* d_in, const int* in_sizes, int n_in, void* d_out, int out_size, void* d_ws, size_t ws_size, hipStream_t stream) {
    static int grid = 0;
    if (grid == 0) {
        if (n_in != 15 || in_sizes[0] != M_TOK * DM || out_size != M_TOK * DM || ws_size < WS_END) { fprintf(stderr, "kernel_launch: unexpected shapes (n_in %d, ws %zu)\n", n_in, ws_size); grid = -1; return; }
        int dev = 0, cus = 0, per_cu = 0;
        (void)hipGetDevice(&dev); (void)hipDeviceGetAttribute(&cus, hipDeviceAttributeMultiprocessorCount, dev);
        if (hipFuncSetAttribute((const void*)mega, hipFuncAttributeMaxDynamicSharedMemorySize, LDS_BYTES) != hipSuccess) { fprintf(stderr, "kernel_launch: hipFuncSetAttribute failed\n"); grid = -1; return; }
        if (hipOccupancyMaxActiveBlocksPerMultiprocessor(&per_cu, (const void*)mega, 512, LDS_BYTES) != hipSuccess || per_cu < 1) { fprintf(stderr, "kernel_launch: occupancy query says %d\n", per_cu); per_cu = 1; }
        (void)hipGetLastError();
        grid = 256;
        if (cus * per_cu < 256) fprintf(stderr, "kernel_launch: device capacity %d x %d < 256 workgroups\n", cus, per_cu);
    }
    if (grid < 0) return;
    (void)hipMemsetAsync((char*)d_ws + WS_CTL, 0, 131072 + 524288, stream);
    Params p{};
    p.x = (const float*)d_in[0]; p.ln_gain = (const float*)d_in[1]; p.w_in = (const float*)d_in[2]; p.sinks = (const float*)d_in[3]; p.conv_w = (const float*)d_in[4]; p.conv_b = (const float*)d_in[5];
    p.w_r = (const float*)d_in[6]; p.b_r = (const float*)d_in[7]; p.w_i = (const float*)d_in[8]; p.b_i = (const float*)d_in[9]; p.lam = (const float*)d_in[10]; p.ga = (const float*)d_in[11]; p.gl = (const float*)d_in[12];
    p.w_out = (const float*)d_in[13]; p.fg = (const float*)d_in[14]; p.out = (float*)d_out; p.ws = (unsigned char*)d_ws;
    if (MK_N_LAUNCHES == 1) {
        p.ph_lo = 0; p.ph_hi = 4; void* args[] = {&p};
        hipError_t e = hipLaunchCooperativeKernel((const void*)mega, dim3(grid), dim3(512), args, LDS_BYTES, stream);
        if (e != hipSuccess) fprintf(stderr, "kernel_launch: cooperative launch failed: %s (grid %d)\n", hipGetErrorString(e), grid);
    } else {
        for (int ph = 0; ph < 4; ++ph) { p.ph_lo = ph; p.ph_hi = ph + 1; hipLaunchKernelGGL(mega, dim3(grid), dim3(512), LDS_BYTES, stream, p); }
    }
}
```

```cpp
#include <hip/hip_runtime.h>
#include <hip/hip_cooperative_groups.h>
#include <cstdio>
#include <cstdint>
namespace cg = cooperative_groups;

#ifndef MK_N_LAUNCHES
#define MK_N_LAUNCHES 1
#endif

#ifndef REP_P0
#define REP_P0 1
#endif
#ifndef REP_P1
#define REP_P1 1
#endif
#ifndef REP_P2L
#define REP_P2L 1
#endif
#ifndef REP_P2A
#define REP_P2A 1
#endif
#ifndef REP_P3
#define REP_P3 1
#endif
#ifndef REP_P4
#define REP_P4 1
#endif
#ifndef REP_SYNC
#define REP_SYNC 1
#endif
#ifndef P1_WGM
#define P1_WGM 2
#endif
#ifndef PROBE_SEAM
#define PROBE_SEAM -1
#endif
#ifndef PROBE_X_US
#define PROBE_X_US 0
#endif

#define LAS __attribute__((address_space(3)))
typedef unsigned short bf16_t;
typedef short bf16x8 __attribute__((ext_vector_type(8)));
typedef short s16x4 __attribute__((ext_vector_type(4)));
typedef float f32x4 __attribute__((ext_vector_type(4)));
typedef float f32x2 __attribute__((ext_vector_type(2)));
typedef float f32x16 __attribute__((ext_vector_type(16)));
typedef unsigned u32x4 __attribute__((ext_vector_type(4)));
typedef unsigned u32x2 __attribute__((ext_vector_type(2)));

constexpr int SEQ = 4096, NB = 8, M_TOK = NB * SEQ, DM = 1024, NIN = 4608, KOUT = 2048;
constexpr int COL_Q = 0, COL_K = 1024, COL_V = 1280, COL_GA = 1536, COL_XL = 2560, COL_GL = 3584;
constexpr float EPS = 1e-6f;
constexpr float LOG2E = 1.4426950408889634f;
constexpr float C2 = 0.125f * LOG2E;

constexpr size_t MiB = 1u << 20;
constexpr size_t WS_CTL = 0;
constexpr int CW_BAR = 1024;
constexpr int CW_PANEL = 8192;
constexpr int CW_LRU = 16384;
constexpr size_t WS_WIN = 2 * MiB;
constexpr size_t WS_WOUT = 12 * MiB;
constexpr size_t WS_CS = 16 * MiB;
constexpr size_t WS_SN = 16 * MiB + 128 * 1024;
constexpr size_t WS_MB = 128 * 1024;
constexpr size_t WS_SSQA = 17 * MiB;
constexpr size_t WS_SSQL = 19 * MiB;
constexpr size_t WS_PSS = 21 * MiB;
constexpr size_t WS_XN = 32 * MiB;
constexpr size_t WS_Y = 32 * MiB;
constexpr size_t WS_Z = 160 * MiB;
constexpr size_t WS_END = 448 * MiB;

constexpr int RING_BYTES = 131072;
constexpr int MISC_OFF = RING_BYTES;
constexpr int RS_OFF = RING_BYTES + 512;
constexpr int LDS_BYTES = 147456;

#define LDS_BARRIER() asm volatile("s_waitcnt lgkmcnt(0)\n\ts_barrier" ::: "memory")
__device__ __forceinline__ unsigned cvt_pk_bf16(float lo, float hi) { unsigned r; asm volatile("v_cvt_pk_bf16_f32 %0, %1, %2" : "=v"(r) : "v"(lo), "v"(hi)); return r; }
__device__ __forceinline__ float bf_lo(unsigned w) { return __uint_as_float(w << 16); }
__device__ __forceinline__ float bf_hi(unsigned w) { return __uint_as_float(w & 0xffff0000u); }
__device__ __forceinline__ unsigned f2bf(float f) { unsigned u = __float_as_uint(f); return (u + 0x7fffu + ((u >> 16) & 1u)) >> 16; }
__device__ __forceinline__ unsigned pk2(float lo, float hi) { return f2bf(lo) | (f2bf(hi) << 16); }
__device__ __forceinline__ float fast_sigmoid(float v) { return __builtin_amdgcn_rcpf(1.0f + __builtin_amdgcn_exp2f(-v * LOG2E)); }

namespace pg8 {
constexpr int BM = 256, BK = 64, HALF = 128, HTB = HALF * BK * 2, STAGE_BYTES = 8 * HTB, NXCD = 8, WGM = 8;
__host__ __device__ __forceinline__ int lds_byte(int r, int c) { const int st = (r >> 4) * 2 + (c >> 5), rr = r & 15, cc = c & 31, ob = rr * 64 + cc * 2; return st * 1024 + (ob ^ (((ob >> 9) & 1) << 5)); }
__host__ __device__ __forceinline__ void stage_rc(int b, int& R, int& C) { const int st = b / 1024, sb = b % 1024, swz = sb ^ (((sb >> 9) & 1) << 5); R = (st >> 1) * 16 + swz / 64; C = (st & 1) * 32 + (swz % 64) / 2; }
__host__ __device__ __forceinline__ int perm32(int rho) { const int n = rho >> 4, i = rho & 15; return 8 * (i >> 2) + 4 * n + (i & 3); }

struct Unit { int pm, pn; };
struct Gemm { const bf16_t* A; const bf16_t* Bt; int M, N, K; };

struct StaticOrder {
    int nM, nN, nwg, G, c, rep, wgm;
    __host__ __device__ void init(int M, int N, int G_, int c_, int rep_ = 1, int wgm_ = WGM) { nM = M / BM; nN = N / BM; nwg = nM * nN; G = G_; c = c_; rep = rep_; wgm = wgm_; }
    __host__ __device__ bool next(int i, Unit& u) const {
        const long L = (long)i * G + c; if (L >= (long)nwg * rep) return false;
        int wgid = (int)(L % nwg); { const int q = nwg / NXCD, r = nwg % NXCD, xcd = wgid % NXCD, off = wgid / NXCD; wgid = (xcd < r ? xcd * (q + 1) : r * (q + 1) + (xcd - r) * q) + off; }
        const int nig = wgm * nN, gid = wgid / nig, fm = gid * wgm, gsz = (nM - fm) < wgm ? (nM - fm) : wgm;
        u.pm = fm + ((wgid % nig) % gsz); u.pn = (wgid % nig) / gsz; return true;
    }
};

template <class Epi, class Sched, bool ALIGN_EPI>
__device__ __forceinline__ void gemm_phase(LAS unsigned char* lds, const Gemm g, const Sched& S, const Epi& E) {
    const int tid = threadIdx.x, wid = __builtin_amdgcn_readfirstlane(tid >> 6), lane = tid & 63, wr = wid >> 2, wc = wid & 3, fr = lane & 15, fq = lane >> 4;
    const int K = g.K, nt = K / BK;
    unsigned voffA[2], voffB[2];
#pragma unroll
    for (int i = 0; i < 2; ++i) { int R, C; stage_rc(tid * 16 + i * 8192, R, C); const int Rb = Epi::PERM ? ((R & ~31) + perm32(R & 31)) : R;
        voffA[i] = (unsigned)(R * K + C) * 2u; voffB[i] = (unsigned)(Rb * K + C) * 2u; }
    const size_t kstep = (size_t)(BK * 2);
    const size_t hstep = (size_t)HALF * K * 2;
    const size_t tstep = 2 * hstep;
    const unsigned ldsw = (unsigned)wid * 1024u;
    const int aoff = lds_byte(wr * 64 + fr, fq * 8), boff = lds_byte(wc * 32 + fr, fq * 8);
#define PG8_SA(b, h) (((b) * 2 + (h)) * HTB)
#define PG8_SB(b, h) ((4 + (b) * 2 + (h)) * HTB)
#define PG8_STAGE(bufoff, gbase, voff) do { _Pragma("unroll") for (int _i = 0; _i < 2; ++_i) \
        __builtin_amdgcn_global_load_lds((const unsigned*)((const char*)(gbase) + (voff)[_i]), (LAS unsigned*)(lds + (bufoff) + ldsw + _i * 8192), 16, 0, 0); } while (0)
#define PG8_LDA(dst, b, h) do { _Pragma("unroll") for (int m = 0; m < 4; ++m) _Pragma("unroll") for (int k = 0; k < 2; ++k) dst[m][k] = *(const LAS bf16x8*)(lds + PG8_SA(b, h) + aoff + m * 2048 + k * 1024); } while (0)
#define PG8_LDB(dst, b, h) do { _Pragma("unroll") for (int n = 0; n < 2; ++n) _Pragma("unroll") for (int k = 0; k < 2; ++k) dst[n][k] = *(const LAS bf16x8*)(lds + PG8_SB(b, h) + boff + n * 2048 + k * 1024); } while (0)
#define PG8_MMA(ai, bj, At, Bt) do { __builtin_amdgcn_s_setprio(1); _Pragma("unroll") for (int m = 0; m < 4; ++m) _Pragma("unroll") for (int n = 0; n < 2; ++n) _Pragma("unroll") for (int k = 0; k < 2; ++k) \
        acc[ai][bj][m][n] = __builtin_amdgcn_mfma_f32_16x16x32_bf16(Bt[n][k], At[m][k], acc[ai][bj][m][n], 0, 0, 0); __builtin_amdgcn_s_setprio(0); } while (0)
#define PG8_WAIT_V(n) asm volatile("s_waitcnt vmcnt(" #n ")" ::: "memory")
#define PG8_WAIT_L(n) asm volatile("s_waitcnt lgkmcnt(" #n ")" ::: "memory")
#define PG8_BAR __builtin_amdgcn_s_barrier()
#define PG8_SCHED __builtin_amdgcn_sched_barrier(0)
    Unit cur, nxt; int ui = 0;
    if (!S.next(0, cur)) return;
    f32x4 acc[2][2][4][2];
#pragma unroll
    for (int a = 0; a < 2; ++a)
#pragma unroll
        for (int b = 0; b < 2; ++b)
#pragma unroll
            for (int m = 0; m < 4; ++m)
#pragma unroll
                for (int n = 0; n < 2; ++n) acc[a][b][m][n] = (f32x4){0.f, 0.f, 0.f, 0.f};
    bf16x8 At[4][2], B0[2][2], B1[2][2];
    const char* cA = (const char*)g.A + (size_t)cur.pm * tstep; const char* cB = (const char*)g.Bt + (size_t)cur.pn * tstep;
    PG8_STAGE(PG8_SB(0, 0), cB, voffB); PG8_STAGE(PG8_SB(0, 1), cB + hstep, voffB); PG8_STAGE(PG8_SA(0, 0), cA, voffA); PG8_STAGE(PG8_SA(0, 1), cA + hstep, voffA);
    if (wr == 1) PG8_BAR;
    PG8_WAIT_V(2); PG8_BAR;
    PG8_STAGE(PG8_SB(1, 0), cB + kstep, voffB); PG8_STAGE(PG8_SA(1, 0), cA + kstep, voffA); PG8_STAGE(PG8_SB(1, 1), cB + hstep + kstep, voffB);
    PG8_WAIT_V(6); PG8_BAR;
    for (;;) {
        const bool has_next = S.next(ui + 1, nxt);
        const char* nA = has_next ? (const char*)g.A + (size_t)nxt.pm * tstep : cA; const char* nB = has_next ? (const char*)g.Bt + (size_t)nxt.pn * tstep : cB;
        for (int t = 0; t < nt; t += 2) {
            const bool last = (t == nt - 2);
            const char* a1 = cA + (size_t)(t + 1) * kstep;
            const char* a2 = last ? nA : cA + (size_t)(t + 2) * kstep; const char* b2 = last ? nB : cB + (size_t)(t + 2) * kstep;
            const char* a3 = a2 + kstep; const char* b3 = b2 + kstep;
            if constexpr (Epi::MIDK > 0) { if (t == Epi::MIDK) E.mid(acc, ui, wr, fr); }
            PG8_LDB(B0, 0, 0); PG8_LDB(B1, 0, 1); PG8_SCHED; PG8_LDA(At, 0, 0); PG8_STAGE(PG8_SA(1, 1), a1 + hstep, voffA);
            PG8_WAIT_V(8); PG8_WAIT_L(0); PG8_BAR; PG8_MMA(0, 0, At, B0); PG8_MMA(0, 1, At, B1); PG8_BAR; PG8_SCHED;
            PG8_LDA(At, 0, 1); PG8_STAGE(PG8_SB(0, 0), b2, voffB); PG8_STAGE(PG8_SB(0, 1), b2 + hstep, voffB); PG8_STAGE(PG8_SA(0, 0), a2, voffA);
            PG8_WAIT_V(8); PG8_WAIT_L(0); PG8_BAR; PG8_MMA(1, 0, At, B0); PG8_MMA(1, 1, At, B1); PG8_BAR; PG8_SCHED;
            PG8_LDB(B0, 1, 0); PG8_LDB(B1, 1, 1); PG8_SCHED; PG8_LDA(At, 1, 0); PG8_STAGE(PG8_SA(0, 1), a2 + hstep, voffA);
            PG8_WAIT_V(8); PG8_WAIT_L(0); PG8_BAR; PG8_MMA(0, 0, At, B0); PG8_MMA(0, 1, At, B1); PG8_BAR; PG8_SCHED;
            PG8_LDA(At, 1, 1); PG8_STAGE(PG8_SB(1, 0), b3, voffB); PG8_STAGE(PG8_SB(1, 1), b3 + hstep, voffB); PG8_STAGE(PG8_SA(1, 0), a3, voffA);
            PG8_WAIT_V(8); PG8_WAIT_L(0); PG8_BAR; PG8_MMA(1, 0, At, B0); PG8_MMA(1, 1, At, B1); PG8_BAR; PG8_SCHED;
        }
        if constexpr (ALIGN_EPI) { if (wr == 0) PG8_BAR; }
        E(acc, cur, ui, wr, wc, fr, fq);
        if (!has_next) break;
#pragma unroll
        for (int a = 0; a < 2; ++a)
#pragma unroll
            for (int b = 0; b < 2; ++b)
#pragma unroll
                for (int m = 0; m < 4; ++m)
#pragma unroll
                    for (int n = 0; n < 2; ++n) acc[a][b][m][n] = (f32x4){0.f, 0.f, 0.f, 0.f};
        cur = nxt; cA = nA; cB = nB; ++ui;
        if constexpr (ALIGN_EPI) { if (wr == 1) PG8_BAR; }
    }
    PG8_WAIT_V(0);
    if constexpr (!ALIGN_EPI) { if (wr == 0) PG8_BAR; }
    PG8_BAR;
#undef PG8_SA
#undef PG8_SB
#undef PG8_STAGE
#undef PG8_LDA
#undef PG8_LDB
#undef PG8_MMA
#undef PG8_WAIT_V
#undef PG8_WAIT_L
#undef PG8_BAR
#undef PG8_SCHED
}
}

struct EpiZ {
    static constexpr bool PERM = true; static constexpr int MIDK = 0;
    bf16_t* Z; const float* cs; const float* sn;
    __device__ __forceinline__ void mid(f32x4 (&acc)[2][2][4][2], int ui, int wr, int fr) const {}
    __device__ __forceinline__ void operator()(const f32x4 (&acc)[2][2][4][2], const pg8::Unit& u, int ui, int wr, int wc, int fr, int fq) const {
        const int row0 = u.pm * 256 + wr * 64 + fr, col0 = u.pn * 256 + wc * 32 + 8 * fq, pn = u.pn;
        const int mode = (pn <= 4) ? 2 : (pn == 5 ? 0 : (pn <= 9 ? 1 : (pn <= 13 ? 0 : 1)));
        const bool rope = (mode == 2) && ((wc & 1) == 0);
        const float sc = (pn <= 3) ? C2 : 1.f;
        const float sgn = (fq == 0) ? -1.f : 1.f;
        if (rope) {
            const bool lo = (fq & 1) == 0;
#pragma unroll
            for (int ai = 0; ai < 2; ++ai) {
                f32x4 cc[4][2], ss_[4][2];
#pragma unroll
                for (int m = 0; m < 4; ++m) { const int pos = (row0 + ai * 128 + m * 16) & (SEQ - 1);
                    if (fq < 2) { cc[m][0] = *(const f32x4*)(cs + pos * 8); cc[m][1] = *(const f32x4*)(cs + pos * 8 + 4); ss_[m][0] = *(const f32x4*)(sn + pos * 8) * sgn; ss_[m][1] = *(const f32x4*)(sn + pos * 8 + 4) * sgn; }
                    else { cc[m][0] = (f32x4){1.f, 1.f, 1.f, 1.f}; cc[m][1] = cc[m][0]; ss_[m][0] = (f32x4){0.f, 0.f, 0.f, 0.f}; ss_[m][1] = ss_[m][0]; } }
#pragma unroll
                for (int m = 0; m < 4; ++m) {
                    bf16_t* rowp = Z + (size_t)(row0 + ai * 128 + m * 16) * NIN + col0;
#pragma unroll
                    for (int bj = 0; bj < 2; ++bj) {
                        f32x4 v0 = acc[ai][bj][m][0], v1 = acc[ai][bj][m][1], p0, p1;
#pragma unroll
                        for (int k = 0; k < 4; ++k) {
                            const auto r0 = __builtin_amdgcn_permlane16_swap(__float_as_uint(v0[k]), __float_as_uint(v0[k]), false, false);
                            const auto r1 = __builtin_amdgcn_permlane16_swap(__float_as_uint(v1[k]), __float_as_uint(v1[k]), false, false);
                            p0[k] = __uint_as_float(lo ? r0[1] : r0[0]); p1[k] = __uint_as_float(lo ? r1[1] : r1[0]); }
                        v0 = (v0 * cc[m][0] + p0 * ss_[m][0]) * sc; v1 = (v1 * cc[m][1] + p1 * ss_[m][1]) * sc;
                        u32x4 w; w.x = cvt_pk_bf16(v0[0], v0[1]); w.y = cvt_pk_bf16(v0[2], v0[3]); w.z = cvt_pk_bf16(v1[0], v1[1]); w.w = cvt_pk_bf16(v1[2], v1[3]);
                        __builtin_nontemporal_store(w, (u32x4*)(rowp + bj * 128));
                    }
                }
            }
            return;
        }
#pragma unroll
        for (int ai = 0; ai < 2; ++ai)
#pragma unroll
            for (int m = 0; m < 4; ++m) {
                bf16_t* rowp = Z + (size_t)(row0 + ai * 128 + m * 16) * NIN + col0;
#pragma unroll
                for (int bj = 0; bj < 2; ++bj) {
                    f32x4 v0 = acc[ai][bj][m][0], v1 = acc[ai][bj][m][1];
                    if (mode == 1) {
#pragma unroll
                        for (int k = 0; k < 4; ++k) {
                            const float da = 1.0f + __builtin_amdgcn_exp2f(fminf(-v0[k] * LOG2E, 60.f)), db = 1.0f + __builtin_amdgcn_exp2f(fminf(-v1[k] * LOG2E, 60.f));
                            const float inv = __builtin_amdgcn_rcpf(da * db); v0[k] = v0[k] * (db * inv); v1[k] = v1[k] * (da * inv); }
                    }
                    v0 = v0 * sc; v1 = v1 * sc;
                    u32x4 w; w.x = cvt_pk_bf16(v0[0], v0[1]); w.y = cvt_pk_bf16(v0[2], v0[3]); w.z = cvt_pk_bf16(v1[0], v1[1]); w.w = cvt_pk_bf16(v1[2], v1[3]);
                    __builtin_nontemporal_store(w, (u32x4*)(rowp + bj * 128));
                }
            }
    }
};

struct EpiOut {
    static constexpr bool PERM = false; static constexpr int MIDK = 16;
    const float* x; float* out; float* pss; LAS const f32x2* RS;
    __device__ __forceinline__ void mid(f32x4 (&acc)[2][2][4][2], int ui, int wr, int fr) const {
#pragma unroll
        for (int ai = 0; ai < 2; ++ai)
#pragma unroll
            for (int m = 0; m < 4; ++m) { const float ratio = RS[(ui & 3) * 256 + ai * 128 + wr * 64 + m * 16 + fr].x;
#pragma unroll
                for (int bj = 0; bj < 2; ++bj)
#pragma unroll
                    for (int n = 0; n < 2; ++n) acc[ai][bj][m][n] = acc[ai][bj][m][n] * ratio; }
    }
    __device__ __forceinline__ void operator()(const f32x4 (&acc)[2][2][4][2], const pg8::Unit& u, int ui, int wr, int wc, int fr, int fq) const {
        const int col0 = u.pn * 256 + wc * 32 + 4 * fq;
#pragma unroll
        for (int ai = 0; ai < 2; ++ai)
#pragma unroll
            for (int m = 0; m < 4; ++m) {
                const int lr = ai * 128 + wr * 64 + m * 16 + fr; const float rB = RS[(ui & 3) * 256 + lr].y;
                const size_t off = (size_t)(u.pm * 256 + lr) * DM + col0; float ss = 0.f;
#pragma unroll
                for (int bj = 0; bj < 2; ++bj)
#pragma unroll
                    for (int n = 0; n < 2; ++n) { const f32x4 xb = *(const f32x4*)(x + off + bj * 128 + n * 16); const f32x4 o = xb + acc[ai][bj][m][n] * rB;
                        ss += (o[0] * o[0] + o[1] * o[1]) + (o[2] * o[2] + o[3] * o[3]); *(f32x4*)(out + off + bj * 128 + n * 16) = o; }
                ss += __shfl_xor(ss, 16); ss += __shfl_xor(ss, 32);
                if (fq == 0) pss[(size_t)(u.pm * 256 + lr) * 16 + u.pn * 4 + wc] = ss;
            }
    }
};

struct EpiOutF {
    static constexpr bool PERM = false; static constexpr int MIDK = 16;
    const float* x; float* out; const float* fg; float* xbuf; unsigned* cnt; LAS const f32x2* RS; LAS float* PP; LAS float* SS;
    __device__ __forceinline__ void mid(f32x4 (&acc)[2][2][4][2], int ui, int wr, int fr) const {
#pragma unroll
        for (int ai = 0; ai < 2; ++ai)
#pragma unroll
            for (int m = 0; m < 4; ++m) { const float ratio = RS[(ui & 3) * 256 + ai * 128 + wr * 64 + m * 16 + fr].x;
#pragma unroll
                for (int bj = 0; bj < 2; ++bj)
#pragma unroll
                    for (int n = 0; n < 2; ++n) acc[ai][bj][m][n] = acc[ai][bj][m][n] * ratio; }
    }
    __device__ __forceinline__ void operator()(f32x4 (&acc)[2][2][4][2], const pg8::Unit& u, int ui, int wr, int wc, int fr, int fq) const {
        const int tid = threadIdx.x, lane = tid & 63, wid = __builtin_amdgcn_readfirstlane(tid >> 6);
        const int col0 = u.pn * 256 + wc * 32 + 4 * fq;
#pragma unroll
        for (int ai = 0; ai < 2; ++ai) {
            f32x4 xb[4][2][2];
#pragma unroll
            for (int m = 0; m < 4; ++m) { const size_t off = (size_t)(u.pm * 256 + ai * 128 + wr * 64 + m * 16 + fr) * DM + col0;
#pragma unroll
                for (int bj = 0; bj < 2; ++bj)
#pragma unroll
                    for (int n = 0; n < 2; ++n) xb[m][bj][n] = *(const f32x4*)(x + off + bj * 128 + n * 16); }
            asm volatile("" ::: "memory");
            float ssv[4];
#pragma unroll
            for (int m = 0; m < 4; ++m) { const int lr = ai * 128 + wr * 64 + m * 16 + fr; const float rB = RS[(ui & 3) * 256 + lr].y; float ss = 0.f;
#pragma unroll
                for (int bj = 0; bj < 2; ++bj)
#pragma unroll
                    for (int n = 0; n < 2; ++n) { const f32x4 o = xb[m][bj][n] + acc[ai][bj][m][n] * rB; ss += (o[0] * o[0] + o[1] * o[1]) + (o[2] * o[2] + o[3] * o[3]); acc[ai][bj][m][n] = o; }
                ssv[m] = ss; }
#pragma unroll
            for (int m = 0; m < 4; ++m) ssv[m] += __shfl_xor(ssv[m], 16);
#pragma unroll
            for (int m = 0; m < 4; ++m) ssv[m] += __shfl_xor(ssv[m], 32);
            if (fq == 0) {
#pragma unroll
                for (int m = 0; m < 4; ++m) PP[(ai * 128 + wr * 64 + m * 16 + fr) * 4 + wc] = ssv[m]; }
        }
        asm volatile("s_waitcnt lgkmcnt(0)" ::: "memory"); __builtin_amdgcn_s_barrier(); asm volatile("" ::: "memory");
        unsigned* pc = cnt + 64 * u.pm;
        if (tid < 256) { const f32x4 pp = *(const LAS f32x4*)(PP + tid * 4); const float tp = (pp[0] + pp[1]) + (pp[2] + pp[3]);
            __hip_atomic_store(xbuf + (size_t)(u.pm * 256 + tid) * 4 + u.pn, tp, __ATOMIC_RELAXED, __HIP_MEMORY_SCOPE_AGENT); }
        asm volatile("s_waitcnt vmcnt(0)" ::: "memory");
        if (tid < 256 && lane == 0) __hip_atomic_fetch_add(pc, 1u, __ATOMIC_RELAXED, __HIP_MEMORY_SCOPE_AGENT);
        if (wid == 0) {
            unsigned sp = 0;
            while ((unsigned)__builtin_amdgcn_readfirstlane(__hip_atomic_load(pc, __ATOMIC_RELAXED, __HIP_MEMORY_SCOPE_AGENT)) < 16u) { if (++sp > (1u << 22)) break; }
            __builtin_amdgcn_fence(__ATOMIC_ACQUIRE, "agent");
        }
        asm volatile("s_waitcnt vmcnt(0) lgkmcnt(0)" ::: "memory"); __builtin_amdgcn_s_barrier(); asm volatile("" ::: "memory");
        if (tid < 256) { const float* slot = xbuf + (size_t)(u.pm * 256 + tid) * 4; float q = 0.f;
#pragma unroll
            for (int t = 0; t < 4; ++t) q += __hip_atomic_load(slot + t, __ATOMIC_RELAXED, __HIP_MEMORY_SCOPE_AGENT);
            SS[tid] = 1.0f / sqrtf(q * (1.f / DM) + EPS); }
        asm volatile("s_waitcnt lgkmcnt(0)" ::: "memory"); __builtin_amdgcn_s_barrier(); asm volatile("" ::: "memory");
        f32x4 gv[2][2];
#pragma unroll
        for (int bj = 0; bj < 2; ++bj)
#pragma unroll
            for (int n = 0; n < 2; ++n) gv[bj][n] = *(const f32x4*)(fg + col0 + bj * 128 + n * 16);
#pragma unroll
        for (int ai = 0; ai < 2; ++ai)
#pragma unroll
            for (int m = 0; m < 4; ++m) {
                const int lr = ai * 128 + wr * 64 + m * 16 + fr; const float rs = SS[lr];
                const size_t off = (size_t)(u.pm * 256 + lr) * DM + col0;
#pragma unroll
                for (int bj = 0; bj < 2; ++bj)
#pragma unroll
                    for (int n = 0; n < 2; ++n) *(f32x4*)(out + off + bj * 128 + n * 16) = acc[ai][bj][m][n] * rs * gv[bj][n];
            }
        asm volatile("s_waitcnt lgkmcnt(0)" ::: "memory"); __builtin_amdgcn_s_barrier(); asm volatile("" ::: "memory");
    }
};

__device__ __forceinline__ float wave_sum(float v) {
#pragma unroll
    for (int o = 1; o < 64; o <<= 1) v += __shfl_xor(v, o);
    return v;
}
__device__ __forceinline__ void p0_transpose_item(const float* W, int K, int N, bf16_t* WT, const float* kscale, LAS float* scr, int item, int lane) {
    const int nblk = N / 32, kb = item / nblk, nb = item % nblk, k0 = 64 * kb, n0 = 32 * nb;
#pragma unroll
    for (int i = 0; i < 32; ++i) { const int kk = 2 * i + (lane >> 5); float v = __builtin_nontemporal_load(W + (size_t)(k0 + kk) * N + n0 + (lane & 31)); if (kscale) v *= kscale[k0 + kk]; scr[kk * 33 + (lane & 31)] = v; }
    asm volatile("s_waitcnt lgkmcnt(0)" ::: "memory");
    const int c = lane & 7;
#pragma unroll
    for (int j = 0; j < 4; ++j) { const int n = (lane >> 3) + 8 * j; const LAS float* s = scr + (8 * c) * 33 + n;
        u32x4 o; o.x = pk2(s[0 * 33], s[1 * 33]); o.y = pk2(s[2 * 33], s[3 * 33]); o.z = pk2(s[4 * 33], s[5 * 33]); o.w = pk2(s[6 * 33], s[7 * 33]);
        *(u32x4*)(WT + (size_t)(n0 + n) * K + k0 + 8 * c) = o; }
    asm volatile("s_waitcnt lgkmcnt(0)" ::: "memory");
}
__device__ __forceinline__ void sincos_d(double xx, double& s, double& c) {
    const double kq = rint(xx * 0.63661977236758134308);
    double r = fma(-kq, 1.57079632679489655800e+00, xx); r = fma(-kq, 6.12323399573676603587e-17, r);
    const int q = ((int)kq) & 3; const double r2 = r * r;
    const double sp = r * (1.0 + r2 * (-1.0 / 6.0 + r2 * (1.0 / 120.0 + r2 * (-1.0 / 5040.0 + r2 * (1.0 / 362880.0 + r2 * (-1.0 / 39916800.0 + r2 * (1.0 / 6227020800.0 + r2 * (-1.0 / 1307674368000.0))))))));
    const double cp = 1.0 + r2 * (-0.5 + r2 * (1.0 / 24.0 + r2 * (-1.0 / 720.0 + r2 * (1.0 / 40320.0 + r2 * (-1.0 / 3628800.0 + r2 * (1.0 / 479001600.0 + r2 * (-1.0 / 87178291200.0 + r2 * (1.0 / 20922789888000.0))))))));
    s = (q == 0) ? sp : (q == 1) ? cp : (q == 2) ? -sp : -cp;
    c = (q == 0) ? cp : (q == 1) ? -sp : (q == 2) ? -cp : sp;
}

namespace att {
constexpr int KV_ROWS = 192, RS = 144;
constexpr int L_K = 0, L_V = KV_ROWS * RS, L_STG = 2 * KV_ROWS * RS, STG_RS = 272, STG_W = 32 * STG_RS, L_LW = L_STG + 8 * STG_W, L_END = L_LW + 8 * 128;
static_assert(L_END <= RING_BYTES, "attention LDS");
__device__ __forceinline__ int crow(int i, int h) { return (i & 3) + 8 * (i >> 2) + 4 * h; }
__device__ __forceinline__ s16x4 vtr(LAS const unsigned char* p) { return __builtin_bit_cast(s16x4, __builtin_amdgcn_ds_read_tr16_b64_v4i16((LAS s16x4*)p)); }

constexpr int NUNITS = NB * 4 * 64;
__device__ __forceinline__ void load_kvq(u32x4 (&kreg)[3], u32x4 (&vreg)[3], bf16x8 (&qr)[4], const bf16_t* __restrict__ z, int u, int tid, int wid, int r, int h) {
    const int b = u >> 8, kvh = (u >> 6) & 3, q0 = (u & 63) * 64; const size_t rowbase = (size_t)b * SEQ;
    const int head = kvh * 4 + (wid >> 1), qs = q0 + 32 * (wid & 1);
#pragma unroll
    for (int i = 0; i < 3; ++i) { const int pidx = tid + 512 * i, row = pidx >> 3, ch = pidx & 7, pos = q0 - 128 + row;
        if (pos >= 0) { const bf16_t* src = z + (rowbase + pos) * NIN + COL_K + kvh * 64 + ch * 8; kreg[i] = *(const u32x4*)src; vreg[i] = *(const u32x4*)(src + 256); }
        else { kreg[i] = (u32x4){0u, 0u, 0u, 0u}; vreg[i] = (u32x4){0u, 0u, 0u, 0u}; } }
#pragma unroll
    for (int d0 = 0; d0 < 4; ++d0) qr[d0] = *(const bf16x8*)(z + (rowbase + qs + r) * NIN + COL_Q + head * 64 + d0 * 16 + h * 8);
}

__device__ __forceinline__ void run(LAS unsigned char* lds, const bf16_t* __restrict__ z, bf16_t* __restrict__ y, float* __restrict__ ssq, const float* __restrict__ sinks, unsigned* ctr, LAS int* ubox) {
    const int tid = threadIdx.x, lane = tid & 63, r = lane & 31, h = lane >> 5, wid = __builtin_amdgcn_readfirstlane(tid >> 6);
    const int G = gridDim.x, nper = (NUNITS + G - 1) / G;
    int u = (int)blockIdx.x * nper; const int uend = (u + nper < NUNITS) ? u + nper : NUNITS;
    if (u >= uend) return;
    float sinkv[4];
#pragma unroll
    for (int kq = 0; kq < 4; ++kq) sinkv[kq] = sinks[kq * 4 + (wid >> 1)] * LOG2E;
    u32x4 kreg[3], vreg[3]; bf16x8 qn[4];
    load_kvq(kreg, vreg, qn, z, u, tid, wid, r, h);
    for (int n = 0;; ++n) {
        const int b = u >> 8, kvh = (u >> 6) & 3, q0 = (u & 63) * 64; const size_t rowbase = (size_t)b * SEQ;
        const int head = kvh * 4 + (wid >> 1), qs = q0 + 32 * (wid & 1);
        bf16x8 qr[4];
#pragma unroll
        for (int d0 = 0; d0 < 4; ++d0) qr[d0] = qn[d0];
#pragma unroll
        for (int i = 0; i < 3; ++i) { const int pidx = tid + 512 * i, row = pidx >> 3, ch = pidx & 7;
            *(LAS u32x4*)(lds + L_K + row * RS + ch * 16) = kreg[i]; *(LAS u32x4*)(lds + L_V + row * RS + ch * 16) = vreg[i]; }
        LDS_BARRIER();
        const int un = u + 1;
        if (un < uend) load_kvq(kreg, vreg, qn, z, un, tid, wid, r, h);
        u32x4 gv[4];
#pragma unroll
        for (int it = 0; it < 4; ++it) gv[it] = *(const u32x4*)(z + (rowbase + qs + it * 8 + (lane >> 3)) * NIN + COL_GA + head * 64 + (lane & 7) * 8);
        f32x16 s[5];
        const LAS unsigned char* kb = lds + L_K + (32 * (wid & 1) + r) * RS + h * 16;
#pragma unroll
        for (int c = 0; c < 5; ++c) { f32x16 a = {0.f, 0.f, 0.f, 0.f, 0.f, 0.f, 0.f, 0.f, 0.f, 0.f, 0.f, 0.f, 0.f, 0.f, 0.f, 0.f};
#pragma unroll
            for (int d0 = 0; d0 < 4; ++d0) { const bf16x8 kf = *(const LAS bf16x8*)(kb + c * 32 * RS + d0 * 32); a = __builtin_amdgcn_mfma_f32_32x32x16_bf16(kf, qr[d0], a, 0, 0, 0); }
            s[c] = a; }
        const float sink2 = (kvh == 0) ? sinkv[0] : (kvh == 1) ? sinkv[1] : (kvh == 2) ? sinkv[2] : sinkv[3];
        float mx = -1e30f;
        if (q0 < 128) {
#pragma unroll
            for (int c = 0; c < 5; ++c)
#pragma unroll
                for (int i = 0; i < 16; ++i) { const int cr = crow(i, h), diff = 128 - 32 * c + r - cr, kp = qs - 128 + 32 * c + cr;
                    const bool valid = (diff >= 0) && (diff < 128) && (kp >= 0); const float v = valid ? s[c][i] : -1e30f; s[c][i] = v; mx = fmaxf(mx, v); }
        } else {
#pragma unroll
            for (int i = 0; i < 16; ++i) { const int cr = crow(i, h); const float v0 = (cr > r) ? s[0][i] : -1e30f, v4 = (cr <= r) ? s[4][i] : -1e30f; s[0][i] = v0; s[4][i] = v4; mx = fmaxf(mx, fmaxf(v0, v4)); }
#pragma unroll
            for (int c = 1; c < 4; ++c)
#pragma unroll
                for (int i = 0; i < 16; ++i) mx = fmaxf(mx, s[c][i]);
        }
        mx = fmaxf(mx, __shfl_xor(mx, 32));
        const float mref = fmaxf(mx, sink2);
        float lsum = 0.f;
#pragma unroll
        for (int c = 0; c < 5; ++c)
#pragma unroll
            for (int i = 0; i < 16; ++i) { const float pv = __builtin_amdgcn_exp2f(s[c][i] - mref); s[c][i] = pv; lsum += pv; }
        lsum += __shfl_xor(lsum, 32);
        const float l = lsum + __builtin_amdgcn_exp2f(sink2 - mref);
        f32x16 o[2];
        o[0] = (f32x16){0.f, 0.f, 0.f, 0.f, 0.f, 0.f, 0.f, 0.f, 0.f, 0.f, 0.f, 0.f, 0.f, 0.f, 0.f, 0.f}; o[1] = o[0];
        const LAS unsigned char* vb = lds + L_V + (32 * (wid & 1) + 4 * h + ((lane & 15) >> 2)) * RS + ((lane >> 4) & 1) * 32 + (lane & 3) * 8;
#pragma unroll
        for (int c = 0; c < 5; ++c)
#pragma unroll
            for (int s2 = 0; s2 < 2; ++s2) {
                u32x4 pw; pw.x = cvt_pk_bf16(s[c][8 * s2 + 0], s[c][8 * s2 + 1]); pw.y = cvt_pk_bf16(s[c][8 * s2 + 2], s[c][8 * s2 + 3]); pw.z = cvt_pk_bf16(s[c][8 * s2 + 4], s[c][8 * s2 + 5]); pw.w = cvt_pk_bf16(s[c][8 * s2 + 6], s[c][8 * s2 + 7]);
                const bf16x8 pa = __builtin_bit_cast(bf16x8, pw);
#pragma unroll
                for (int dh = 0; dh < 2; ++dh) { const LAS unsigned char* ap = vb + (32 * c + 16 * s2) * RS + dh * 64;
                    const s16x4 lo = vtr(ap), hi = vtr(ap + 8 * RS);
                    const bf16x8 vf = __builtin_shufflevector(lo, hi, 0, 1, 2, 3, 4, 5, 6, 7);
                    o[dh] = __builtin_amdgcn_mfma_f32_32x32x16_bf16(pa, vf, o[dh], 0, 0, 0); }
            }
        LAS float* lw = (LAS float*)(lds + L_LW + wid * 128);
        if (h == 0) lw[r] = __builtin_amdgcn_rcpf(l);
        LAS unsigned char* stg = lds + L_STG + wid * STG_W;
#pragma unroll
        for (int i = 0; i < 16; ++i) { const int cr = crow(i, h); const float rl = lw[cr];
            *(LAS float*)(stg + cr * STG_RS + r * 4) = o[0][i] * rl; *(LAS float*)(stg + cr * STG_RS + (32 + r) * 4) = o[1][i] * rl; }
#pragma unroll
        for (int it = 0; it < 4; ++it) { const int row = it * 8 + (lane >> 3), ch = lane & 7;
            const f32x4 a0 = *(const LAS f32x4*)(stg + row * STG_RS + ch * 32), a1 = *(const LAS f32x4*)(stg + row * STG_RS + ch * 32 + 16);
            const size_t grow = rowbase + qs + row;
            const u32x4 g = gv[it];
            const float g0 = bf_lo(g.x), g1 = bf_hi(g.x), g2 = bf_lo(g.y), g3 = bf_hi(g.y), g4 = bf_lo(g.z), g5 = bf_hi(g.z), g6 = bf_lo(g.w), g7 = bf_hi(g.w);
            const float y0 = a0[0] * g0, y1 = a0[1] * g1, y2 = a0[2] * g2, y3 = a0[3] * g3;
            const float y4 = a1[0] * g4, y5 = a1[1] * g5, y6 = a1[2] * g6, y7 = a1[3] * g7;
            float ss = (y0 * y0 + y1 * y1) + (y2 * y2 + y3 * y3) + (y4 * y4 + y5 * y5) + (y6 * y6 + y7 * y7);
            ss += __shfl_xor(ss, 1); ss += __shfl_xor(ss, 2); ss += __shfl_xor(ss, 4);
            u32x4 w; w.x = cvt_pk_bf16(y0, y1); w.y = cvt_pk_bf16(y2, y3); w.z = cvt_pk_bf16(y4, y5); w.w = cvt_pk_bf16(y6, y7);
            *(u32x4*)(y + grow * KOUT + head * 64 + ch * 8) = w;
            if (ch == 0) ssq[grow * 16 + head] = ss; }
        LDS_BARRIER();
        u = un;
        if (u >= uend) break;
    }
}
}

namespace lru {
constexpr int L_CW = 0, L_WT = 2048, L_STG = L_WT + 8192, STG_RS = 272, STG_W = 16 * STG_RS, L_END = L_STG + 8 * STG_W;
static_assert(L_END <= RING_BYTES, "lru LDS");
constexpr int NCH = SEQ / 128;

template <bool FIRST> __device__ __forceinline__ void load_x(u32x4 (&xv)[4][2], const bf16_t* __restrict__ z, size_t rowbase, int tok, int cbase) {
#pragma unroll
    for (int tap = 0; tap < 4; ++tap) { const int pos = tok - 3 + tap, posc = (FIRST && pos < 0) ? 0 : pos;
#pragma unroll
        for (int ks = 0; ks < 2; ++ks) xv[tap][ks] = *(const u32x4*)(z + (rowbase + posc) * NIN + cbase + 32 * ks); }
    if (FIRST) {
#pragma unroll
        for (int tap = 0; tap < 3; ++tap) if (tok - 3 + tap < 0) { xv[tap][0] = (u32x4){0u, 0u, 0u, 0u}; xv[tap][1] = (u32x4){0u, 0u, 0u, 0u}; }
    }
}

template <bool PAIRED>
__device__ __forceinline__ void unit(LAS unsigned char* lds, const bf16_t* __restrict__ z, bf16_t* __restrict__ y, float* __restrict__ ssq,
                                     const float* __restrict__ conv_w, const float* __restrict__ conv_b, const float* __restrict__ w_r, const float* __restrict__ b_r,
                                     const float* __restrict__ w_i, const float* __restrict__ b_i, const float* __restrict__ lam, int b, int blk,
                                     int half, unsigned* myseq, unsigned* pseq, float* mydata, float* pdata) {
    constexpr int STEP = PAIRED ? 2 : 1, NIT = NCH / STEP;
    const int tid = threadIdx.x, lane = tid & 63, fr = lane & 15, fq = lane >> 4, wid = __builtin_amdgcn_readfirstlane(tid >> 6);
    const size_t rowbase = (size_t)b * SEQ;
    LAS float* cw = (LAS float*)(lds + L_CW);
    if (tid < 320) { const int tap = tid >> 6, c = tid & 63; cw[tid] = (tap < 4) ? conv_w[tap * 1024 + blk * 64 + c] : conv_b[blk * 64 + c]; }
    bf16x8 bfr[2][4], bfi[2][4];
#pragma unroll
    for (int ks = 0; ks < 2; ++ks)
#pragma unroll
        for (int nt = 0; nt < 4; ++nt) {
            u32x4 wr_, wi_; unsigned* pr = (unsigned*)&wr_; unsigned* pi = (unsigned*)&wi_;
#pragma unroll
            for (int j = 0; j < 8; j += 2) { const size_t o0 = ((size_t)blk * 64 + 8 * fq + j + 32 * ks) * 64 + fr + 16 * nt;
                pr[j >> 1] = pk2(w_r[o0], w_r[o0 + 64]); pi[j >> 1] = pk2(w_i[o0], w_i[o0 + 64]); }
            bfr[ks][nt] = __builtin_bit_cast(bf16x8, wr_); bfi[ks][nt] = __builtin_bit_cast(bf16x8, wi_);
        }
    float nbr[4], nbi[4], sp[4], carry[4], Aown[4], Hown[4];
#pragma unroll
    for (int nt = 0; nt < 4; ++nt) { const int c = blk * 64 + fr + 16 * nt; nbr[nt] = -b_r[c] * LOG2E; nbi[nt] = -b_i[c] * LOG2E; sp[nt] = -8.0f * log1pf(expf(-lam[c])) * LOG2E; carry[nt] = 0.f; Aown[nt] = 1.f; Hown[nt] = 0.f; }
    __syncthreads();
    const int cbaseA = COL_XL + blk * 64 + 8 * fq;
    LAS unsigned char* stg = lds + L_STG + wid * STG_W;
    u32x4 xn[4][2], gn[2];
    if (wid == 0 && half == 0) load_x<true>(xn, z, rowbase, fr, cbaseA); else load_x<false>(xn, z, rowbase, 128 * half + 16 * wid + fr, cbaseA);
    const bf16_t* gbase = z + (rowbase + 128 * half + 16 * wid + (lane >> 3)) * NIN + COL_GL + blk * 64 + (lane & 7) * 8;
    gn[0] = *(const u32x4*)gbase; gn[1] = *(const u32x4*)(gbase + (size_t)8 * NIN);
    for (int kk = 0; kk < NIT; ++kk) {
        asm volatile("" ::: "memory");
        const int k = half + STEP * kk;
        const int tw = 128 * k + 16 * wid;
        bf16x8 uA[2];
#pragma unroll
        for (int ks = 0; ks < 2; ++ks) {
            float u[8];
            { const f32x4 b0 = *(const LAS f32x4*)(cw + 4 * 64 + 32 * ks + 8 * fq), b1 = *(const LAS f32x4*)(cw + 4 * 64 + 32 * ks + 8 * fq + 4);
              u[0] = b0[0]; u[1] = b0[1]; u[2] = b0[2]; u[3] = b0[3]; u[4] = b1[0]; u[5] = b1[1]; u[6] = b1[2]; u[7] = b1[3]; }
#pragma unroll
            for (int tap = 0; tap < 4; ++tap) { const f32x4 w0 = *(const LAS f32x4*)(cw + tap * 64 + 32 * ks + 8 * fq), w1 = *(const LAS f32x4*)(cw + tap * 64 + 32 * ks + 8 * fq + 4); const u32x4 xx = xn[tap][ks];
                u[0] += w0[0] * bf_lo(xx.x); u[1] += w0[1] * bf_hi(xx.x); u[2] += w0[2] * bf_lo(xx.y); u[3] += w0[3] * bf_hi(xx.y);
                u[4] += w1[0] * bf_lo(xx.z); u[5] += w1[1] * bf_hi(xx.z); u[6] += w1[2] * bf_lo(xx.w); u[7] += w1[3] * bf_hi(xx.w); }
            u32x4 pw; pw.x = cvt_pk_bf16(u[0], u[1]); pw.y = cvt_pk_bf16(u[2], u[3]); pw.z = cvt_pk_bf16(u[4], u[5]); pw.w = cvt_pk_bf16(u[6], u[7]);
            uA[ks] = __builtin_bit_cast(bf16x8, pw);
            *(LAS f32x4*)(stg + fr * STG_RS + (32 * ks + 8 * fq) * 4) = (f32x4){u[0], u[1], u[2], u[3]};
            *(LAS f32x4*)(stg + fr * STG_RS + (32 * ks + 8 * fq) * 4 + 16) = (f32x4){u[4], u[5], u[6], u[7]};
        }
        const u32x4 gc0 = gn[0], gc1 = gn[1];
        if (kk + 1 < NIT) { load_x<false>(xn, z, rowbase, tw + 128 * STEP + fr, cbaseA); const bf16_t* gp = gbase + (size_t)(128 * STEP * (kk + 1)) * NIN; gn[0] = *(const u32x4*)gp; gn[1] = *(const u32x4*)(gp + (size_t)8 * NIN); }
        float Al[4][4], Hl[4][4], At_[4], Ht_[4];
#pragma unroll
        for (int nt = 0; nt < 4; ++nt) {
            f32x4 R = {0.f, 0.f, 0.f, 0.f}, I = R;
            R = __builtin_amdgcn_mfma_f32_16x16x32_bf16(uA[0], bfr[0][nt], R, 0, 0, 0); R = __builtin_amdgcn_mfma_f32_16x16x32_bf16(uA[1], bfr[1][nt], R, 0, 0, 0);
            I = __builtin_amdgcn_mfma_f32_16x16x32_bf16(uA[0], bfi[0][nt], I, 0, 0, 0); I = __builtin_amdgcn_mfma_f32_16x16x32_bf16(uA[1], bfi[1][nt], I, 0, 0, 0);
            float A = 1.f, H = 0.f;
#pragma unroll
            for (int ip = 0; ip < 2; ++ip) {
                const f32x2 uc = {*(const LAS float*)(stg + (4 * fq + 2 * ip) * STG_RS + (fr + 16 * nt) * 4), *(const LAS float*)(stg + (4 * fq + 2 * ip + 1) * STG_RS + (fr + 16 * nt) * 4)};
                const f32x2 R2 = {R[2 * ip], R[2 * ip + 1]}, I2 = {I[2 * ip], I[2 * ip + 1]};
                const f32x2 t1 = R2 * (-LOG2E) + nbr[nt], t2 = I2 * (-LOG2E) + nbi[nt];
                f32x2 d1 = {__builtin_amdgcn_exp2f(t1.x), __builtin_amdgcn_exp2f(t1.y)}, d2 = {__builtin_amdgcn_exp2f(t2.x), __builtin_amdgcn_exp2f(t2.y)};
                d1 = d1 + 1.0f; d2 = d2 + 1.0f;
                const f32x2 dd = d1 * d2; const f32x2 inv = {__builtin_amdgcn_rcpf(dd.x), __builtin_amdgcn_rcpf(dd.y)};
                const f32x2 rg = d2 * inv, ig = d1 * inv, la = rg * sp[nt];
                const f32x2 a = {__builtin_amdgcn_exp2f(la.x), __builtin_amdgcn_exp2f(la.y)};
                const f32x2 om = 1.0f - a * a; const f32x2 sq = {__builtin_amdgcn_sqrtf(om.x), __builtin_amdgcn_sqrtf(om.y)};
                const f32x2 bb = sq * (ig * uc);
                H = a.x * H + bb.x; A = A * a.x; Al[nt][2 * ip] = A; Hl[nt][2 * ip] = H;
                H = a.y * H + bb.y; A = A * a.y; Al[nt][2 * ip + 1] = A; Hl[nt][2 * ip + 1] = H;
            }
            float pA = __shfl_up(A, 16), pH = __shfl_up(H, 16);
            if (fq >= 1) { H = A * pH + H; A = A * pA; }
            pA = __shfl_up(A, 32); pH = __shfl_up(H, 32);
            if (fq >= 2) { H = A * pH + H; A = A * pA; }
            At_[nt] = A; Ht_[nt] = H;
            if (fq == 3) *(LAS f32x2*)(lds + L_WT + (((kk & 1) * 8 + wid) * 64 + nt * 16 + fr) * 8) = (f32x2){A, H};
        }
        LDS_BARRIER();
        float Ap[4], Hp[4];
        if constexpr (PAIRED) {
            if (wid == 0 && k + 1 < NCH) {
                unsigned long long* slotp = (unsigned long long*)mydata + (kk & 3) * 64 + fr; const unsigned tag = 0x11u + (unsigned)kk;
#pragma unroll
                for (int nt = 0; nt < 4; ++nt) {
                    float Ar = 1.f, Hr = 0.f;
#pragma unroll
                    for (int w = 0; w < 8; ++w) { const f32x2 t = *(const LAS f32x2*)(lds + L_WT + (((kk & 1) * 8 + w) * 64 + nt * 16 + fr) * 8); Hr = t.x * Hr + t.y; Ar = Ar * t.x; }
                    if (fq == 0) __hip_atomic_store(slotp + nt * 16, ((unsigned long long)__float_as_uint(Hr) << 32) | (unsigned long long)((__float_as_uint(Ar) & 0xffffff00u) | tag), __ATOMIC_RELAXED, __HIP_MEMORY_SCOPE_AGENT);
                }
            }
            if (k > 0) {
                const unsigned need = half ? (unsigned)(kk + 1) : (unsigned)kk, tag = 0x10u + need; unsigned spn = 0;
                const unsigned long long* pd = (const unsigned long long*)pdata + ((need - 1u) & 3u) * 64 + fr;
                for (;;) {
                    unsigned long long v[4]; bool ok = true;
#pragma unroll
                    for (int nt = 0; nt < 4; ++nt) { v[nt] = __hip_atomic_load(pd + nt * 16, __ATOMIC_RELAXED, __HIP_MEMORY_SCOPE_AGENT); ok = ok && (((unsigned)v[nt] & 0xffu) == tag); }
#pragma unroll
                    for (int nt = 0; nt < 4; ++nt) { Ap[nt] = __uint_as_float((unsigned)v[nt] & 0xffffff00u); Hp[nt] = __uint_as_float((unsigned)(v[nt] >> 32)); }
                    if (__all(ok) || ++spn > (1u << 20)) break;
                }
            } else {
#pragma unroll
                for (int nt = 0; nt < 4; ++nt) { Ap[nt] = 0.f; Hp[nt] = 0.f; }
            }
        }
#pragma unroll
        for (int nt = 0; nt < 4; ++nt) {
            float Ar = 1.f, Hr = 0.f, Ain = 1.f, Hin = 0.f;
#pragma unroll
            for (int w = 0; w < 8; ++w) { const f32x2 t = *(const LAS f32x2*)(lds + L_WT + (((kk & 1) * 8 + w) * 64 + nt * 16 + fr) * 8); if (w == wid) { Ain = Ar; Hin = Hr; } Hr = t.x * Hr + t.y; Ar = Ar * t.x; }
            float cc;
            if constexpr (PAIRED) { cc = Ap[nt] * (Aown[nt] * carry[nt] + Hown[nt]) + Hp[nt]; carry[nt] = cc; Aown[nt] = Ar; Hown[nt] = Hr; }
            else { cc = carry[nt]; carry[nt] = Ar * cc + Hr; }
            const float cin = Ain * cc + Hin;
            float eA = __shfl_up(At_[nt], 16), eH = __shfl_up(Ht_[nt], 16);
            if (fq == 0) { eA = 1.f; eH = 0.f; }
            const float hin = eA * cin + eH;
#pragma unroll
            for (int i = 0; i < 4; ++i) *(LAS float*)(stg + (4 * fq + i) * STG_RS + (fr + 16 * nt) * 4) = Hl[nt][i] + Al[nt][i] * hin;
        }
#pragma unroll
        for (int it = 0; it < 2; ++it) { const int row = it * 8 + (lane >> 3), ch = lane & 7;
            const f32x4 a0 = *(const LAS f32x4*)(stg + row * STG_RS + ch * 32), a1 = *(const LAS f32x4*)(stg + row * STG_RS + ch * 32 + 16);
            const size_t grow = rowbase + tw + row;
            const u32x4 g = it ? gc1 : gc0;
            const float y0 = a0[0] * bf_lo(g.x), y1 = a0[1] * bf_hi(g.x), y2 = a0[2] * bf_lo(g.y), y3 = a0[3] * bf_hi(g.y);
            const float y4 = a1[0] * bf_lo(g.z), y5 = a1[1] * bf_hi(g.z), y6 = a1[2] * bf_lo(g.w), y7 = a1[3] * bf_hi(g.w);
            float ss = (y0 * y0 + y1 * y1) + (y2 * y2 + y3 * y3) + (y4 * y4 + y5 * y5) + (y6 * y6 + y7 * y7);
            ss += __shfl_xor(ss, 1); ss += __shfl_xor(ss, 2); ss += __shfl_xor(ss, 4);
            u32x4 w; w.x = cvt_pk_bf16(y0, y1); w.y = cvt_pk_bf16(y2, y3); w.z = cvt_pk_bf16(y4, y5); w.w = cvt_pk_bf16(y6, y7);
            *(u32x4*)(y + grow * KOUT + 1024 + blk * 64 + ch * 8) = w;
            if (ch == 0) ssq[grow * 16 + blk] = ss; }
    }
    __syncthreads();
}
}

#define XB_TMO      128
#define XB_XCNT(j)  (256  + 64 * (j))
#define XB_XSUB(j)  (1280 + 64 * (j))
#define XB_XGEN(j)  (2304 + 64 * (j))
#define XB_TOP      3328
#define XB_TOPGEN   3392
#define XCD_BAR_WORDS 3456
#define XB_SPIN_CAP (1u << 18)
__device__ __forceinline__ unsigned xb_ld(unsigned* p)              { return __hip_atomic_load(p, __ATOMIC_RELAXED, __HIP_MEMORY_SCOPE_AGENT); }
__device__ __forceinline__ unsigned xb_add(unsigned* p, unsigned v) { return __hip_atomic_fetch_add(p, v, __ATOMIC_RELAXED, __HIP_MEMORY_SCOPE_AGENT); }
__device__ __forceinline__ unsigned xb_xcc_id() { return (unsigned)__builtin_amdgcn_s_getreg((3 << 11) | 20) & 0xFu; }
#define XB_SPIN(cond, bar) do { unsigned _sp = 0; while (cond) { __builtin_amdgcn_s_sleep(1); \
    if ((++_sp & 255u) == 0u) { if (xb_ld(&(bar)[XB_TMO])) break; if (_sp > XB_SPIN_CAP) { atomicAdd(&(bar)[XB_TMO], 1u); break; } } } } while (0)
struct XcdBarrier { unsigned* bar; unsigned x; volatile LAS unsigned* st; };
__device__ __forceinline__ XcdBarrier xcd_barrier_post(unsigned* bar, volatile LAS unsigned* st) {
    XcdBarrier b; b.bar = bar; b.x = xb_xcc_id(); b.st = st;
    if (threadIdx.x == 0) (void)xb_add(&bar[XB_XCNT(b.x)], 1u);
    return b;
}
__device__ __forceinline__ void xcd_barrier_complete(unsigned* bar, unsigned x, unsigned& nloc, unsigned& nx) {
    const unsigned G = gridDim.x * gridDim.y * gridDim.z;
    unsigned sum, cnt, mine, sp = 0u;
    for (;;) {
        sum = 0u; cnt = 0u; mine = 0u;
#pragma unroll
        for (unsigned j = 0; j < 16; ++j) { const unsigned c = xb_ld(&bar[XB_XCNT(j)]); sum += c; cnt += (c > 0u) ? 1u : 0u; mine = (j == x) ? c : mine; }
        if (sum == G) break;
        __builtin_amdgcn_s_sleep(1);
        if ((++sp & 255u) == 0u) { if (xb_ld(&bar[XB_TMO])) break; if (sp > XB_SPIN_CAP) { atomicAdd(&bar[XB_TMO], 1u); break; } }
    }
    nloc = mine > 0u ? mine : 1u; nx = cnt > 0u ? cnt : 1u;
}
__device__ __forceinline__ void xcd_barrier(const XcdBarrier& b) {
    asm volatile("s_waitcnt vmcnt(0)" ::: "memory");
    __syncthreads();
    if (threadIdx.x == 0) {
        unsigned* bar = b.bar;
        __builtin_amdgcn_s_waitcnt(0);
        unsigned nloc = b.st[0], nx = b.st[1];
        if (nloc == 0u) { xcd_barrier_complete(bar, b.x, nloc, nx); b.st[0] = nloc; b.st[1] = nx; }
        const unsigned old = xb_add(&bar[XB_XSUB(b.x)], 1u);
        const unsigned gen = old / nloc;
        if (old + 1u == (gen + 1u) * nloc) {
            __builtin_amdgcn_fence(__ATOMIC_RELEASE, "agent");
            asm volatile("s_waitcnt vmcnt(0)" ::: "memory");
            const unsigned og = xb_add(&bar[XB_TOP], 1u);
            const unsigned tg = og / nx;
            if (og + 1u == (tg + 1u) * nx) xb_add(&bar[XB_TOPGEN], 1u);
            else XB_SPIN(xb_ld(&bar[XB_TOPGEN]) == tg, bar);
            __builtin_amdgcn_fence(__ATOMIC_ACQUIRE, "agent");
            xb_add(&bar[XB_XGEN(b.x)], 1u);
            asm volatile("s_waitcnt vmcnt(0)" ::: "memory");
        } else {
            XB_SPIN(xb_ld(&bar[XB_XGEN(b.x)]) == gen, bar);
            __builtin_amdgcn_fence(__ATOMIC_ACQUIRE, "agent");
            asm volatile("s_waitcnt vmcnt(0)" ::: "memory");
        }
    }
    __syncthreads();
}

struct Params {
    const float* x; const float* ln_gain; const float* w_in; const float* sinks; const float* conv_w; const float* conv_b;
    const float* w_r; const float* b_r; const float* w_i; const float* b_i; const float* lam; const float* ga; const float* gl; const float* w_out; const float* fg;
    float* out; unsigned char* ws; int ph_lo, ph_hi;
};

__global__ void __launch_bounds__(512, 2) mega(Params p) {
    extern __shared__ __attribute__((aligned(16))) unsigned char lds_raw[];
    LAS unsigned char* lds = (LAS unsigned char*)lds_raw;
    const int tid = threadIdx.x, lane = tid & 63, wave = __builtin_amdgcn_readfirstlane(tid >> 6);
    const int G = gridDim.x, bx = blockIdx.x;
    unsigned char* ws = p.ws;
    unsigned* ctl = (unsigned*)(ws + WS_CTL);
    bf16_t* WinT = (bf16_t*)(ws + WS_WIN); bf16_t* WoutT = (bf16_t*)(ws + WS_WOUT);
    float* cs = (float*)(ws + WS_CS); float* sn = (float*)(ws + WS_SN);
    float* ssqa = (float*)(ws + WS_SSQA); float* ssql = (float*)(ws + WS_SSQL); float* pss = (float*)(ws + WS_PSS);
    bf16_t* XN = (bf16_t*)(ws + WS_XN); bf16_t* Y = (bf16_t*)(ws + WS_Y); bf16_t* Z = (bf16_t*)(ws + WS_Z);
    const int lo = p.ph_lo, hi = p.ph_hi;
#define IN(k) (lo <= (k) && (k) < hi)
    if (tid < 32) ((LAS unsigned*)(lds + MISC_OFF))[tid] = 0u;
    __syncthreads();
    XcdBarrier bar; bar.bar = ctl + CW_BAR; bar.x = 0; bar.st = nullptr;
    if (hi - lo > 1) bar = xcd_barrier_post(ctl + CW_BAR, (volatile LAS unsigned*)(lds + MISC_OFF) + 8);
    if (hi > 1000) cg::this_grid().sync();
    const unsigned long long t_start = (PROBE_SEAM >= 0) ? __builtin_amdgcn_s_memrealtime() : 0ull;
#define SEAM(k) do { if (IN(k) && IN((k) + 1)) { if (PROBE_SEAM == (k)) { while (__builtin_amdgcn_s_memrealtime() - t_start < (unsigned long long)(PROBE_X_US) * 100ull) __builtin_amdgcn_s_sleep(8); } \
    for (int rs_ = 0; rs_ < REP_SYNC; ++rs_) xcd_barrier(bar); } } while (0)

    if (IN(0)) for (int rep = 0; rep < REP_P0; ++rep) {
        LAS float* scr = (LAS float*)(lds + wave * 16384);
        const int gw = bx * 8 + wave, NGW = G * 8;
        constexpr int I_IN = (DM / 64) * (NIN / 32), I_OUT = (KOUT / 64) * (DM / 32);
        for (int e = bx * 512 + tid; e < SEQ * 8; e += G * 512) {
            const int pos = e >> 3, i = e & 7;
            const double invf = (i == 0) ? 1.0 : (i == 1) ? 0.19392274474868576 : (i == 2) ? 0.03760603093086393 : (i == 3) ? 0.007292664737217109 : (i == 4) ? 0.001414213562373095
                              : (i == 5) ? 0.0002742481756762073 : (i == 6) ? 5.318295896944988e-05 : 1.031338537721246e-05;
            double s, c; sincos_d((double)pos * invf, s, c); cs[e] = (float)c; sn[e] = (float)s;
        }
        {
            const f32x4* gr = (const f32x4*)p.ln_gain + lane;
            f32x4 gq[4];
#pragma unroll
            for (int j = 0; j < 4; ++j) gq[j] = gr[64 * j];
            for (int m0 = gw * 4; m0 < M_TOK; m0 += NGW * 4) {
                f32x4 v[4][4]; float s2[4];
#pragma unroll
                for (int rr = 0; rr < 4; ++rr) { const f32x4* xr = (const f32x4*)(p.x + (size_t)(m0 + rr) * DM) + lane;
#pragma unroll
                    for (int j = 0; j < 4; ++j) v[rr][j] = __builtin_nontemporal_load(xr + 64 * j); }
#pragma unroll
                for (int rr = 0; rr < 4; ++rr) { float t = 0.f;
#pragma unroll
                    for (int j = 0; j < 4; ++j) t += (v[rr][j].x * v[rr][j].x + v[rr][j].y * v[rr][j].y) + (v[rr][j].z * v[rr][j].z + v[rr][j].w * v[rr][j].w);
                    s2[rr] = t; }
#pragma unroll
                for (int o = 1; o < 64; o <<= 1) {
#pragma unroll
                    for (int rr = 0; rr < 4; ++rr) s2[rr] += __shfl_xor(s2[rr], o); }
#pragma unroll
                for (int rr = 0; rr < 4; ++rr) { const float rstd = 1.0f / sqrtf(s2[rr] * (1.f / DM) + EPS);
                    u32x2* o8 = (u32x2*)(XN + (size_t)(m0 + rr) * DM) + lane;
#pragma unroll
                    for (int j = 0; j < 4; ++j) { const f32x4 g = gq[j]; u32x2 w; w.x = cvt_pk_bf16(v[rr][j].x * rstd * g.x, v[rr][j].y * rstd * g.y); w.y = cvt_pk_bf16(v[rr][j].z * rstd * g.z, v[rr][j].w * rstd * g.w); o8[64 * j] = w; } }
            }
        }
        for (int it = gw; it < I_IN + I_OUT; it += NGW) {
            if (it < I_IN) p0_transpose_item(p.w_in, DM, NIN, WinT, nullptr, scr, it, lane);
            else { const int r = it - I_IN; const int kb = r / (DM / 32); p0_transpose_item(p.w_out, KOUT, DM, WoutT, (kb < 16) ? p.ga : (p.gl - 1024), scr, r, lane); }
        }
    }
    SEAM(0);

    if (IN(1)) {
        pg8::Gemm g{XN, WinT, M_TOK, NIN, DM}; pg8::StaticOrder S; S.init(M_TOK, NIN, G, bx, REP_P1, P1_WGM);
        EpiZ E{Z, cs, sn};
        pg8::gemm_phase<EpiZ, pg8::StaticOrder, true>(lds, g, S, E);
    }
    SEAM(1);

    if (IN(2)) {
        {
            const int uu = bx & 127, half = (bx >> 7) & 1;
            unsigned* sq = ctl + CW_LRU + uu * 128; float* mb = (float*)(ws + WS_MB) + uu * 1024;
            lru::unit<true>(lds, Z, Y, ssql, p.conv_w, p.conv_b, p.w_r, p.b_r, p.w_i, p.b_i, p.lam, uu >> 4, uu & 15, half, sq + 64 * half, sq + 64 * (half ^ 1), mb + 512 * half, mb + 512 * (half ^ 1));
        }
        LAS int* ubox = (LAS int*)(lds + MISC_OFF);
        for (int rep = 0; rep < REP_P2A; ++rep) { att::run(lds, Z, Y, ssqa, p.sinks, ctl + 64 + 64 * rep, ubox); __syncthreads(); }
    }
    SEAM(2);

    if (IN(3)) {
        pg8::Gemm g{Y, WoutT, M_TOK, DM, KOUT}; pg8::StaticOrder S; S.init(M_TOK, DM, G, bx, REP_P3);
        LAS f32x2* RS = (LAS f32x2*)(lds + RS_OFF);
        pg8::Unit u;
        for (int i = 0; i < 4 && S.next(i, u); ++i) {
            if (tid < 256) { const size_t row = (size_t)u.pm * 256 + tid; const f32x4* pa = (const f32x4*)(ssqa + row * 16); const f32x4* pl = (const f32x4*)(ssql + row * 16);
                float sa = 0.f, sl = 0.f;
#pragma unroll
                for (int j = 0; j < 4; ++j) { const f32x4 a = pa[j], l = pl[j]; sa += (a.x + a.y) + (a.z + a.w); sl += (l.x + l.y) + (l.z + l.w); }
                const float rA = 1.0f / sqrtf(sa * (1.f / 1024.f) + EPS), rB = 1.0f / sqrtf(sl * (1.f / 1024.f) + EPS);
                RS[i * 256 + tid] = (f32x2){rA / rB, rB}; }
        }
        __syncthreads();
        EpiOutF E{p.x, p.out, p.fg, pss, ctl + CW_PANEL, RS, (LAS float*)(lds + RS_OFF + 8192), (LAS float*)(lds + RS_OFF + 8192 + 4096)};
        pg8::gemm_phase<EpiOutF, pg8::StaticOrder, true>(lds, g, S, E);
    }
    SEAM(3);

    if (IN(4)) {
        const int gw = bx * 8 + wave, NGW = G * 8;
        const f32x4* fgr = (const f32x4*)p.fg + lane;
        for (int rep = 0; rep < REP_P4; ++rep)
        for (int m = gw; m < M_TOK; m += NGW) {
            float s2 = (lane < 16) ? pss[(size_t)m * 16 + lane] : 0.f;
            s2 += __shfl_xor(s2, 1); s2 += __shfl_xor(s2, 2); s2 += __shfl_xor(s2, 4); s2 += __shfl_xor(s2, 8);
            s2 = __shfl(s2, 0);
            float rstd = 1.0f / sqrtf(s2 * (1.f / DM) + EPS);
            if (rep > 0) rstd = 1.0f;
            f32x4* orow = (f32x4*)(p.out + (size_t)m * DM) + lane;
#pragma unroll
            for (int j = 0; j < 4; ++j) { const f32x4 t = orow[64 * j]; f32x4 g = fgr[64 * j]; if (rep > 0) g = (f32x4){1.f, 1.f, 1.f, 1.f}; orow[64 * j] = t * rstd * g; }
        }
    }
#undef IN
#undef SEAM
}

extern "C" void kernel_launch(void* const* d_in, const int* in_sizes, int n_in, void* d_out, int out_size, void* d_ws, size_t ws_size, hipStream_t stream) {
    static int grid = 0;
    if (grid == 0) {
        if (n_in != 15 || in_sizes[0] != M_TOK * DM || out_size != M_TOK * DM || ws_size < WS_END) { fprintf(stderr, "kernel_launch: unexpected shapes (n_in %d, ws %zu)\n", n_in, ws_size); grid = -1; return; }
        int dev = 0, cus = 0, per_cu = 0;
        (void)hipGetDevice(&dev); (void)hipDeviceGetAttribute(&cus, hipDeviceAttributeMultiprocessorCount, dev);
        if (hipFuncSetAttribute((const void*)mega, hipFuncAttributeMaxDynamicSharedMemorySize, LDS_BYTES) != hipSuccess) { fprintf(stderr, "kernel_launch: hipFuncSetAttribute failed\n"); grid = -1; return; }
        if (hipOccupancyMaxActiveBlocksPerMultiprocessor(&per_cu, (const void*)mega, 512, LDS_BYTES) != hipSuccess || per_cu < 1) { fprintf(stderr, "kernel_launch: occupancy query says %d\n", per_cu); per_cu = 1; }
        (void)hipGetLastError();
        grid = 256;
        if (cus * per_cu < 256) fprintf(stderr, "kernel_launch: device capacity %d x %d < 256 workgroups\n", cus, per_cu);
    }
    if (grid < 0) return;
    (void)hipMemsetAsync((char*)d_ws + WS_CTL, 0, 131072 + 524288, stream);
    Params p{};
    p.x = (const float*)d_in[0]; p.ln_gain = (const float*)d_in[1]; p.w_in = (const float*)d_in[2]; p.sinks = (const float*)d_in[3]; p.conv_w = (const float*)d_in[4]; p.conv_b = (const float*)d_in[5];
    p.w_r = (const float*)d_in[6]; p.b_r = (const float*)d_in[7]; p.w_i = (const float*)d_in[8]; p.b_i = (const float*)d_in[9]; p.lam = (const float*)d_in[10]; p.ga = (const float*)d_in[11]; p.gl = (const float*)d_in[12];
    p.w_out = (const float*)d_in[13]; p.fg = (const float*)d_in[14]; p.out = (float*)d_out; p.ws = (unsigned char*)d_ws;
    if (MK_N_LAUNCHES == 1) {
        p.ph_lo = 0; p.ph_hi = 4; void* args[] = {&p};
        hipError_t e = hipLaunchCooperativeKernel((const void*)mega, dim3(grid), dim3(512), args, LDS_BYTES, stream);
        if (e != hipSuccess) fprintf(stderr, "kernel_launch: cooperative launch failed: %s (grid %d)\n", hipGetErrorString(e), grid);
    } else {
        for (int ph = 0; ph < 4; ++ph) { p.ph_lo = ph; p.ph_hi = ph + 1; hipLaunchKernelGGL(mega, dim3(grid), dim3(512), LDS_BYTES, stream, p); }
    }
}
```

```cpp
#include <hip/hip_runtime.h>
#include <hip/hip_cooperative_groups.h>
#include <cstdio>
#include <cstdint>
namespace cg = cooperative_groups;

#ifndef MK_N_LAUNCHES
#define MK_N_LAUNCHES 1
#endif

#ifndef REP_P0
#define REP_P0 1
#endif
#ifndef REP_P1
#define REP_P1 1
#endif
#ifndef REP_P2L
#define REP_P2L 1
#endif
#ifndef REP_P2A
#define REP_P2A 1
#endif
#ifndef REP_P3
#define REP_P3 1
#endif
#ifndef REP_P4
#define REP_P4 1
#endif
#ifndef REP_SYNC
#define REP_SYNC 1
#endif
#ifndef P1_WGM
#define P1_WGM 2
#endif
#ifndef PROBE_SEAM
#define PROBE_SEAM -1
#endif
#ifndef PROBE_X_US
#define PROBE_X_US 0
#endif

#define LAS __attribute__((address_space(3)))
typedef unsigned short bf16_t;
typedef short bf16x8 __attribute__((ext_vector_type(8)));
typedef short s16x4 __attribute__((ext_vector_type(4)));
typedef float f32x4 __attribute__((ext_vector_type(4)));
typedef float f32x2 __attribute__((ext_vector_type(2)));
typedef float f32x16 __attribute__((ext_vector_type(16)));
typedef unsigned u32x4 __attribute__((ext_vector_type(4)));
typedef unsigned u32x2 __attribute__((ext_vector_type(2)));

constexpr int SEQ = 4096, NB = 8, M_TOK = NB * SEQ, DM = 1024, NIN = 4608, KOUT = 2048;
constexpr int COL_Q = 0, COL_K = 1024, COL_V = 1280, COL_GA = 1536, COL_XL = 2560, COL_GL = 3584;
constexpr float EPS = 1e-6f;
constexpr float LOG2E = 1.4426950408889634f;
constexpr float C2 = 0.125f * LOG2E;

constexpr size_t MiB = 1u << 20;
constexpr size_t WS_CTL = 0;
constexpr int CW_BAR = 1024;
constexpr int CW_PANEL = 8192;
constexpr int CW_LRU = 16384;
constexpr size_t WS_WIN = 2 * MiB;
constexpr size_t WS_WOUT = 12 * MiB;
constexpr size_t WS_CS = 16 * MiB;
constexpr size_t WS_SN = 16 * MiB + 128 * 1024;
constexpr size_t WS_MB = 128 * 1024;
constexpr size_t WS_SSQA = 17 * MiB;
constexpr size_t WS_SSQL = 19 * MiB;
constexpr size_t WS_PSS = 21 * MiB;
constexpr size_t WS_XN = 32 * MiB;
constexpr size_t WS_Y = 32 * MiB;
constexpr size_t WS_Z = 160 * MiB;
constexpr size_t WS_END = 448 * MiB;

constexpr int RING_BYTES = 131072;
constexpr int MISC_OFF = RING_BYTES;
constexpr int RS_OFF = RING_BYTES + 512;
constexpr int LDS_BYTES = 147456;

#define LDS_BARRIER() asm volatile("s_waitcnt lgkmcnt(0)\n\ts_barrier" ::: "memory")
__device__ __forceinline__ unsigned cvt_pk_bf16(float lo, float hi) { unsigned r; asm volatile("v_cvt_pk_bf16_f32 %0, %1, %2" : "=v"(r) : "v"(lo), "v"(hi)); return r; }
__device__ __forceinline__ float bf_lo(unsigned w) { return __uint_as_float(w << 16); }
__device__ __forceinline__ float bf_hi(unsigned w) { return __uint_as_float(w & 0xffff0000u); }
__device__ __forceinline__ unsigned f2bf(float f) { unsigned u = __float_as_uint(f); return (u + 0x7fffu + ((u >> 16) & 1u)) >> 16; }
__device__ __forceinline__ unsigned pk2(float lo, float hi) { return f2bf(lo) | (f2bf(hi) << 16); }
__device__ __forceinline__ float fast_sigmoid(float v) { return __builtin_amdgcn_rcpf(1.0f + __builtin_amdgcn_exp2f(-v * LOG2E)); }

namespace pg8 {
constexpr int BM = 256, BK = 64, HALF = 128, HTB = HALF * BK * 2, STAGE_BYTES = 8 * HTB, NXCD = 8, WGM = 8;
__host__ __device__ __forceinline__ int lds_byte(int r, int c) { const int st = (r >> 4) * 2 + (c >> 5), rr = r & 15, cc = c & 31, ob = rr * 64 + cc * 2; return st * 1024 + (ob ^ (((ob >> 9) & 1) << 5)); }
__host__ __device__ __forceinline__ void stage_rc(int b, int& R, int& C) { const int st = b / 1024, sb = b % 1024, swz = sb ^ (((sb >> 9) & 1) << 5); R = (st >> 1) * 16 + swz / 64; C = (st & 1) * 32 + (swz % 64) / 2; }
__host__ __device__ __forceinline__ int perm32(int rho) { const int n = rho >> 4, i = rho & 15; return 8 * (i >> 2) + 4 * n + (i & 3); }

struct Unit { int pm, pn; };
struct Gemm { const bf16_t* A; const bf16_t* Bt; int M, N, K; };

struct StaticOrder {
    int nM, nN, nwg, G, c, rep, wgm;
    __host__ __device__ void init(int M, int N, int G_, int c_, int rep_ = 1, int wgm_ = WGM) { nM = M / BM; nN = N / BM; nwg = nM * nN; G = G_; c = c_; rep = rep_; wgm = wgm_; }
    __host__ __device__ bool next(int i, Unit& u) const {
        const long L = (long)i * G + c; if (L >= (long)nwg * rep) return false;
        int wgid = (int)(L % nwg); { const int q = nwg / NXCD, r = nwg % NXCD, xcd = wgid % NXCD, off = wgid / NXCD; wgid = (xcd < r ? xcd * (q + 1) : r * (q + 1) + (xcd - r) * q) + off; }
        const int nig = wgm * nN, gid = wgid / nig, fm = gid * wgm, gsz = (nM - fm) < wgm ? (nM - fm) : wgm;
        u.pm = fm + ((wgid % nig) % gsz); u.pn = (wgid % nig) / gsz; return true;
    }
};

template <class Epi, class Sched, bool ALIGN_EPI>
__device__ __forceinline__ void gemm_phase(LAS unsigned char* lds, const Gemm g, const Sched& S, const Epi& E) {
    const int tid = threadIdx.x, wid = __builtin_amdgcn_readfirstlane(tid >> 6), lane = tid & 63, wr = wid >> 2, wc = wid & 3, fr = lane & 15, fq = lane >> 4;
    const int K = g.K, nt = K / BK;
    unsigned voffA[2], voffB[2];
#pragma unroll
    for (int i = 0; i < 2; ++i) { int R, C; stage_rc(tid * 16 + i * 8192, R, C); const int Rb = Epi::PERM ? ((R & ~31) + perm32(R & 31)) : R;
        voffA[i] = (unsigned)(R * K + C) * 2u; voffB[i] = (unsigned)(Rb * K + C) * 2u; }
    const size_t kstep = (size_t)(BK * 2);
    const size_t hstep = (size_t)HALF * K * 2;
    const size_t tstep = 2 * hstep;
    const unsigned ldsw = (unsigned)wid * 1024u;
    const int aoff = lds_byte(wr * 64 + fr, fq * 8), boff = lds_byte(wc * 32 + fr, fq * 8);
#define PG8_SA(b, h) (((b) * 2 + (h)) * HTB)
#define PG8_SB(b, h) ((4 + (b) * 2 + (h)) * HTB)
#define PG8_STAGE(bufoff, gbase, voff) do { _Pragma("unroll") for (int _i = 0; _i < 2; ++_i) \
        __builtin_amdgcn_global_load_lds((const unsigned*)((const char*)(gbase) + (voff)[_i]), (LAS unsigned*)(lds + (bufoff) + ldsw + _i * 8192), 16, 0, 0); } while (0)
#define PG8_LDA(dst, b, h) do { _Pragma("unroll") for (int m = 0; m < 4; ++m) _Pragma("unroll") for (int k = 0; k < 2; ++k) dst[m][k] = *(const LAS bf16x8*)(lds + PG8_SA(b, h) + aoff + m * 2048 + k * 1024); } while (0)
#define PG8_LDB(dst, b, h) do { _Pragma("unroll") for (int n = 0; n < 2; ++n) _Pragma("unroll") for (int k = 0; k < 2; ++k) dst[n][k] = *(const LAS bf16x8*)(lds + PG8_SB(b, h) + boff + n * 2048 + k * 1024); } while (0)
#define PG8_MMA(ai, bj, At, Bt) do { __builtin_amdgcn_s_setprio(1); _Pragma("unroll") for (int m = 0; m < 4; ++m) _Pragma("unroll") for (int n = 0; n < 2; ++n) _Pragma("unroll") for (int k = 0; k < 2; ++k) \
        acc[ai][bj][m][n] = __builtin_amdgcn_mfma_f32_16x16x32_bf16(Bt[n][k], At[m][k], acc[ai][bj][m][n], 0, 0, 0); __builtin_amdgcn_s_setprio(0); } while (0)
#define PG8_WAIT_V(n) asm volatile("s_waitcnt vmcnt(" #n ")" ::: "memory")
#define PG8_WAIT_L(n) asm volatile("s_waitcnt lgkmcnt(" #n ")" ::: "memory")
#define PG8_BAR __builtin_amdgcn_s_barrier()
#define PG8_SCHED __builtin_amdgcn_sched_barrier(0)
    Unit cur, nxt; int ui = 0;
    if (!S.next(0, cur)) return;
    f32x4 acc[2][2][4][2];
#pragma unroll
    for (int a = 0; a < 2; ++a)
#pragma unroll
        for (int b = 0; b < 2; ++b)
#pragma unroll
            for (int m = 0; m < 4; ++m)
#pragma unroll
                for (int n = 0; n < 2; ++n) acc[a][b][m][n] = (f32x4){0.f, 0.f, 0.f, 0.f};
    bf16x8 At[4][2], B0[2][2], B1[2][2];
    const char* cA = (const char*)g.A + (size_t)cur.pm * tstep; const char* cB = (const char*)g.Bt + (size_t)cur.pn * tstep;
    PG8_STAGE(PG8_SB(0, 0), cB, voffB); PG8_STAGE(PG8_SB(0, 1), cB + hstep, voffB); PG8_STAGE(PG8_SA(0, 0), cA, voffA); PG8_STAGE(PG8_SA(0, 1), cA + hstep, voffA);
    if (wr == 1) PG8_BAR;
    PG8_WAIT_V(2); PG8_BAR;
    PG8_STAGE(PG8_SB(1, 0), cB + kstep, voffB); PG8_STAGE(PG8_SA(1, 0), cA + kstep, voffA); PG8_STAGE(PG8_SB(1, 1), cB + hstep + kstep, voffB);
    PG8_WAIT_V(6); PG8_BAR;
    for (;;) {
        const bool has_next = S.next(ui + 1, nxt);
        const char* nA = has_next ? (const char*)g.A + (size_t)nxt.pm * tstep : cA; const char* nB = has_next ? (const char*)g.Bt + (size_t)nxt.pn * tstep : cB;
        for (int t = 0; t < nt; t += 2) {
            const bool last = (t == nt - 2);
            const char* a1 = cA + (size_t)(t + 1) * kstep;
            const char* a2 = last ? nA : cA + (size_t)(t + 2) * kstep; const char* b2 = last ? nB : cB + (size_t)(t + 2) * kstep;
            const char* a3 = a2 + kstep; const char* b3 = b2 + kstep;
            if constexpr (Epi::MIDK > 0) { if (t == Epi::MIDK) E.mid(acc, ui, wr, fr); }
            PG8_LDB(B0, 0, 0); PG8_LDB(B1, 0, 1); PG8_SCHED; PG8_LDA(At, 0, 0); PG8_STAGE(PG8_SA(1, 1), a1 + hstep, voffA);
            PG8_WAIT_V(8); PG8_WAIT_L(0); PG8_BAR; PG8_MMA(0, 0, At, B0); PG8_MMA(0, 1, At, B1); PG8_BAR; PG8_SCHED;
            PG8_LDA(At, 0, 1); PG8_STAGE(PG8_SB(0, 0), b2, voffB); PG8_STAGE(PG8_SB(0, 1), b2 + hstep, voffB); PG8_STAGE(PG8_SA(0, 0), a2, voffA);
            PG8_WAIT_V(8); PG8_WAIT_L(0); PG8_BAR; PG8_MMA(1, 0, At, B0); PG8_MMA(1, 1, At, B1); PG8_BAR; PG8_SCHED;
            PG8_LDB(B0, 1, 0); PG8_LDB(B1, 1, 1); PG8_SCHED; PG8_LDA(At, 1, 0); PG8_STAGE(PG8_SA(0, 1), a2 + hstep, voffA);
            PG8_WAIT_V(8); PG8_WAIT_L(0); PG8_BAR; PG8_MMA(0, 0, At, B0); PG8_MMA(0, 1, At, B1); PG8_BAR; PG8_SCHED;
            PG8_LDA(At, 1, 1); PG8_STAGE(PG8_SB(1, 0), b3, voffB); PG8_STAGE(PG8_SB(1, 1), b3 + hstep, voffB); PG8_STAGE(PG8_SA(1, 0), a3, voffA);
            PG8_WAIT_V(8); PG8_WAIT_L(0); PG8_BAR; PG8_MMA(1, 0, At, B0); PG8_MMA(1, 1, At, B1); PG8_BAR; PG8_SCHED;
        }
        if constexpr (ALIGN_EPI) { if (wr == 0) PG8_BAR; }
        E(acc, cur, ui, wr, wc, fr, fq);
        if (!has_next) break;
#pragma unroll
        for (int a = 0; a < 2; ++a)
#pragma unroll
            for (int b = 0; b < 2; ++b)
#pragma unroll
                for (int m = 0; m < 4; ++m)
#pragma unroll
                    for (int n = 0; n < 2; ++n) acc[a][b][m][n] = (f32x4){0.f, 0.f, 0.f, 0.f};
        cur = nxt; cA = nA; cB = nB; ++ui;
        if constexpr (ALIGN_EPI) { if (wr == 1) PG8_BAR; }
    }
    PG8_WAIT_V(0);
    if constexpr (!ALIGN_EPI) { if (wr == 0) PG8_BAR; }
    PG8_BAR;
#undef PG8_SA
#undef PG8_SB
#undef PG8_STAGE
#undef PG8_LDA
#undef PG8_LDB
#undef PG8_MMA
#undef PG8_WAIT_V
#undef PG8_WAIT_L
#undef PG8_BAR
#undef PG8_SCHED
}
}

struct EpiZ {
    static constexpr bool PERM = true; static constexpr int MIDK = 0;
    bf16_t* Z; const float* cs; const float* sn;
    __device__ __forceinline__ void mid(f32x4 (&acc)[2][2][4][2], int ui, int wr, int fr) const {}
    __device__ __forceinline__ void operator()(const f32x4 (&acc)[2][2][4][2], const pg8::Unit& u, int ui, int wr, int wc, int fr, int fq) const {
        const int row0 = u.pm * 256 + wr * 64 + fr, col0 = u.pn * 256 + wc * 32 + 8 * fq, pn = u.pn;
        const int mode = (pn <= 4) ? 2 : (pn == 5 ? 0 : (pn <= 9 ? 1 : (pn <= 13 ? 0 : 1)));
        const bool rope = (mode == 2) && ((wc & 1) == 0);
        const float sc = (pn <= 3) ? C2 : 1.f;
        const float sgn = (fq == 0) ? -1.f : 1.f;
        if (rope) {
            const bool lo = (fq & 1) == 0;
#pragma unroll
            for (int ai = 0; ai < 2; ++ai) {
                f32x4 cc[4][2], ss_[4][2];
#pragma unroll
                for (int m = 0; m < 4; ++m) { const int pos = (row0 + ai * 128 + m * 16) & (SEQ - 1);
                    if (fq < 2) { cc[m][0] = *(const f32x4*)(cs + pos * 8); cc[m][1] = *(const f32x4*)(cs + pos * 8 + 4); ss_[m][0] = *(const f32x4*)(sn + pos * 8) * sgn; ss_[m][1] = *(const f32x4*)(sn + pos * 8 + 4) * sgn; }
                    else { cc[m][0] = (f32x4){1.f, 1.f, 1.f, 1.f}; cc[m][1] = cc[m][0]; ss_[m][0] = (f32x4){0.f, 0.f, 0.f, 0.f}; ss_[m][1] = ss_[m][0]; } }
#pragma unroll
                for (int m = 0; m < 4; ++m) {
                    bf16_t* rowp = Z + (size_t)(row0 + ai * 128 + m * 16) * NIN + col0;
#pragma unroll
                    for (int bj = 0; bj < 2; ++bj) {
                        f32x4 v0 = acc[ai][bj][m][0], v1 = acc[ai][bj][m][1], p0, p1;
#pragma unroll
                        for (int k = 0; k < 4; ++k) {
                            const auto r0 = __builtin_amdgcn_permlane16_swap(__float_as_uint(v0[k]), __float_as_uint(v0[k]), false, false);
                            const auto r1 = __builtin_amdgcn_permlane16_swap(__float_as_uint(v1[k]), __float_as_uint(v1[k]), false, false);
                            p0[k] = __uint_as_float(lo ? r0[1] : r0[0]); p1[k] = __uint_as_float(lo ? r1[1] : r1[0]); }
                        v0 = (v0 * cc[m][0] + p0 * ss_[m][0]) * sc; v1 = (v1 * cc[m][1] + p1 * ss_[m][1]) * sc;
                        u32x4 w; w.x = cvt_pk_bf16(v0[0], v0[1]); w.y = cvt_pk_bf16(v0[2], v0[3]); w.z = cvt_pk_bf16(v1[0], v1[1]); w.w = cvt_pk_bf16(v1[2], v1[3]);
                        __builtin_nontemporal_store(w, (u32x4*)(rowp + bj * 128));
                    }
                }
            }
            return;
        }
#pragma unroll
        for (int ai = 0; ai < 2; ++ai)
#pragma unroll
            for (int m = 0; m < 4; ++m) {
                bf16_t* rowp = Z + (size_t)(row0 + ai * 128 + m * 16) * NIN + col0;
#pragma unroll
                for (int bj = 0; bj < 2; ++bj) {
                    f32x4 v0 = acc[ai][bj][m][0], v1 = acc[ai][bj][m][1];
                    if (mode == 1) {
#pragma unroll
                        for (int k = 0; k < 4; ++k) {
                            const float da = 1.0f + __builtin_amdgcn_exp2f(fminf(-v0[k] * LOG2E, 60.f)), db = 1.0f + __builtin_amdgcn_exp2f(fminf(-v1[k] * LOG2E, 60.f));
                            const float inv = __builtin_amdgcn_rcpf(da * db); v0[k] = v0[k] * (db * inv); v1[k] = v1[k] * (da * inv); }
                    }
                    v0 = v0 * sc; v1 = v1 * sc;
                    u32x4 w; w.x = cvt_pk_bf16(v0[0], v0[1]); w.y = cvt_pk_bf16(v0[2], v0[3]); w.z = cvt_pk_bf16(v1[0], v1[1]); w.w = cvt_pk_bf16(v1[2], v1[3]);
                    __builtin_nontemporal_store(w, (u32x4*)(rowp + bj * 128));
                }
            }
    }
};

struct EpiOut {
    static constexpr bool PERM = false; static constexpr int MIDK = 16;
    const float* x; float* out; float* pss; LAS const f32x2* RS;
    __device__ __forceinline__ void mid(f32x4 (&acc)[2][2][4][2], int ui, int wr, int fr) const {
#pragma unroll
        for (int ai = 0; ai < 2; ++ai)
#pragma unroll
            for (int m = 0; m < 4; ++m) { const float ratio = RS[(ui & 3) * 256 + ai * 128 + wr * 64 + m * 16 + fr].x;
#pragma unroll
                for (int bj = 0; bj < 2; ++bj)
#pragma unroll
                    for (int n = 0; n < 2; ++n) acc[ai][bj][m][n] = acc[ai][bj][m][n] * ratio; }
    }
    __device__ __forceinline__ void operator()(const f32x4 (&acc)[2][2][4][2], const pg8::Unit& u, int ui, int wr, int wc, int fr, int fq) const {
        const int col0 = u.pn * 256 + wc * 32 + 4 * fq;
#pragma unroll
        for (int ai = 0; ai < 2; ++ai)
#pragma unroll
            for (int m = 0; m < 4; ++m) {
                const int lr = ai * 128 + wr * 64 + m * 16 + fr; const float rB = RS[(ui & 3) * 256 + lr].y;
                const size_t off = (size_t)(u.pm * 256 + lr) * DM + col0; float ss = 0.f;
#pragma unroll
                for (int bj = 0; bj < 2; ++bj)
#pragma unroll
                    for (int n = 0; n < 2; ++n) { const f32x4 xb = *(const f32x4*)(x + off + bj * 128 + n * 16); const f32x4 o = xb + acc[ai][bj][m][n] * rB;
                        ss += (o[0] * o[0] + o[1] * o[1]) + (o[2] * o[2] + o[3] * o[3]); *(f32x4*)(out + off + bj * 128 + n * 16) = o; }
                ss += __shfl_xor(ss, 16); ss += __shfl_xor(ss, 32);
                if (fq == 0) pss[(size_t)(u.pm * 256 + lr) * 16 + u.pn * 4 + wc] = ss;
            }
    }
};

struct EpiOutF {
    static constexpr bool PERM = false; static constexpr int MIDK = 16;
    const float* x; float* out; const float* fg; float* xbuf; unsigned* cnt; LAS const f32x2* RS; LAS float* PP; LAS float* SS;
    __device__ __forceinline__ void mid(f32x4 (&acc)[2][2][4][2], int ui, int wr, int fr) const {
#pragma unroll
        for (int ai = 0; ai < 2; ++ai)
#pragma unroll
            for (int m = 0; m < 4; ++m) { const float ratio = RS[(ui & 3) * 256 + ai * 128 + wr * 64 + m * 16 + fr].x;
#pragma unroll
                for (int bj = 0; bj < 2; ++bj)
#pragma unroll
                    for (int n = 0; n < 2; ++n) acc[ai][bj][m][n] = acc[ai][bj][m][n] * ratio; }
    }
    __device__ __forceinline__ void operator()(f32x4 (&acc)[2][2][4][2], const pg8::Unit& u, int ui, int wr, int wc, int fr, int fq) const {
        const int tid = threadIdx.x, lane = tid & 63, wid = __builtin_amdgcn_readfirstlane(tid >> 6);
        const int col0 = u.pn * 256 + wc * 32 + 4 * fq;
#pragma unroll
        for (int ai = 0; ai < 2; ++ai) {
            f32x4 xb[4][2][2];
#pragma unroll
            for (int m = 0; m < 4; ++m) { const size_t off = (size_t)(u.pm * 256 + ai * 128 + wr * 64 + m * 16 + fr) * DM + col0;
#pragma unroll
                for (int bj = 0; bj < 2; ++bj)
#pragma unroll
                    for (int n = 0; n < 2; ++n) xb[m][bj][n] = *(const f32x4*)(x + off + bj * 128 + n * 16); }
            asm volatile("" ::: "memory");
            float ssv[4];
#pragma unroll
            for (int m = 0; m < 4; ++m) { const int lr = ai * 128 + wr * 64 + m * 16 + fr; const float rB = RS[(ui & 3) * 256 + lr].y; float ss = 0.f;
#pragma unroll
                for (int bj = 0; bj < 2; ++bj)
#pragma unroll
                    for (int n = 0; n < 2; ++n) { const f32x4 o = xb[m][bj][n] + acc[ai][bj][m][n] * rB; ss += (o[0] * o[0] + o[1] * o[1]) + (o[2] * o[2] + o[3] * o[3]); acc[ai][bj][m][n] = o; }
                ssv[m] = ss; }
#pragma unroll
            for (int m = 0; m < 4; ++m) ssv[m] += __shfl_xor(ssv[m], 16);
#pragma unroll
            for (int m = 0; m < 4; ++m) ssv[m] += __shfl_xor(ssv[m], 32);
            if (fq == 0) {
#pragma unroll
                for (int m = 0; m < 4; ++m) PP[(ai * 128 + wr * 64 + m * 16 + fr) * 4 + wc] = ssv[m]; }
        }
        asm volatile("s_waitcnt lgkmcnt(0)" ::: "memory"); __builtin_amdgcn_s_barrier(); asm volatile("" ::: "memory");
        unsigned* pc = cnt + 64 * u.pm;
        if (tid < 256) { const f32x4 pp = *(const LAS f32x4*)(PP + tid * 4); const float tp = (pp[0] + pp[1]) + (pp[2] + pp[3]);
            __hip_atomic_store(xbuf + (size_t)(u.pm * 256 + tid) * 4 + u.pn, tp, __ATOMIC_RELAXED, __HIP_MEMORY_SCOPE_AGENT); }
        asm volatile("s_waitcnt vmcnt(0)" ::: "memory");
        if (tid < 256 && lane == 0) __hip_atomic_fetch_add(pc, 1u, __ATOMIC_RELAXED, __HIP_MEMORY_SCOPE_AGENT);
        if (wid == 0) {
            unsigned sp = 0;
            while ((unsigned)__builtin_amdgcn_readfirstlane(__hip_atomic_load(pc, __ATOMIC_RELAXED, __HIP_MEMORY_SCOPE_AGENT)) < 16u) { if (++sp > (1u << 22)) break; }
            __builtin_amdgcn_fence(__ATOMIC_ACQUIRE, "agent");
        }
        asm volatile("s_waitcnt vmcnt(0) lgkmcnt(0)" ::: "memory"); __builtin_amdgcn_s_barrier(); asm volatile("" ::: "memory");
        if (tid < 256) { const float* slot = xbuf + (size_t)(u.pm * 256 + tid) * 4; float q = 0.f;
#pragma unroll
            for (int t = 0; t < 4; ++t) q += __hip_atomic_load(slot + t, __ATOMIC_RELAXED, __HIP_MEMORY_SCOPE_AGENT);
            SS[tid] = 1.0f / sqrtf(q * (1.f / DM) + EPS); }
        asm volatile("s_waitcnt lgkmcnt(0)" ::: "memory"); __builtin_amdgcn_s_barrier(); asm volatile("" ::: "memory");
        f32x4 gv[2][2];
#pragma unroll
        for (int bj = 0; bj < 2; ++bj)
#pragma unroll
            for (int n = 0; n < 2; ++n) gv[bj][n] = *(const f32x4*)(fg + col0 + bj * 128 + n * 16);
#pragma unroll
        for (int ai = 0; ai < 2; ++ai)
#pragma unroll
            for (int m = 0; m < 4; ++m) {
                const int lr = ai * 128 + wr * 64 + m * 16 + fr; const float rs = SS[lr];
                const size_t off = (size_t)(u.pm * 256 + lr) * DM + col0;
#pragma unroll
                for (int bj = 0; bj < 2; ++bj)
#pragma unroll
                    for (int n = 0; n < 2; ++n) *(f32x4*)(out + off + bj * 128 + n * 16) = acc[ai][bj][m][n] * rs * gv[bj][n];
            }
        asm volatile("s_waitcnt lgkmcnt(0)" ::: "memory"); __builtin_amdgcn_s_barrier(); asm volatile("" ::: "memory");
    }
};

__device__ __forceinline__ float wave_sum(float v) {
#pragma unroll
    for (int o = 1; o < 64; o <<= 1) v += __shfl_xor(v, o);
    return v;
}
__device__ __forceinline__ void p0_transpose_item(const float* W, int K, int N, bf16_t* WT, const float* kscale, LAS float* scr, int item, int lane) {
    const int nblk = N / 32, kb = item / nblk, nb = item % nblk, k0 = 64 * kb, n0 = 32 * nb;
#pragma unroll
    for (int i = 0; i < 8; ++i) { const int kk = i * 8 + (lane >> 3); f32x4 v = __builtin_nontemporal_load((const f32x4*)(W + (size_t)(k0 + kk) * N + n0 + (lane & 7) * 4)); if (kscale) v = v * kscale[k0 + kk];
        *(LAS f32x4*)(scr + kk * 36 + (lane & 7) * 4) = v; }
    asm volatile("s_waitcnt lgkmcnt(0)" ::: "memory");
    const int c = lane & 7;
#pragma unroll
    for (int j = 0; j < 4; ++j) { const int n = (lane >> 3) + 8 * j; const LAS float* s = scr + (8 * c) * 36 + n;
        u32x4 o; o.x = pk2(s[0 * 36], s[1 * 36]); o.y = pk2(s[2 * 36], s[3 * 36]); o.z = pk2(s[4 * 36], s[5 * 36]); o.w = pk2(s[6 * 36], s[7 * 36]);
        *(u32x4*)(WT + (size_t)(n0 + n) * K + k0 + 8 * c) = o; }
    asm volatile("s_waitcnt lgkmcnt(0)" ::: "memory");
}
__device__ __forceinline__ void sincos_d(double xx, double& s, double& c) {
    const double kq = rint(xx * 0.63661977236758134308);
    double r = fma(-kq, 1.57079632679489655800e+00, xx); r = fma(-kq, 6.12323399573676603587e-17, r);
    const int q = ((int)kq) & 3; const double r2 = r * r;
    const double sp = r * (1.0 + r2 * (-1.0 / 6.0 + r2 * (1.0 / 120.0 + r2 * (-1.0 / 5040.0 + r2 * (1.0 / 362880.0 + r2 * (-1.0 / 39916800.0 + r2 * (1.0 / 6227020800.0 + r2 * (-1.0 / 1307674368000.0))))))));
    const double cp = 1.0 + r2 * (-0.5 + r2 * (1.0 / 24.0 + r2 * (-1.0 / 720.0 + r2 * (1.0 / 40320.0 + r2 * (-1.0 / 3628800.0 + r2 * (1.0 / 479001600.0 + r2 * (-1.0 / 87178291200.0 + r2 * (1.0 / 20922789888000.0))))))));
    s = (q == 0) ? sp : (q == 1) ? cp : (q == 2) ? -sp : -cp;
    c = (q == 0) ? cp : (q == 1) ? -sp : (q == 2) ? -cp : sp;
}

namespace att {
constexpr int KV_ROWS = 192, RS = 144;
constexpr int L_K = 0, L_V = KV_ROWS * RS, L_STG = 2 * KV_ROWS * RS, STG_RS = 272, STG_W = 32 * STG_RS, L_LW = L_STG + 8 * STG_W, L_END = L_LW + 8 * 128;
static_assert(L_END <= RING_BYTES, "attention LDS");
__device__ __forceinline__ int crow(int i, int h) { return (i & 3) + 8 * (i >> 2) + 4 * h; }
__device__ __forceinline__ s16x4 vtr(LAS const unsigned char* p) { return __builtin_bit_cast(s16x4, __builtin_amdgcn_ds_read_tr16_b64_v4i16((LAS s16x4*)p)); }

constexpr int NUNITS = NB * 4 * 64;
__device__ __forceinline__ void load_kvq(u32x4 (&kreg)[3], u32x4 (&vreg)[3], bf16x8 (&qr)[4], const bf16_t* __restrict__ z, int u, int tid, int wid, int r, int h) {
    const int b = u >> 8, kvh = (u >> 6) & 3, q0 = (u & 63) * 64; const size_t rowbase = (size_t)b * SEQ;
    const int head = kvh * 4 + (wid >> 1), qs = q0 + 32 * (wid & 1);
#pragma unroll
    for (int i = 0; i < 3; ++i) { const int pidx = tid + 512 * i, row = pidx >> 3, ch = pidx & 7, pos = q0 - 128 + row;
        if (pos >= 0) { const bf16_t* src = z + (rowbase + pos) * NIN + COL_K + kvh * 64 + ch * 8; kreg[i] = *(const u32x4*)src; vreg[i] = *(const u32x4*)(src + 256); }
        else { kreg[i] = (u32x4){0u, 0u, 0u, 0u}; vreg[i] = (u32x4){0u, 0u, 0u, 0u}; } }
#pragma unroll
    for (int d0 = 0; d0 < 4; ++d0) qr[d0] = *(const bf16x8*)(z + (rowbase + qs + r) * NIN + COL_Q + head * 64 + d0 * 16 + h * 8);
}

__device__ __forceinline__ void run(LAS unsigned char* lds, const bf16_t* __restrict__ z, bf16_t* __restrict__ y, float* __restrict__ ssq, const float* __restrict__ sinks, unsigned* ctr, LAS int* ubox) {
    const int tid = threadIdx.x, lane = tid & 63, r = lane & 31, h = lane >> 5, wid = __builtin_amdgcn_readfirstlane(tid >> 6);
    const int G = gridDim.x, nper = (NUNITS + G - 1) / G;
    int u = (int)blockIdx.x * nper; const int uend = (u + nper < NUNITS) ? u + nper : NUNITS;
    if (u >= uend) return;
    float sinkv[4];
#pragma unroll
    for (int kq = 0; kq < 4; ++kq) sinkv[kq] = sinks[kq * 4 + (wid >> 1)] * LOG2E;
    u32x4 kreg[3], vreg[3]; bf16x8 qn[4];
    load_kvq(kreg, vreg, qn, z, u, tid, wid, r, h);
    for (int n = 0;; ++n) {
        const int b = u >> 8, kvh = (u >> 6) & 3, q0 = (u & 63) * 64; const size_t rowbase = (size_t)b * SEQ;
        const int head = kvh * 4 + (wid >> 1), qs = q0 + 32 * (wid & 1);
        bf16x8 qr[4];
#pragma unroll
        for (int d0 = 0; d0 < 4; ++d0) qr[d0] = qn[d0];
#pragma unroll
        for (int i = 0; i < 3; ++i) { const int pidx = tid + 512 * i, row = pidx >> 3, ch = pidx & 7;
            *(LAS u32x4*)(lds + L_K + row * RS + ch * 16) = kreg[i]; *(LAS u32x4*)(lds + L_V + row * RS + ch * 16) = vreg[i]; }
        LDS_BARRIER();
        const int un = u + 1;
        if (un < uend) load_kvq(kreg, vreg, qn, z, un, tid, wid, r, h);
        u32x4 gv[4];
#pragma unroll
        for (int it = 0; it < 4; ++it) gv[it] = *(const u32x4*)(z + (rowbase + qs + it * 8 + (lane >> 3)) * NIN + COL_GA + head * 64 + (lane & 7) * 8);
        f32x16 s[5];
        const LAS unsigned char* kb = lds + L_K + (32 * (wid & 1) + r) * RS + h * 16;
#pragma unroll
        for (int c = 0; c < 5; ++c) { f32x16 a = {0.f, 0.f, 0.f, 0.f, 0.f, 0.f, 0.f, 0.f, 0.f, 0.f, 0.f, 0.f, 0.f, 0.f, 0.f, 0.f};
#pragma unroll
            for (int d0 = 0; d0 < 4; ++d0) { const bf16x8 kf = *(const LAS bf16x8*)(kb + c * 32 * RS + d0 * 32); a = __builtin_amdgcn_mfma_f32_32x32x16_bf16(kf, qr[d0], a, 0, 0, 0); }
            s[c] = a; }
        const float sink2 = (kvh == 0) ? sinkv[0] : (kvh == 1) ? sinkv[1] : (kvh == 2) ? sinkv[2] : sinkv[3];
        float mx = -1e30f;
        if (q0 < 128) {
#pragma unroll
            for (int c = 0; c < 5; ++c)
#pragma unroll
                for (int i = 0; i < 16; ++i) { const int cr = crow(i, h), diff = 128 - 32 * c + r - cr, kp = qs - 128 + 32 * c + cr;
                    const bool valid = (diff >= 0) && (diff < 128) && (kp >= 0); const float v = valid ? s[c][i] : -1e30f; s[c][i] = v; mx = fmaxf(mx, v); }
        } else {
#pragma unroll
            for (int i = 0; i < 16; ++i) { const int cr = crow(i, h); const float v0 = (cr > r) ? s[0][i] : -1e30f, v4 = (cr <= r) ? s[4][i] : -1e30f; s[0][i] = v0; s[4][i] = v4; mx = fmaxf(mx, fmaxf(v0, v4)); }
#pragma unroll
            for (int c = 1; c < 4; ++c)
#pragma unroll
                for (int i = 0; i < 16; ++i) mx = fmaxf(mx, s[c][i]);
        }
        mx = fmaxf(mx, __shfl_xor(mx, 32));
        const float mref = fmaxf(mx, sink2);
        float lsum = 0.f;
#pragma unroll
        for (int c = 0; c < 5; ++c)
#pragma unroll
            for (int i = 0; i < 16; ++i) { const float pv = __builtin_amdgcn_exp2f(s[c][i] - mref); s[c][i] = pv; lsum += pv; }
        lsum += __shfl_xor(lsum, 32);
        const float l = lsum + __builtin_amdgcn_exp2f(sink2 - mref);
        f32x16 o[2];
        o[0] = (f32x16){0.f, 0.f, 0.f, 0.f, 0.f, 0.f, 0.f, 0.f, 0.f, 0.f, 0.f, 0.f, 0.f, 0.f, 0.f, 0.f}; o[1] = o[0];
        const LAS unsigned char* vb = lds + L_V + (32 * (wid & 1) + 4 * h + ((lane & 15) >> 2)) * RS + ((lane >> 4) & 1) * 32 + (lane & 3) * 8;
#pragma unroll
        for (int c = 0; c < 5; ++c)
#pragma unroll
            for (int s2 = 0; s2 < 2; ++s2) {
                u32x4 pw; pw.x = cvt_pk_bf16(s[c][8 * s2 + 0], s[c][8 * s2 + 1]); pw.y = cvt_pk_bf16(s[c][8 * s2 + 2], s[c][8 * s2 + 3]); pw.z = cvt_pk_bf16(s[c][8 * s2 + 4], s[c][8 * s2 + 5]); pw.w = cvt_pk_bf16(s[c][8 * s2 + 6], s[c][8 * s2 + 7]);
                const bf16x8 pa = __builtin_bit_cast(bf16x8, pw);
#pragma unroll
                for (int dh = 0; dh < 2; ++dh) { const LAS unsigned char* ap = vb + (32 * c + 16 * s2) * RS + dh * 64;
                    const s16x4 lo = vtr(ap), hi = vtr(ap + 8 * RS);
                    const bf16x8 vf = __builtin_shufflevector(lo, hi, 0, 1, 2, 3, 4, 5, 6, 7);
                    o[dh] = __builtin_amdgcn_mfma_f32_32x32x16_bf16(pa, vf, o[dh], 0, 0, 0); }
            }
        LAS float* lw = (LAS float*)(lds + L_LW + wid * 128);
        if (h == 0) lw[r] = __builtin_amdgcn_rcpf(l);
        LAS unsigned char* stg = lds + L_STG + wid * STG_W;
#pragma unroll
        for (int i = 0; i < 16; ++i) { const int cr = crow(i, h); const float rl = lw[cr];
            *(LAS float*)(stg + cr * STG_RS + r * 4) = o[0][i] * rl; *(LAS float*)(stg + cr * STG_RS + (32 + r) * 4) = o[1][i] * rl; }
#pragma unroll
        for (int it = 0; it < 4; ++it) { const int row = it * 8 + (lane >> 3), ch = lane & 7;
            const f32x4 a0 = *(const LAS f32x4*)(stg + row * STG_RS + ch * 32), a1 = *(const LAS f32x4*)(stg + row * STG_RS + ch * 32 + 16);
            const size_t grow = rowbase + qs + row;
            const u32x4 g = gv[it];
            const float g0 = bf_lo(g.x), g1 = bf_hi(g.x), g2 = bf_lo(g.y), g3 = bf_hi(g.y), g4 = bf_lo(g.z), g5 = bf_hi(g.z), g6 = bf_lo(g.w), g7 = bf_hi(g.w);
            const float y0 = a0[0] * g0, y1 = a0[1] * g1, y2 = a0[2] * g2, y3 = a0[3] * g3;
            const float y4 = a1[0] * g4, y5 = a1[1] * g5, y6 = a1[2] * g6, y7 = a1[3] * g7;
            float ss = (y0 * y0 + y1 * y1) + (y2 * y2 + y3 * y3) + (y4 * y4 + y5 * y5) + (y6 * y6 + y7 * y7);
            ss += __shfl_xor(ss, 1); ss += __shfl_xor(ss, 2); ss += __shfl_xor(ss, 4);
            u32x4 w; w.x = cvt_pk_bf16(y0, y1); w.y = cvt_pk_bf16(y2, y3); w.z = cvt_pk_bf16(y4, y5); w.w = cvt_pk_bf16(y6, y7);
            *(u32x4*)(y + grow * KOUT + head * 64 + ch * 8) = w;
            if (ch == 0) ssq[grow * 16 + head] = ss; }
        LDS_BARRIER();
        u = un;
        if (u >= uend) break;
    }
}
}

namespace lru {
constexpr int L_CW = 0, L_WT = 2048, L_STG = L_WT + 8192, STG_RS = 272, STG_W = 16 * STG_RS, L_END = L_STG + 8 * STG_W;
static_assert(L_END <= RING_BYTES, "lru LDS");
constexpr int NCH = SEQ / 128;

template <bool FIRST> __device__ __forceinline__ void load_x(u32x4 (&xv)[4][2], const bf16_t* __restrict__ z, size_t rowbase, int tok, int cbase) {
#pragma unroll
    for (int tap = 0; tap < 4; ++tap) { const int pos = tok - 3 + tap, posc = (FIRST && pos < 0) ? 0 : pos;
#pragma unroll
        for (int ks = 0; ks < 2; ++ks) xv[tap][ks] = *(const u32x4*)(z + (rowbase + posc) * NIN + cbase + 32 * ks); }
    if (FIRST) {
#pragma unroll
        for (int tap = 0; tap < 3; ++tap) if (tok - 3 + tap < 0) { xv[tap][0] = (u32x4){0u, 0u, 0u, 0u}; xv[tap][1] = (u32x4){0u, 0u, 0u, 0u}; }
    }
}

template <bool PAIRED>
__device__ __forceinline__ void unit(LAS unsigned char* lds, const bf16_t* __restrict__ z, bf16_t* __restrict__ y, float* __restrict__ ssq,
                                     const float* __restrict__ conv_w, const float* __restrict__ conv_b, const float* __restrict__ w_r, const float* __restrict__ b_r,
                                     const float* __restrict__ w_i, const float* __restrict__ b_i, const float* __restrict__ lam, int b, int blk,
                                     int half, unsigned* myseq, unsigned* pseq, float* mydata, float* pdata) {
    constexpr int STEP = PAIRED ? 2 : 1, NIT = NCH / STEP;
    const int tid = threadIdx.x, lane = tid & 63, fr = lane & 15, fq = lane >> 4, wid = __builtin_amdgcn_readfirstlane(tid >> 6);
    const size_t rowbase = (size_t)b * SEQ;
    LAS float* cw = (LAS float*)(lds + L_CW);
    if (tid < 320) { const int tap = tid >> 6, c = tid & 63; cw[tid] = (tap < 4) ? conv_w[tap * 1024 + blk * 64 + c] : conv_b[blk * 64 + c]; }
    bf16x8 bfr[2][4], bfi[2][4];
#pragma unroll
    for (int ks = 0; ks < 2; ++ks)
#pragma unroll
        for (int nt = 0; nt < 4; ++nt) {
            u32x4 wr_, wi_; unsigned* pr = (unsigned*)&wr_; unsigned* pi = (unsigned*)&wi_;
#pragma unroll
            for (int j = 0; j < 8; j += 2) { const size_t o0 = ((size_t)blk * 64 + 8 * fq + j + 32 * ks) * 64 + fr + 16 * nt;
                pr[j >> 1] = pk2(w_r[o0], w_r[o0 + 64]); pi[j >> 1] = pk2(w_i[o0], w_i[o0 + 64]); }
            bfr[ks][nt] = __builtin_bit_cast(bf16x8, wr_); bfi[ks][nt] = __builtin_bit_cast(bf16x8, wi_);
        }
    float nbr[4], nbi[4], sp[4], carry[4], Aown[4], Hown[4];
#pragma unroll
    for (int nt = 0; nt < 4; ++nt) { const int c = blk * 64 + fr + 16 * nt; nbr[nt] = -b_r[c] * LOG2E; nbi[nt] = -b_i[c] * LOG2E; sp[nt] = -8.0f * log1pf(expf(-lam[c])) * LOG2E; carry[nt] = 0.f; Aown[nt] = 1.f; Hown[nt] = 0.f; }
    __syncthreads();
    const int cbaseA = COL_XL + blk * 64 + 8 * fq;
    LAS unsigned char* stg = lds + L_STG + wid * STG_W;
    u32x4 xn[4][2], gn[2];
    if (wid == 0 && half == 0) load_x<true>(xn, z, rowbase, fr, cbaseA); else load_x<false>(xn, z, rowbase, 128 * half + 16 * wid + fr, cbaseA);
    const bf16_t* gbase = z + (rowbase + 128 * half + 16 * wid + (lane >> 3)) * NIN + COL_GL + blk * 64 + (lane & 7) * 8;
    gn[0] = *(const u32x4*)gbase; gn[1] = *(const u32x4*)(gbase + (size_t)8 * NIN);
    for (int kk = 0; kk < NIT; ++kk) {
        asm volatile("" ::: "memory");
        const int k = half + STEP * kk;
        const int tw = 128 * k + 16 * wid;
        bf16x8 uA[2];
#pragma unroll
        for (int ks = 0; ks < 2; ++ks) {
            float u[8];
            { const f32x4 b0 = *(const LAS f32x4*)(cw + 4 * 64 + 32 * ks + 8 * fq), b1 = *(const LAS f32x4*)(cw + 4 * 64 + 32 * ks + 8 * fq + 4);
              u[0] = b0[0]; u[1] = b0[1]; u[2] = b0[2]; u[3] = b0[3]; u[4] = b1[0]; u[5] = b1[1]; u[6] = b1[2]; u[7] = b1[3]; }
#pragma unroll
            for (int tap = 0; tap < 4; ++tap) { const f32x4 w0 = *(const LAS f32x4*)(cw + tap * 64 + 32 * ks + 8 * fq), w1 = *(const LAS f32x4*)(cw + tap * 64 + 32 * ks + 8 * fq + 4); const u32x4 xx = xn[tap][ks];
                u[0] += w0[0] * bf_lo(xx.x); u[1] += w0[1] * bf_hi(xx.x); u[2] += w0[2] * bf_lo(xx.y); u[3] += w0[3] * bf_hi(xx.y);
                u[4] += w1[0] * bf_lo(xx.z); u[5] += w1[1] * bf_hi(xx.z); u[6] += w1[2] * bf_lo(xx.w); u[7] += w1[3] * bf_hi(xx.w); }
            u32x4 pw; pw.x = cvt_pk_bf16(u[0], u[1]); pw.y = cvt_pk_bf16(u[2], u[3]); pw.z = cvt_pk_bf16(u[4], u[5]); pw.w = cvt_pk_bf16(u[6], u[7]);
            uA[ks] = __builtin_bit_cast(bf16x8, pw);
            *(LAS f32x4*)(stg + fr * STG_RS + (32 * ks + 8 * fq) * 4) = (f32x4){u[0], u[1], u[2], u[3]};
            *(LAS f32x4*)(stg + fr * STG_RS + (32 * ks + 8 * fq) * 4 + 16) = (f32x4){u[4], u[5], u[6], u[7]};
        }
        const u32x4 gc0 = gn[0], gc1 = gn[1];
        if (kk + 1 < NIT) { load_x<false>(xn, z, rowbase, tw + 128 * STEP + fr, cbaseA); const bf16_t* gp = gbase + (size_t)(128 * STEP * (kk + 1)) * NIN; gn[0] = *(const u32x4*)gp; gn[1] = *(const u32x4*)(gp + (size_t)8 * NIN); }
        float Al[4][4], Hl[4][4], At_[4], Ht_[4];
#pragma unroll
        for (int nt = 0; nt < 4; ++nt) {
            f32x4 R = {0.f, 0.f, 0.f, 0.f}, I = R;
            R = __builtin_amdgcn_mfma_f32_16x16x32_bf16(uA[0], bfr[0][nt], R, 0, 0, 0); R = __builtin_amdgcn_mfma_f32_16x16x32_bf16(uA[1], bfr[1][nt], R, 0, 0, 0);
            I = __builtin_amdgcn_mfma_f32_16x16x32_bf16(uA[0], bfi[0][nt], I, 0, 0, 0); I = __builtin_amdgcn_mfma_f32_16x16x32_bf16(uA[1], bfi[1][nt], I, 0, 0, 0);
            float A = 1.f, H = 0.f;
#pragma unroll
            for (int ip = 0; ip < 2; ++ip) {
                const f32x2 uc = {*(const LAS float*)(stg + (4 * fq + 2 * ip) * STG_RS + (fr + 16 * nt) * 4), *(const LAS float*)(stg + (4 * fq + 2 * ip + 1) * STG_RS + (fr + 16 * nt) * 4)};
                const f32x2 R2 = {R[2 * ip], R[2 * ip + 1]}, I2 = {I[2 * ip], I[2 * ip + 1]};
                const f32x2 t1 = R2 * (-LOG2E) + nbr[nt], t2 = I2 * (-LOG2E) + nbi[nt];
                f32x2 d1 = {__builtin_amdgcn_exp2f(t1.x), __builtin_amdgcn_exp2f(t1.y)}, d2 = {__builtin_amdgcn_exp2f(t2.x), __builtin_amdgcn_exp2f(t2.y)};
                d1 = d1 + 1.0f; d2 = d2 + 1.0f;
                const f32x2 dd = d1 * d2; const f32x2 inv = {__builtin_amdgcn_rcpf(dd.x), __builtin_amdgcn_rcpf(dd.y)};
                const f32x2 rg = d2 * inv, ig = d1 * inv, la = rg * sp[nt];
                const f32x2 a = {__builtin_amdgcn_exp2f(la.x), __builtin_amdgcn_exp2f(la.y)};
                const f32x2 om = 1.0f - a * a; const f32x2 sq = {__builtin_amdgcn_sqrtf(om.x), __builtin_amdgcn_sqrtf(om.y)};
                const f32x2 bb = sq * (ig * uc);
                H = a.x * H + bb.x; A = A * a.x; Al[nt][2 * ip] = A; Hl[nt][2 * ip] = H;
                H = a.y * H + bb.y; A = A * a.y; Al[nt][2 * ip + 1] = A; Hl[nt][2 * ip + 1] = H;
            }
            float pA = __shfl_up(A, 16), pH = __shfl_up(H, 16);
            if (fq >= 1) { H = A * pH + H; A = A * pA; }
            pA = __shfl_up(A, 32); pH = __shfl_up(H, 32);
            if (fq >= 2) { H = A * pH + H; A = A * pA; }
            At_[nt] = A; Ht_[nt] = H;
            if (fq == 3) *(LAS f32x2*)(lds + L_WT + (((kk & 1) * 8 + wid) * 64 + nt * 16 + fr) * 8) = (f32x2){A, H};
        }
        LDS_BARRIER();
        float Ap[4], Hp[4];
        if constexpr (PAIRED) {
            if (wid == 0 && k + 1 < NCH) {
                unsigned long long* slotp = (unsigned long long*)mydata + (kk & 3) * 64 + fr; const unsigned tag = 0x11u + (unsigned)kk;
#pragma unroll
                for (int nt = 0; nt < 4; ++nt) {
                    float Ar = 1.f, Hr = 0.f;
#pragma unroll
                    for (int w = 0; w < 8; ++w) { const f32x2 t = *(const LAS f32x2*)(lds + L_WT + (((kk & 1) * 8 + w) * 64 + nt * 16 + fr) * 8); Hr = t.x * Hr + t.y; Ar = Ar * t.x; }
                    if (fq == 0) __hip_atomic_store(slotp + nt * 16, ((unsigned long long)__float_as_uint(Hr) << 32) | (unsigned long long)((__float_as_uint(Ar) & 0xffffff00u) | tag), __ATOMIC_RELAXED, __HIP_MEMORY_SCOPE_AGENT);
                }
            }
            if (k > 0) {
                const unsigned need = half ? (unsigned)(kk + 1) : (unsigned)kk, tag = 0x10u + need; unsigned spn = 0;
                const unsigned long long* pd = (const unsigned long long*)pdata + ((need - 1u) & 3u) * 64 + fr;
                for (;;) {
                    unsigned long long v[4]; bool ok = true;
#pragma unroll
                    for (int nt = 0; nt < 4; ++nt) { v[nt] = __hip_atomic_load(pd + nt * 16, __ATOMIC_RELAXED, __HIP_MEMORY_SCOPE_AGENT); ok = ok && (((unsigned)v[nt] & 0xffu) == tag); }
#pragma unroll
                    for (int nt = 0; nt < 4; ++nt) { Ap[nt] = __uint_as_float((unsigned)v[nt] & 0xffffff00u); Hp[nt] = __uint_as_float((unsigned)(v[nt] >> 32)); }
                    if (__all(ok) || ++spn > (1u << 20)) break;
                }
            } else {
#pragma unroll
                for (int nt = 0; nt < 4; ++nt) { Ap[nt] = 0.f; Hp[nt] = 0.f; }
            }
        }
#pragma unroll
        for (int nt = 0; nt < 4; ++nt) {
            float Ar = 1.f, Hr = 0.f, Ain = 1.f, Hin = 0.f;
#pragma unroll
            for (int w = 0; w < 8; ++w) { const f32x2 t = *(const LAS f32x2*)(lds + L_WT + (((kk & 1) * 8 + w) * 64 + nt * 16 + fr) * 8); if (w == wid) { Ain = Ar; Hin = Hr; } Hr = t.x * Hr + t.y; Ar = Ar * t.x; }
            float cc;
            if constexpr (PAIRED) { cc = Ap[nt] * (Aown[nt] * carry[nt] + Hown[nt]) + Hp[nt]; carry[nt] = cc; Aown[nt] = Ar; Hown[nt] = Hr; }
            else { cc = carry[nt]; carry[nt] = Ar * cc + Hr; }
            const float cin = Ain * cc + Hin;
            float eA = __shfl_up(At_[nt], 16), eH = __shfl_up(Ht_[nt], 16);
            if (fq == 0) { eA = 1.f; eH = 0.f; }
            const float hin = eA * cin + eH;
#pragma unroll
            for (int i = 0; i < 4; ++i) *(LAS float*)(stg + (4 * fq + i) * STG_RS + (fr + 16 * nt) * 4) = Hl[nt][i] + Al[nt][i] * hin;
        }
#pragma unroll
        for (int it = 0; it < 2; ++it) { const int row = it * 8 + (lane >> 3), ch = lane & 7;
            const f32x4 a0 = *(const LAS f32x4*)(stg + row * STG_RS + ch * 32), a1 = *(const LAS f32x4*)(stg + row * STG_RS + ch * 32 + 16);
            const size_t grow = rowbase + tw + row;
            const u32x4 g = it ? gc1 : gc0;
            const float y0 = a0[0] * bf_lo(g.x), y1 = a0[1] * bf_hi(g.x), y2 = a0[2] * bf_lo(g.y), y3 = a0[3] * bf_hi(g.y);
            const float y4 = a1[0] * bf_lo(g.z), y5 = a1[1] * bf_hi(g.z), y6 = a1[2] * bf_lo(g.w), y7 = a1[3] * bf_hi(g.w);
            float ss = (y0 * y0 + y1 * y1) + (y2 * y2 + y3 * y3) + (y4 * y4 + y5 * y5) + (y6 * y6 + y7 * y7);
            ss += __shfl_xor(ss, 1); ss += __shfl_xor(ss, 2); ss += __shfl_xor(ss, 4);
            u32x4 w; w.x = cvt_pk_bf16(y0, y1); w.y = cvt_pk_bf16(y2, y3); w.z = cvt_pk_bf16(y4, y5); w.w = cvt_pk_bf16(y6, y7);
            *(u32x4*)(y + grow * KOUT + 1024 + blk * 64 + ch * 8) = w;
            if (ch == 0) ssq[grow * 16 + blk] = ss; }
    }
    __syncthreads();
}
}

#define XB_TMO      128
#define XB_XCNT(j)  (256  + 64 * (j))
#define XB_XSUB(j)  (1280 + 64 * (j))
#define XB_XGEN(j)  (2304 + 64 * (j))
#define XB_TOP      3328
#define XB_TOPGEN   3392
#define XCD_BAR_WORDS 3456
#define XB_SPIN_CAP (1u << 18)
__device__ __forceinline__ unsigned xb_ld(unsigned* p)              { return __hip_atomic_load(p, __ATOMIC_RELAXED, __HIP_MEMORY_SCOPE_AGENT); }
__device__ __forceinline__ unsigned xb_add(unsigned* p, unsigned v) { return __hip_atomic_fetch_add(p, v, __ATOMIC_RELAXED, __HIP_MEMORY_SCOPE_AGENT); }
__device__ __forceinline__ unsigned xb_xcc_id() { return (unsigned)__builtin_amdgcn_s_getreg((3 << 11) | 20) & 0xFu; }
#define XB_SPIN(cond, bar) do { unsigned _sp = 0; while (cond) { __builtin_amdgcn_s_sleep(1); \
    if ((++_sp & 255u) == 0u) { if (xb_ld(&(bar)[XB_TMO])) break; if (_sp > XB_SPIN_CAP) { atomicAdd(&(bar)[XB_TMO], 1u); break; } } } } while (0)
struct XcdBarrier { unsigned* bar; unsigned x; volatile LAS unsigned* st; };
__device__ __forceinline__ XcdBarrier xcd_barrier_post(unsigned* bar, volatile LAS unsigned* st) {
    XcdBarrier b; b.bar = bar; b.x = xb_xcc_id(); b.st = st;
    if (threadIdx.x == 0) (void)xb_add(&bar[XB_XCNT(b.x)], 1u);
    return b;
}
__device__ __forceinline__ void xcd_barrier_complete(unsigned* bar, unsigned x, unsigned& nloc, unsigned& nx) {
    const unsigned G = gridDim.x * gridDim.y * gridDim.z;
    unsigned sum, cnt, mine, sp = 0u;
    for (;;) {
        sum = 0u; cnt = 0u; mine = 0u;
#pragma unroll
        for (unsigned j = 0; j < 16; ++j) { const unsigned c = xb_ld(&bar[XB_XCNT(j)]); sum += c; cnt += (c > 0u) ? 1u : 0u; mine = (j == x) ? c : mine; }
        if (sum == G) break;
        __builtin_amdgcn_s_sleep(1);
        if ((++sp & 255u) == 0u) { if (xb_ld(&bar[XB_TMO])) break; if (sp > XB_SPIN_CAP) { atomicAdd(&bar[XB_TMO], 1u); break; } }
    }
    nloc = mine > 0u ? mine : 1u; nx = cnt > 0u ? cnt : 1u;
}
__device__ __forceinline__ void xcd_barrier(const XcdBarrier& b) {
    asm volatile("s_waitcnt vmcnt(0)" ::: "memory");
    __syncthreads();
    if (threadIdx.x == 0) {
        unsigned* bar = b.bar;
        __builtin_amdgcn_s_waitcnt(0);
        unsigned nloc = b.st[0], nx = b.st[1];
        if (nloc == 0u) { xcd_barrier_complete(bar, b.x, nloc, nx); b.st[0] = nloc; b.st[1] = nx; }
        const unsigned old = xb_add(&bar[XB_XSUB(b.x)], 1u);
        const unsigned gen = old / nloc;
        if (old + 1u == (gen + 1u) * nloc) {
            __builtin_amdgcn_fence(__ATOMIC_RELEASE, "agent");
            asm volatile("s_waitcnt vmcnt(0)" ::: "memory");
            const unsigned og = xb_add(&bar[XB_TOP], 1u);
            const unsigned tg = og / nx;
            if (og + 1u == (tg + 1u) * nx) xb_add(&bar[XB_TOPGEN], 1u);
            else XB_SPIN(xb_ld(&bar[XB_TOPGEN]) == tg, bar);
            __builtin_amdgcn_fence(__ATOMIC_ACQUIRE, "agent");
            xb_add(&bar[XB_XGEN(b.x)], 1u);
            asm volatile("s_waitcnt vmcnt(0)" ::: "memory");
        } else {
            XB_SPIN(xb_ld(&bar[XB_XGEN(b.x)]) == gen, bar);
            __builtin_amdgcn_fence(__ATOMIC_ACQUIRE, "agent");
            asm volatile("s_waitcnt vmcnt(0)" ::: "memory");
        }
    }
    __syncthreads();
}

struct Params {
    const float* x; const float* ln_gain; const float* w_in; const float* sinks; const float* conv_w; const float* conv_b;
    const float* w_r; const float* b_r; const float* w_i; const float* b_i; const float* lam; const float* ga; const float* gl; const float* w_out; const float* fg;
    float* out; unsigned char* ws; int ph_lo, ph_hi;
};

__global__ void __launch_bounds__(512, 2) mega(Params p) {
    extern __shared__ __attribute__((aligned(16))) unsigned char lds_raw[];
    LAS unsigned char* lds = (LAS unsigned char*)lds_raw;
    const int tid = threadIdx.x, lane = tid & 63, wave = __builtin_amdgcn_readfirstlane(tid >> 6);
    const int G = gridDim.x, bx = blockIdx.x;
    unsigned char* ws = p.ws;
    unsigned* ctl = (unsigned*)(ws + WS_CTL);
    bf16_t* WinT = (bf16_t*)(ws + WS_WIN); bf16_t* WoutT = (bf16_t*)(ws + WS_WOUT);
    float* cs = (float*)(ws + WS_CS); float* sn = (float*)(ws + WS_SN);
    float* ssqa = (float*)(ws + WS_SSQA); float* ssql = (float*)(ws + WS_SSQL); float* pss = (float*)(ws + WS_PSS);
    bf16_t* XN = (bf16_t*)(ws + WS_XN); bf16_t* Y = (bf16_t*)(ws + WS_Y); bf16_t* Z = (bf16_t*)(ws + WS_Z);
    const int lo = p.ph_lo, hi = p.ph_hi;
#define IN(k) (lo <= (k) && (k) < hi)
    if (tid < 32) ((LAS unsigned*)(lds + MISC_OFF))[tid] = 0u;
    __syncthreads();
    XcdBarrier bar; bar.bar = ctl + CW_BAR; bar.x = 0; bar.st = nullptr;
    if (hi - lo > 1) bar = xcd_barrier_post(ctl + CW_BAR, (volatile LAS unsigned*)(lds + MISC_OFF) + 8);
    if (hi > 1000) cg::this_grid().sync();
    const unsigned long long t_start = (PROBE_SEAM >= 0) ? __builtin_amdgcn_s_memrealtime() : 0ull;
#define SEAM(k) do { if (IN(k) && IN((k) + 1)) { if (PROBE_SEAM == (k)) { while (__builtin_amdgcn_s_memrealtime() - t_start < (unsigned long long)(PROBE_X_US) * 100ull) __builtin_amdgcn_s_sleep(8); } \
    for (int rs_ = 0; rs_ < REP_SYNC; ++rs_) xcd_barrier(bar); } } while (0)

    if (IN(0)) for (int rep = 0; rep < REP_P0; ++rep) {
        LAS float* scr = (LAS float*)(lds + wave * 16384);
        const int gw = bx * 8 + wave, NGW = G * 8;
        constexpr int I_IN = (DM / 64) * (NIN / 32), I_OUT = (KOUT / 64) * (DM / 32);
        for (int it = gw; it < I_IN + I_OUT; it += NGW) {
            if (it < I_IN) p0_transpose_item(p.w_in, DM, NIN, WinT, nullptr, scr, it, lane);
            else { const int r = it - I_IN; const int kb = r / (DM / 32); p0_transpose_item(p.w_out, KOUT, DM, WoutT, (kb < 16) ? p.ga : (p.gl - 1024), scr, r, lane); }
        }
        for (int e = bx * 512 + tid; e < SEQ * 8; e += G * 512) {
            const int pos = e >> 3, i = e & 7;
            const double invf = (i == 0) ? 1.0 : (i == 1) ? 0.19392274474868576 : (i == 2) ? 0.03760603093086393 : (i == 3) ? 0.007292664737217109 : (i == 4) ? 0.001414213562373095
                              : (i == 5) ? 0.0002742481756762073 : (i == 6) ? 5.318295896944988e-05 : 1.031338537721246e-05;
            double s, c; sincos_d((double)pos * invf, s, c); cs[e] = (float)c; sn[e] = (float)s;
        }
        {
            const f32x4* gr = (const f32x4*)p.ln_gain + lane;
            f32x4 gq[4];
#pragma unroll
            for (int j = 0; j < 4; ++j) gq[j] = gr[64 * j];
            for (int m0 = gw * 4; m0 < M_TOK; m0 += NGW * 4) {
                f32x4 v[4][4]; float s2[4];
#pragma unroll
                for (int rr = 0; rr < 4; ++rr) { const f32x4* xr = (const f32x4*)(p.x + (size_t)(m0 + rr) * DM) + lane;
#pragma unroll
                    for (int j = 0; j < 4; ++j) v[rr][j] = __builtin_nontemporal_load(xr + 64 * j); }
#pragma unroll
                for (int rr = 0; rr < 4; ++rr) { float t = 0.f;
#pragma unroll
                    for (int j = 0; j < 4; ++j) t += (v[rr][j].x * v[rr][j].x + v[rr][j].y * v[rr][j].y) + (v[rr][j].z * v[rr][j].z + v[rr][j].w * v[rr][j].w);
                    s2[rr] = t; }
#pragma unroll
                for (int o = 1; o < 64; o <<= 1) {
#pragma unroll
                    for (int rr = 0; rr < 4; ++rr) s2[rr] += __shfl_xor(s2[rr], o); }
#pragma unroll
                for (int rr = 0; rr < 4; ++rr) { const float rstd = 1.0f / sqrtf(s2[rr] * (1.f / DM) + EPS);
                    u32x2* o8 = (u32x2*)(XN + (size_t)(m0 + rr) * DM) + lane;
#pragma unroll
                    for (int j = 0; j < 4; ++j) { const f32x4 g = gq[j]; u32x2 w; w.x = cvt_pk_bf16(v[rr][j].x * rstd * g.x, v[rr][j].y * rstd * g.y); w.y = cvt_pk_bf16(v[rr][j].z * rstd * g.z, v[rr][j].w * rstd * g.w); o8[64 * j] = w; } }
            }
        }
    }
    SEAM(0);

    if (IN(1)) {
        pg8::Gemm g{XN, WinT, M_TOK, NIN, DM}; pg8::StaticOrder S; S.init(M_TOK, NIN, G, bx, REP_P1, P1_WGM);
        EpiZ E{Z, cs, sn};
        pg8::gemm_phase<EpiZ, pg8::StaticOrder, true>(lds, g, S, E);
    }
    SEAM(1);

    if (IN(2)) {
        {
            const int uu = bx & 127, half = (bx >> 7) & 1;
            unsigned* sq = ctl + CW_LRU + uu * 128; float* mb = (float*)(ws + WS_MB) + uu * 1024;
            lru::unit<true>(lds, Z, Y, ssql, p.conv_w, p.conv_b, p.w_r, p.b_r, p.w_i, p.b_i, p.lam, uu >> 4, uu & 15, half, sq + 64 * half, sq + 64 * (half ^ 1), mb + 512 * half, mb + 512 * (half ^ 1));
        }
        LAS int* ubox = (LAS int*)(lds + MISC_OFF);
        for (int rep = 0; rep < REP_P2A; ++rep) { att::run(lds, Z, Y, ssqa, p.sinks, ctl + 64 + 64 * rep, ubox); __syncthreads(); }
    }
    SEAM(2);

    if (IN(3)) {
        pg8::Gemm g{Y, WoutT, M_TOK, DM, KOUT}; pg8::StaticOrder S; S.init(M_TOK, DM, G, bx, REP_P3);
        LAS f32x2* RS = (LAS f32x2*)(lds + RS_OFF);
        pg8::Unit u;
        for (int i = 0; i < 4 && S.next(i, u); ++i) {
            if (tid < 256) { const size_t row = (size_t)u.pm * 256 + tid; const f32x4* pa = (const f32x4*)(ssqa + row * 16); const f32x4* pl = (const f32x4*)(ssql + row * 16);
                float sa = 0.f, sl = 0.f;
#pragma unroll
                for (int j = 0; j < 4; ++j) { const f32x4 a = pa[j], l = pl[j]; sa += (a.x + a.y) + (a.z + a.w); sl += (l.x + l.y) + (l.z + l.w); }
                const float rA = 1.0f / sqrtf(sa * (1.f / 1024.f) + EPS), rB = 1.0f / sqrtf(sl * (1.f / 1024.f) + EPS);
                RS[i * 256 + tid] = (f32x2){rA / rB, rB}; }
        }
        __syncthreads();
        EpiOutF E{p.x, p.out, p.fg, pss, ctl + CW_PANEL, RS, (LAS float*)(lds + RS_OFF + 8192), (LAS float*)(lds + RS_OFF + 8192 + 4096)};
        pg8::gemm_phase<EpiOutF, pg8::StaticOrder, true>(lds, g, S, E);
    }
    SEAM(3);

    if (IN(4)) {
        const int gw = bx * 8 + wave, NGW = G * 8;
        const f32x4* fgr = (const f32x4*)p.fg + lane;
        for (int rep = 0; rep < REP_P4; ++rep)
        for (int m = gw; m < M_TOK; m += NGW) {
            float s2 = (lane < 16) ? pss[(size_t)m * 16 + lane] : 0.f;
            s2 += __shfl_xor(s2, 1); s2 += __shfl_xor(s2, 2); s2 += __shfl_xor(s2, 4); s2 += __shfl_xor(s2, 8);
            s2 = __shfl(s2, 0);
            float rstd = 1.0f / sqrtf(s2 * (1.f / DM) + EPS);
            if (rep > 0) rstd = 1.0f;
            f32x4* orow = (f32x4*)(p.out + (size_t)m * DM) + lane;
#pragma unroll
            for (int j = 0; j < 4; ++j) { const f32x4 t = orow[64 * j]; f32x4 g = fgr[64 * j]; if (rep > 0) g = (f32x4){1.f, 1.f, 1.f, 1.f}; orow[64 * j] = t * rstd * g; }
        }
    }
#undef IN
#undef SEAM
}

extern "C" void kernel_launch(void* const* d_in, const int* in_sizes, int n_in, void* d_out, int out_size, void* d_ws, size_t ws_size, hipStream_t stream) {
    static int grid = 0;
    if (grid == 0) {
        if (n_in != 15 || in_sizes[0] != M_TOK * DM || out_size != M_TOK * DM || ws_size < WS_END) { fprintf(stderr, "kernel_launch: unexpected shapes (n_in %d, ws %zu)\n", n_in, ws_size); grid = -1; return; }
        int dev = 0, cus = 0, per_cu = 0;
        (void)hipGetDevice(&dev); (void)hipDeviceGetAttribute(&cus, hipDeviceAttributeMultiprocessorCount, dev);
        if (hipFuncSetAttribute((const void*)mega, hipFuncAttributeMaxDynamicSharedMemorySize, LDS_BYTES) != hipSuccess) { fprintf(stderr, "kernel_launch: hipFuncSetAttribute failed\n"); grid = -1; return; }
        if (hipOccupancyMaxActiveBlocksPerMultiprocessor(&per_cu, (const void*)mega, 512, LDS_BYTES) != hipSuccess || per_cu < 1) { fprintf(stderr, "kernel_launch: occupancy query says %d\n", per_cu); per_cu = 1; }
        (void)hipGetLastError();
        grid = 256;
        if (cus * per_cu < 256) fprintf(stderr, "kernel_launch: device capacity %d x %d < 256 workgroups\n", cus, per_cu);
    }
    if (grid < 0) return;
    (void)hipMemsetAsync((char*)d_ws + WS_CTL, 0, 131072 + 524288, stream);
    Params p{};
    p.x = (const float*)d_in[0]; p.ln_gain = (const float*)d_in[1]; p.w_in = (const float*)d_in[2]; p.sinks = (const float*)d_in[3]; p.conv_w = (const float*)d_in[4]; p.conv_b = (const float*)d_in[5];
    p.w_r = (const float*)d_in[6]; p.b_r = (const float*)d_in[7]; p.w_i = (const float*)d_in[8]; p.b_i = (const float*)d_in[9]; p.lam = (const float*)d_in[10]; p.ga = (const float*)d_in[11]; p.gl = (const float*)d_in[12];
    p.w_out = (const float*)d_in[13]; p.fg = (const float*)d_in[14]; p.out = (float*)d_out; p.ws = (unsigned char*)d_ws;
    if (MK_N_LAUNCHES == 1) {
        p.ph_lo = 0; p.ph_hi = 4; void* args[] = {&p};
        hipError_t e = hipLaunchCooperativeKernel((const void*)mega, dim3(grid), dim3(512), args, LDS_BYTES, stream);
        if (e != hipSuccess) fprintf(stderr, "kernel_launch: cooperative launch failed: %s (grid %d)\n", hipGetErrorString(e), grid);
    } else {
        for (int ph = 0; ph < 4; ++ph) { p.ph_lo = ph; p.ph_hi = ph + 1; hipLaunchKernelGGL(mega, dim3(grid), dim3(512), LDS_BYTES, stream, p); }
    }
}
```
